# Optimizing an MI355X kernel written in HIP

```python
import math
import jax, jax.numpy as jnp
from jax import lax
import numpy as np

D_MODEL = 1024
BATCH = 2
SEQ = 8192
DEPTH = 2

HEAD_DIM = 64
N_RET = 6
N_NSA = 6
N_KV = 2
HPG = N_NSA // N_KV
N_GM = 4
GM_DIM = 64
RET_W = N_RET * HEAD_DIM
NSA_W = N_NSA * HEAD_DIM
GM_W = N_GM * GM_DIM
MIX_W = RET_W + NSA_W + GM_W
RET_CHUNK = 128
CMP_LEN = 32
CMP_STRIDE = 16
SEL_BLOCK = 64
N_SEL = 16
WINDOW = 512
Q_BLOCK = 128
GM_CHUNK = 128
N_BUCKETS = 32
MAX_DISTANCE = 128
ROPE_THETA = 10000.0
D_FF = -(-8 * D_MODEL // (3 * 256)) * 256
SPLIT_SIZES = (RET_W, RET_W, RET_W, RET_W, NSA_W, 3 * 2 * N_KV * HEAD_DIM, 3 * N_NSA, 2 * GM_W)
IN_W = sum(SPLIT_SIZES)
EPS = 1e-6
BIG = 1e9
NEG = -1e30

kernel_name = "hybrid_retention_nsa_gmlp_block"


def rms_norm(x, gain=None):
    xf = x.astype(jnp.float32)
    y = xf * lax.rsqrt(jnp.mean(xf * xf, axis=-1, keepdims=True) + EPS)
    if gain is not None:
        y = y * gain.astype(jnp.float32)
    return y.astype(x.dtype)


def rope(x, pos):
    half = x.shape[-1] // 2
    inv = ROPE_THETA ** (-jnp.arange(half, dtype=jnp.float32) / half)
    ang = pos.astype(jnp.float32)[:, None] * inv[None, :]
    cos = jnp.cos(ang)[None, :, None, :]
    sin = jnp.sin(ang)[None, :, None, :]
    x1 = x[..., :half].astype(jnp.float32)
    x2 = x[..., half:].astype(jnp.float32)
    return jnp.concatenate([x1 * cos - x2 * sin, x2 * cos + x1 * sin], axis=-1).astype(x.dtype)


def t5_bucket(dist):
    n = jnp.maximum(dist, 0)
    max_exact = N_BUCKETS // 2
    nf = jnp.maximum(n, 1).astype(jnp.float32)
    large = max_exact + (jnp.log(nf / max_exact) / math.log(MAX_DISTANCE / max_exact)
                         * (N_BUCKETS - max_exact)).astype(jnp.int32)
    large = jnp.minimum(large, N_BUCKETS - 1)
    return jnp.where(n < max_exact, n, large)


def masked_softmax(logits, mask):
    s = jnp.where(mask, logits.astype(jnp.float32), NEG)
    return jax.nn.softmax(s, axis=-1) * mask


def retention(q, k, v, g):
    B, T, H, d = q.shape
    C = RET_CHUNK
    nc = T // C
    f32 = jnp.float32
    to_chunks = lambda a: a.astype(f32).reshape(B, nc, C, H, d).transpose(0, 3, 1, 2, 4)
    qc, kc, vc = to_chunks(q), to_chunks(k * d ** -0.5), to_chunks(v)
    log_gamma = jnp.log(1.0 - 2.0 ** (-5.0 - jnp.arange(H, dtype=f32)))
    idx = jnp.arange(C, dtype=f32)
    diff = idx[:, None] - idx[None, :]
    decay = jnp.where(diff >= 0, jnp.exp(jnp.maximum(diff, 0.0)[None] * log_gamma[:, None, None]), 0.0)
    scores = jnp.einsum('bhcnd,bhcmd->bhcnm', qc, kc) * decay[:, None]
    inner = jnp.einsum('bhcnm,bhcme->bhcne', scores, vc)
    zeta = jnp.exp((C - 1 - idx)[None, :] * log_gamma[:, None])
    xi = jnp.exp((idx + 1)[None, :] * log_gamma[:, None])
    chunk_decay = jnp.exp(C * log_gamma)

    def step(R, kv):
        kt, vt = kv
        R_new = chunk_decay[None, :, None, None] * R + jnp.einsum('bhmd,bhme->bhde', kt * zeta[None, :, :, None], vt)
        return R_new, R

    R0 = jnp.zeros((B, H, d, d), f32)
    _, R_prev = lax.scan(step, R0, (kc.transpose(2, 0, 1, 3, 4), vc.transpose(2, 0, 1, 3, 4)))
    cross = jnp.einsum('bhcnd,cbhde->bhcne', qc, R_prev) * xi[None, :, None, :, None]
    o = (inner + cross).transpose(0, 2, 3, 1, 4).reshape(B, T, H, d)
    o = rms_norm(o) * jax.nn.silu(g.astype(f32))
    return o.reshape(B, T, H * d).astype(q.dtype)


def nsa(q, kv, gates, q_gain, k_gain, cmp_pe, cmp_w1, cmp_w2, rel_bias):
    B, T, _, d = q.shape
    out_dtype = q.dtype
    q = rms_norm(q, q_gain) * d ** -0.5
    q = q.reshape(B, T, N_KV, HPG, d).transpose(0, 2, 3, 1, 4)
    kv = kv.transpose(2, 3, 0, 4, 1, 5)

    n_cmp = (T - CMP_LEN) // CMP_STRIDE + 1
    blk_idx = np.arange(n_cmp)[:, None] * CMP_STRIDE + np.arange(CMP_LEN)[None, :]

    def compress(a, j):
        blocks = a[:, :, blk_idx] + cmp_pe[j]
        flat = blocks.reshape(B, N_KV, n_cmp, CMP_LEN * d)
        return jax.nn.gelu(flat @ cmp_w1[j]) @ cmp_w2[j]

    k_cmp = rms_norm(compress(kv[0, 0], 0), k_gain[0])
    v_cmp = compress(kv[0, 1], 1)
    cmp_end = jnp.asarray(blk_idx[:, -1], jnp.int32)

    n_slc = T // SEL_BLOCK
    n_sel = min(N_SEL, n_slc)
    k_sel = rms_norm(kv[1, 0], k_gain[1]).reshape(B, N_KV, n_slc, SEL_BLOCK, d)
    v_sel = kv[1, 1].reshape(B, N_KV, n_slc, SEL_BLOCK, d)
    cs = np.arange(n_cmp)[:, None] * CMP_STRIDE
    ss = np.arange(n_slc)[None, :] * SEL_BLOCK
    overlap = np.clip(np.minimum(cs + CMP_LEN, ss + SEL_BLOCK) - np.maximum(cs, ss), 0, None) // CMP_STRIDE
    overlap = jnp.asarray(overlap, jnp.float32)

    pad = ((0, 0), (0, 0), (WINDOW, 0), (0, 0))
    k_win = jnp.pad(rms_norm(kv[2, 0], k_gain[2]), pad)
    v_win = jnp.pad(kv[2, 1], pad)

    gates_t = jax.nn.sigmoid(gates.astype(jnp.float32)).reshape(B, T, N_KV, HPG, 3).transpose(0, 2, 3, 1, 4)
    bias_tab = rel_bias.reshape(N_BUCKETS, N_KV, HPG)
    bi = jnp.arange(B)[:, None, None, None]
    gi = jnp.arange(N_KV)[None, :, None, None]
    K_SEL = n_sel * SEL_BLOCK

    def block(i):
        q0 = i * Q_BLOCK
        qb = lax.dynamic_slice_in_dim(q, q0, Q_BLOCK, axis=3)
        t = q0 + jnp.arange(Q_BLOCK, dtype=jnp.int32)

        dist_c = t[:, None] - cmp_end[None, :]
        bias_c = bias_tab[t5_bucket(dist_c)].transpose(2, 3, 0, 1)
        s_c = jnp.einsum('bghqd,bgnd->bghqn', qb, k_cmp) + bias_c
        p_c = masked_softmax(s_c, dist_c >= 0)
        o_c = jnp.einsum('bghqn,bgnd->bghqd', p_c, v_cmp)

        imp = jnp.einsum('bghqn,nj->bgqj', p_c, overlap)
        cur = (t // SEL_BLOCK)[:, None]
        j = jnp.arange(n_slc)[None, :]
        imp = jnp.where((j == 0) | (j == cur) | (j == cur - 1), BIG, imp)
        imp = jnp.where(j > cur, -BIG, imp)
        _, sel = lax.top_k(imp, n_sel)
        ks = k_sel[bi, gi, sel].reshape(B, N_KV, Q_BLOCK, K_SEL, d)
        vs = v_sel[bi, gi, sel].reshape(B, N_KV, Q_BLOCK, K_SEL, d)
        pos = sel[..., None] * SEL_BLOCK + jnp.arange(SEL_BLOCK, dtype=jnp.int32)
        dist_s = (t[None, None, :, None, None] - pos).reshape(B, N_KV, Q_BLOCK, K_SEL)
        bias_s = bias_tab[t5_bucket(dist_s), gi].transpose(0, 1, 4, 2, 3)
        s_s = jnp.einsum('bghqd,bgqkd->bghqk', qb, ks) + bias_s
        p_s = masked_softmax(s_s, (dist_s >= 0)[:, :, None])
        o_s = jnp.einsum('bghqk,bgqkd->bghqd', p_s, vs)

        kw = lax.dynamic_slice_in_dim(k_win, q0, WINDOW + Q_BLOCK, axis=2)
        vw = lax.dynamic_slice_in_dim(v_win, q0, WINDOW + Q_BLOCK, axis=2)
        s_pos = q0 - WINDOW + jnp.arange(WINDOW + Q_BLOCK, dtype=jnp.int32)
        dist_w = t[:, None] - s_pos[None, :]
        mask_w = (dist_w >= 0) & (dist_w < WINDOW) & (s_pos[None, :] >= 0)
        bias_w = bias_tab[t5_bucket(dist_w)].transpose(2, 3, 0, 1)
        s_w = jnp.einsum('bghqd,bgkd->bghqk', qb, kw) + bias_w
        p_w = masked_softmax(s_w, mask_w)
        o_w = jnp.einsum('bghqk,bgkd->bghqd', p_w, vw)

        g = lax.dynamic_slice_in_dim(gates_t, q0, Q_BLOCK, axis=3)
        return g[..., 0:1] * o_c + g[..., 1:2] * o_s + g[..., 2:3] * o_w

    out = lax.map(block, jnp.arange(T // Q_BLOCK, dtype=jnp.int32))
    return out.transpose(1, 0, 4, 2, 3, 5).reshape(B, T, N_NSA * d).astype(out_dtype)


def spatial_gating(z, ws, b):
    B, T, _ = z.shape
    nch = T // GM_CHUNK
    z = jax.nn.gelu(z)
    u, v = jnp.split(z, 2, axis=-1)
    v = rms_norm(v.reshape(B, nch, GM_CHUNK, N_GM, GM_DIM))
    causal = jnp.tril(jnp.ones((GM_CHUNK, GM_CHUNK), ws.dtype))
    sv = jnp.einsum('gts,bcsgd->bctgd', ws * causal, v) + b.T[None, None, :, :, None]
    return (u.reshape(B, nch, GM_CHUNK, N_GM, GM_DIM) * sv).reshape(B, T, GM_W)


def setup_inputs(seed: int = 0) -> dict:
    key = jax.random.key(seed)
    ks = jax.random.split(key, 16)
    f32 = jnp.float32
    nrm = lambda k, shape, scale: jax.random.normal(k, shape, f32) * scale
    return {
        "x": nrm(ks[0], (BATCH, SEQ, D_MODEL), 1.0),
        "attn_norm": 1.0 + nrm(ks[1], (DEPTH, D_MODEL), 0.02),
        "w_in": nrm(ks[2], (DEPTH, D_MODEL, IN_W), D_MODEL ** -0.5),
        "w_out": nrm(ks[3], (DEPTH, MIX_W, D_MODEL), MIX_W ** -0.5),
        "nsa_q_gain": 1.0 + nrm(ks[4], (DEPTH, HEAD_DIM), 0.02),
        "nsa_k_gain": 1.0 + nrm(ks[5], (DEPTH, 3, HEAD_DIM), 0.02),
        "cmp_pe": nrm(ks[6], (DEPTH, 2, CMP_LEN, HEAD_DIM), 0.1),
        "cmp_w1": nrm(ks[7], (DEPTH, 2, CMP_LEN * HEAD_DIM, HEAD_DIM), (CMP_LEN * HEAD_DIM) ** -0.5),
        "cmp_w2": nrm(ks[8], (DEPTH, 2, HEAD_DIM, HEAD_DIM), HEAD_DIM ** -0.5),
        "gm_ws": nrm(ks[9], (DEPTH, N_GM, GM_CHUNK, GM_CHUNK), GM_CHUNK ** -0.5),
        "gm_b": 1.0 + nrm(ks[10], (DEPTH, N_GM, GM_CHUNK), 0.02),
        "ffn_norm": 1.0 + nrm(ks[11], (DEPTH, D_MODEL), 0.02),
        "w_gate_up": nrm(ks[12], (DEPTH, D_MODEL, 2 * D_FF), D_MODEL ** -0.5),
        "w_down": nrm(ks[13], (DEPTH, D_FF, D_MODEL), D_FF ** -0.5),
        "rel_bias": nrm(ks[14], (N_BUCKETS, N_NSA), 0.5),
    }


def reference(x, attn_norm, w_in, w_out, nsa_q_gain, nsa_k_gain, cmp_pe, cmp_w1, cmp_w2,
              gm_ws, gm_b, ffn_norm, w_gate_up, w_down, rel_bias):
    B, T, _ = x.shape
    pos = jnp.arange(T, dtype=jnp.int32)
    split_points = [int(s) for s in np.cumsum(SPLIT_SIZES)[:-1]]
    for l in range(DEPTH):
        h = rms_norm(x, attn_norm[l])
        proj = h @ w_in[l]
        r_q, r_k, r_v, r_g, n_q, n_kv, n_g, gm_z = jnp.split(proj, split_points, axis=-1)
        hs = (B, T, N_RET, HEAD_DIM)
        ret_o = retention(rope(r_q.reshape(hs), pos), rope(r_k.reshape(hs), pos),
                          r_v.reshape(hs), r_g.reshape(hs))
        nsa_o = nsa(n_q.reshape(B, T, N_NSA, HEAD_DIM),
                    n_kv.reshape(B, T, 3, 2, N_KV, HEAD_DIM),
                    n_g.reshape(B, T, N_NSA, 3),
                    nsa_q_gain[l], nsa_k_gain[l], cmp_pe[l], cmp_w1[l], cmp_w2[l], rel_bias)
        gm_o = spatial_gating(gm_z, gm_ws[l], gm_b[l])
        mix = jnp.concatenate([ret_o, nsa_o.astype(ret_o.dtype), gm_o.astype(ret_o.dtype)], axis=-1)
        x = x + (mix @ w_out[l]).astype(x.dtype)
        h = rms_norm(x, ffn_norm[l])
        gate, up = jnp.split(h @ w_gate_up[l], 2, axis=-1)
        x = x + ((jax.nn.silu(gate) * up) @ w_down[l]).astype(x.dtype)
    return x
```

```cpp
#include <hip/hip_runtime.h>
#include <stdint.h>
#include <stdio.h>

typedef unsigned short bf16_t;

#define T_ 8192
#define M_ 16384
#define D_ 1024
#define INW 3218
#define DFF 2816
#define EPS 1e-6f
#define NTHR 256

struct P {
  const float *x, *attn_norm, *w_in, *w_out, *q_gain, *k_gain, *cmp_pe, *cmp_w1, *cmp_w2, *gm_ws, *gm_b, *ffn_norm, *w_gu, *w_down, *rel_bias;
  float* out; unsigned char* ws;
};

constexpr size_t MiB = 1u << 20;
constexpr size_t OFF_HB = 0;
constexpr size_t OFF_ACT = 0;
constexpr size_t OFF_MIX = 100 * MiB;
constexpr size_t OFF_GATES = 132 * MiB;
constexpr size_t OFF_KC = 134 * MiB;
constexpr size_t OFF_VC = 134 * MiB + 512 * 1024;
constexpr size_t OFF_RS = 135 * MiB;
constexpr size_t OFF_RSTD = 147 * MiB;
constexpr size_t OFF_ROPE = 148 * MiB;

__device__ __forceinline__ float bf2f(bf16_t v) { return __uint_as_float(((unsigned)v) << 16); }
__device__ __forceinline__ bf16_t f2bf(float f) { unsigned u = __float_as_uint(f); u += 0x7fffu + ((u >> 16) & 1u); return (bf16_t)(u >> 16); }
__device__ __forceinline__ float gelu_tanh(float x) { return 0.5f * x * (1.f + tanhf(0.7978845608028654f * (x + 0.044715f * x * x * x))); }
__device__ __forceinline__ float sigmoidf(float x) { return 1.f / (1.f + expf(-x)); }
__device__ __forceinline__ float wave_sum(float v) {
#pragma unroll
  for (int o = 1; o < 64; o <<= 1) v += __shfl_xor(v, o);
  return v;
}
__device__ __forceinline__ float wave_max(float v) {
#pragma unroll
  for (int o = 1; o < 64; o <<= 1) v = fmaxf(v, __shfl_xor(v, o));
  return v;
}
__device__ __forceinline__ int t5_bucket(int n) {
  if (n < 16) return n;
  int b = 16;
  b += (n >= 19); b += (n >= 21); b += (n >= 24); b += (n >= 27); b += (n >= 31); b += (n >= 35); b += (n >= 40); b += (n >= 46);
  b += (n >= 52); b += (n >= 59); b += (n >= 67); b += (n >= 77); b += (n >= 87); b += (n >= 99); b += (n >= 113);
  return b;
}
#define WSYNC() do { __builtin_amdgcn_fence(__ATOMIC_RELEASE, "wavefront"); __builtin_amdgcn_wave_barrier(); __builtin_amdgcn_fence(__ATOMIC_ACQUIRE, "wavefront"); } while (0)

__device__ void ph_init(const P& p) {
  float2* tab = (float2*)(p.ws + OFF_ROPE);
  for (int i = blockIdx.x * NTHR + threadIdx.x; i < T_ * 32; i += gridDim.x * NTHR) {
    const int t = i >> 5, k = i & 31;
    const float inv = powf(10000.0f, -(float)k / 32.0f);
    const float ang = (float)t * inv;
    tab[i] = make_float2(cosf(ang), sinf(ang));
  }
}
__device__ void ph_rowstat(const P& p, const float* xc) {
  float* rstd = (float*)(p.ws + OFF_RSTD);
  const int wave = threadIdx.x >> 6, lane = threadIdx.x & 63;
  for (int r = blockIdx.x * 4 + wave; r < M_; r += gridDim.x * 4) {
    const float4* xr = (const float4*)(xc + (size_t)r * D_);
    float s = 0.f;
#pragma unroll
    for (int j = 0; j < 4; ++j) { const float4 v = xr[lane + 64 * j]; s += v.x * v.x + v.y * v.y + v.z * v.z + v.w * v.w; }
    s = wave_sum(s);
    if (lane == 0) rstd[r] = rsqrtf(s * (1.f / D_) + EPS);
  }
}
template <int MODE>
__device__ void gemm_item(const P& p, int layer, int item, const float* xc, float* xo, float* sm) {
  constexpr int BM = 128, BN = 64, BK = 16, LDA_S = BM + 4;
  constexpr int NT = (MODE == 0) ? 51 : (MODE == 1) ? 16 : (MODE == 2) ? 44 : 16;
  constexpr int K = (MODE == 3) ? DFF : D_;
  const int tm = item / NT, tn = item % NT;
  const int tid = threadIdx.x, tx = tid & 15, ty = tid >> 4;
  float* As = sm; float* Bs = sm + BK * LDA_S; float* Bs2 = Bs + BK * BN;
  const float* rstd = (const float*)(p.ws + OFF_RSTD);
  const bf16_t* mix = (const bf16_t*)(p.ws + OFF_MIX);
  const bf16_t* act = (const bf16_t*)(p.ws + OFF_ACT);
  const float* gain = (MODE == 0) ? p.attn_norm + layer * D_ : p.ffn_norm + layer * D_;
  const float* Bw; int ldb, col0, ncol = 64;
  if (MODE == 0) { Bw = p.w_in + (size_t)layer * D_ * INW; ldb = INW; col0 = (tn < 42) ? 64 * tn : (tn < 50) ? 2706 + 64 * (tn - 42) : 2688; if (tn == 50) ncol = 18; }
  else if (MODE == 1) { Bw = p.w_out + (size_t)layer * D_ * D_; ldb = D_; col0 = tn * 64; }
  else if (MODE == 2) { Bw = p.w_gu + (size_t)layer * D_ * 2 * DFF; ldb = 2 * DFF; col0 = tn * 64; }
  else { Bw = p.w_down + (size_t)layer * DFF * D_; ldb = D_; col0 = tn * 64; }
  float acc[8][4], acc2[8][4];
#pragma unroll
  for (int i = 0; i < 8; ++i)
#pragma unroll
    for (int j = 0; j < 4; ++j) { acc[i][j] = 0.f; acc2[i][j] = 0.f; }
  const int r0 = tm * BM;
  for (int k0 = 0; k0 < K; k0 += BK) {
    __syncthreads();
#pragma unroll
    for (int i = 0; i < 8; ++i) {
      const int idx = tid + 256 * i, row = idx >> 4, k = idx & 15; float a;
      if (MODE == 0 || MODE == 2) a = xc[(size_t)(r0 + row) * D_ + k0 + k] * rstd[r0 + row] * gain[k0 + k];
      else if (MODE == 1) a = bf2f(mix[(size_t)(r0 + row) * D_ + k0 + k]);
      else a = bf2f(act[(size_t)(r0 + row) * DFF + k0 + k]);
      As[k * LDA_S + row] = a;
    }
#pragma unroll
    for (int i = 0; i < 4; ++i) {
      const int idx = tid + 256 * i, k = idx >> 6, c = idx & 63;
      Bs[k * BN + c] = (c < ncol) ? Bw[(size_t)(k0 + k) * ldb + col0 + c] : 0.f;
      if (MODE == 2) Bs2[k * BN + c] = Bw[(size_t)(k0 + k) * ldb + DFF + col0 + c];
    }
    __syncthreads();
#pragma unroll
    for (int kk = 0; kk < BK; ++kk) {
      float a[8], b[4], b2[4];
#pragma unroll
      for (int i = 0; i < 8; ++i) a[i] = As[kk * LDA_S + ty * 8 + i];
#pragma unroll
      for (int j = 0; j < 4; ++j) { b[j] = Bs[kk * BN + tx * 4 + j]; if (MODE == 2) b2[j] = Bs2[kk * BN + tx * 4 + j]; }
#pragma unroll
      for (int i = 0; i < 8; ++i)
#pragma unroll
        for (int j = 0; j < 4; ++j) { acc[i][j] += a[i] * b[j]; if (MODE == 2) acc2[i][j] += a[i] * b2[j]; }
    }
  }
  if (MODE == 1 || MODE == 3) {
#pragma unroll
    for (int i = 0; i < 8; ++i) {
      const size_t o = (size_t)(r0 + ty * 8 + i) * D_ + col0 + tx * 4;
      const float4 xv = *(const float4*)(xc + o);
      *(float4*)(xo + o) = make_float4(xv.x + acc[i][0], xv.y + acc[i][1], xv.z + acc[i][2], xv.w + acc[i][3]);
    }
  } else if (MODE == 2) {
    bf16_t* actw = (bf16_t*)(p.ws + OFF_ACT);
#pragma unroll
    for (int i = 0; i < 8; ++i)
#pragma unroll
      for (int j = 0; j < 4; ++j) { const float g = acc[i][j], u = acc2[i][j]; actw[(size_t)(r0 + ty * 8 + i) * DFF + col0 + tx * 4 + j] = f2bf(g * sigmoidf(g) * u); }
  } else {
    __syncthreads();
    float* Ct = sm;
#pragma unroll
    for (int i = 0; i < 8; ++i)
#pragma unroll
      for (int j = 0; j < 4; ++j) Ct[(ty * 8 + i) * 65 + tx * 4 + j] = acc[i][j];
    __syncthreads();
    const int row = tid >> 1, half = tid & 1, r = r0 + row, t = r & (T_ - 1), slot = tn;
    bf16_t* HB = (bf16_t*)(p.ws + OFF_HB);
    bf16_t* dst = HB + ((size_t)slot * M_ + r) * 64;
    const float* cr = Ct + row * 65;
    if (slot < 12) {
      const float2* tab = (const float2*)(p.ws + OFF_ROPE) + t * 32;
      const float sc = (slot >= 6) ? 0.125f : 1.f;
      for (int i = half * 16; i < half * 16 + 16; ++i) {
        const float x1 = cr[i], x2 = cr[i + 32]; const float2 cs = tab[i];
        dst[i] = f2bf((x1 * cs.x - x2 * cs.y) * sc); dst[i + 32] = f2bf((x2 * cs.x + x1 * cs.y) * sc);
      }
    } else if (slot == 50) {
      float* gates = (float*)(p.ws + OFF_GATES);
      if (half == 0) for (int i = 0; i < 18; ++i) gates[(size_t)r * 24 + i] = sigmoidf(cr[i]);
    } else {
      const bool is_gelu = (slot >= 42);
      const bool is_rms = (slot >= 24 && slot < 30) || slot == 34 || slot == 35 || slot == 38 || slot == 39 || slot >= 46;
      float v[32]; float ss = 0.f;
#pragma unroll
      for (int i = 0; i < 32; ++i) { float x = cr[half * 32 + i]; if (is_gelu) x = gelu_tanh(x); v[i] = x; ss += x * x; }
      ss += __shfl_xor(ss, 1);
      if (is_rms) {
        const float rs = rsqrtf(ss * (1.f / 64.f) + EPS);
        const float* gn = nullptr; float sc = 1.f;
        if (slot < 30) { gn = p.q_gain + layer * 64; sc = 0.125f; }
        else if (slot == 34 || slot == 35) gn = p.k_gain + (layer * 3 + 1) * 64;
        else if (slot == 38 || slot == 39) gn = p.k_gain + (layer * 3 + 2) * 64;
#pragma unroll
        for (int i = 0; i < 32; ++i) v[i] = v[i] * rs * (gn ? gn[half * 32 + i] : 1.f) * sc;
      }
#pragma unroll
      for (int i = 0; i < 32; ++i) dst[half * 32 + i] = f2bf(v[i]);
    }
  }
}
template <int MODE>
__device__ void ph_gemm(const P& p, int layer, const float* xc, float* xo, float* sm) {
  constexpr int NT = (MODE == 0) ? 51 : (MODE == 1) ? 16 : (MODE == 2) ? 44 : 16;
  for (int item = blockIdx.x; item < (M_ / 128) * NT; item += gridDim.x) { gemm_item<MODE>(p, layer, item, xc, xo, sm); __syncthreads(); }
}
__device__ __forceinline__ float ret_loggamma(int h) { return log1pf(-exp2f(-5.f - (float)h)); }
__device__ void ret_kv_item(const P& p, int item, float* sm) {
  const int c = item & 63, bh = item >> 6, b = bh / 6, h = bh % 6, tid = threadIdx.x;
  const bf16_t* HB = (const bf16_t*)(p.ws + OFF_HB);
  const bf16_t* Kp = HB + ((size_t)(6 + h) * M_ + b * T_ + c * 128) * 64;
  const bf16_t* Vp = HB + ((size_t)(12 + h) * M_ + b * T_ + c * 128) * 64;
  float* Ks = sm; float* Vs = sm + 8192;
  const float lg = ret_loggamma(h);
  for (int i = tid; i < 8192; i += NTHR) { const int m = i >> 6; Ks[i] = bf2f(Kp[i]) * expf((float)(127 - m) * lg); Vs[i] = bf2f(Vp[i]); }
  __syncthreads();
  const int d = tid >> 2, e0 = (tid & 3) * 16;
  float acc[16];
#pragma unroll
  for (int j = 0; j < 16; ++j) acc[j] = 0.f;
  for (int m = 0; m < 128; ++m) { const float kd = Ks[m * 64 + d];
#pragma unroll
    for (int j = 0; j < 16; ++j) acc[j] += kd * Vs[m * 64 + e0 + j]; }
  float* S = (float*)(p.ws + OFF_RS) + (size_t)item * 4096 + d * 64 + e0;
#pragma unroll
  for (int j = 0; j < 16; ++j) S[j] = acc[j];
}
__device__ void ph_scan(const P& p) {
  float* S = (float*)(p.ws + OFF_RS);
  for (int i = blockIdx.x * NTHR + threadIdx.x; i < 12 * 4096; i += gridDim.x * NTHR) {
    const int bh = i >> 12, de = i & 4095, h = bh % 6;
    const float cd = expf(128.f * ret_loggamma(h));
    float R = 0.f;
    for (int c = 0; c < 64; ++c) { float* q = S + ((size_t)(bh * 64 + c) * 4096 + de); const float kv = *q; *q = R; R = cd * R + kv; }
  }
}
__device__ void ret_out_item(const P& p, int item, float* sm) {
  const int c = item & 63, bh = item >> 6, b = bh / 6, h = bh % 6, tid = threadIdx.x;
  const bf16_t* HB = (const bf16_t*)(p.ws + OFF_HB);
  const size_t r0 = (size_t)b * T_ + c * 128;
  const bf16_t* Qp = HB + ((size_t)(0 + h) * M_ + r0) * 64;
  const bf16_t* Kp = HB + ((size_t)(6 + h) * M_ + r0) * 64;
  const bf16_t* Vp = HB + ((size_t)(12 + h) * M_ + r0) * 64;
  const bf16_t* Gp = HB + ((size_t)(18 + h) * M_ + r0) * 64;
  const float* R = (const float*)(p.ws + OFF_RS) + (size_t)item * 4096;
  float* Qs = sm;
  float* red = sm + 128 * 65;
  bf16_t* Ks = (bf16_t*)(red + 256);
  bf16_t* Vs = Ks + 8192;
  const float lg = ret_loggamma(h);
  for (int i = tid; i < 8192; i += NTHR) { Ks[i] = Kp[i]; Vs[i] = Vp[i]; Qs[(i >> 6) * 65 + (i & 63)] = bf2f(Qp[i]); }
  __syncthreads();
  const int n = tid & 127, half = tid >> 7;
  const float* qr = Qs + n * 65;
  float o[32];
#pragma unroll
  for (int j = 0; j < 32; ++j) o[j] = 0.f;
  for (int m = 0; m <= n; ++m) {
    float s = 0.f;
#pragma unroll 8
    for (int d = 0; d < 64; ++d) s += qr[d] * bf2f(Ks[m * 64 + d]);
    s *= expf((float)(n - m) * lg);
#pragma unroll
    for (int j = 0; j < 32; ++j) o[j] += s * bf2f(Vs[m * 64 + half * 32 + j]);
  }
  const float xi = expf((float)(n + 1) * lg);
  for (int d = 0; d < 64; ++d) { const float qd = qr[d] * xi;
#pragma unroll
    for (int j = 0; j < 32; ++j) o[j] += qd * R[d * 64 + half * 32 + j]; }
  float ss = 0.f;
#pragma unroll
  for (int j = 0; j < 32; ++j) ss += o[j] * o[j];
  red[tid] = ss;
  __syncthreads();
  const float rs = rsqrtf((red[n] + red[n + 128]) * (1.f / 64.f) + EPS);
  bf16_t* mix = (bf16_t*)(p.ws + OFF_MIX) + (r0 + n) * D_ + h * 64 + half * 32;
#pragma unroll
  for (int j = 0; j < 32; ++j) { const float g = bf2f(Gp[n * 64 + half * 32 + j]); mix[j] = f2bf(o[j] * rs * (g * sigmoidf(g))); }
}
__device__ void gmlp_item(const P& p, int layer, int item, float* sm) {
  const int g = item & 3, bc = item >> 2, tid = threadIdx.x;
  const size_t r0 = (size_t)bc * 128;
  const bf16_t* HB = (const bf16_t*)(p.ws + OFF_HB);
  const bf16_t* Up = HB + ((size_t)(42 + g) * M_ + r0) * 64;
  const bf16_t* Vp = HB + ((size_t)(46 + g) * M_ + r0) * 64;
  float* Vs = sm;
  for (int i = tid; i < 8192; i += NTHR) Vs[i] = bf2f(Vp[i]);
  __syncthreads();
  const int t = tid >> 1, half = tid & 1;
  const float* wrow = p.gm_ws + ((size_t)(layer * 4 + g) * 128 + t) * 128;
  float acc[32];
#pragma unroll
  for (int j = 0; j < 32; ++j) acc[j] = 0.f;
  for (int s = 0; s <= t; ++s) { const float w = wrow[s];
#pragma unroll
    for (int j = 0; j < 32; ++j) acc[j] += w * Vs[s * 64 + half * 32 + j]; }
  const float bias = p.gm_b[(layer * 4 + g) * 128 + t];
  bf16_t* mix = (bf16_t*)(p.ws + OFF_MIX) + (r0 + t) * D_ + 768 + g * 64 + half * 32;
#pragma unroll
  for (int j = 0; j < 32; ++j) mix[j] = f2bf(bf2f(Up[t * 64 + half * 32 + j]) * (acc[j] + bias));
}
__device__ void cmp_item(const P& p, int layer, int item, float* sm) {
  const int o8 = item & 63, j = (item >> 6) & 1, bg = item >> 7, b = bg >> 1, g = bg & 1, tid = threadIdx.x;
  const int slot = 30 + j * 2 + g;
  const bf16_t* src = (const bf16_t*)(p.ws + OFF_HB) + ((size_t)slot * M_ + (size_t)b * T_) * 64;
  float* xs = sm; float* pes = sm + 144 * 64; float* hid = pes + 2048;
  const int tok0 = 128 * o8;
  for (int i = tid; i < 144 * 64; i += NTHR) { const int tok = tok0 + (i >> 6); xs[i] = (tok < T_) ? bf2f(src[(size_t)tok * 64 + (i & 63)]) : 0.f; }
  for (int i = tid; i < 2048; i += NTHR) pes[i] = p.cmp_pe[(size_t)(layer * 2 + j) * 2048 + i];
  __syncthreads();
  const int f = tid & 63, nq = tid >> 6;
  const float* w1 = p.cmp_w1 + (size_t)(layer * 2 + j) * 2048 * 64;
  float a0 = 0.f, a1 = 0.f;
  for (int i = 0; i < 2048; ++i) {
    const int l = i >> 6, d = i & 63; const float w = w1[(size_t)i * 64 + f], pe = pes[i];
    a0 += (xs[(16 * (nq * 2) + l) * 64 + d] + pe) * w;
    a1 += (xs[(16 * (nq * 2 + 1) + l) * 64 + d] + pe) * w;
  }
  hid[(nq * 2) * 64 + f] = gelu_tanh(a0); hid[(nq * 2 + 1) * 64 + f] = gelu_tanh(a1);
  __syncthreads();
  const float* w2 = p.cmp_w2 + (size_t)(layer * 2 + j) * 4096;
  float o0 = 0.f, o1 = 0.f;
  for (int ff = 0; ff < 64; ++ff) { const float w = w2[ff * 64 + f]; o0 += hid[(nq * 2) * 64 + ff] * w; o1 += hid[(nq * 2 + 1) * 64 + ff] * w; }
  if (j == 0) {
    const float gn = p.k_gain[(layer * 3 + 0) * 64 + f];
    const float s0 = wave_sum(o0 * o0), s1 = wave_sum(o1 * o1);
    o0 = o0 * rsqrtf(s0 * (1.f / 64.f) + EPS) * gn; o1 = o1 * rsqrtf(s1 * (1.f / 64.f) + EPS) * gn;
  }
  float* dst = (float*)(p.ws + (j == 0 ? OFF_KC : OFF_VC)) + (size_t)bg * 512 * 64;
  const int n0 = 8 * o8 + nq * 2;
  if (n0 < 511) dst[(size_t)n0 * 64 + f] = o0;
  if (n0 + 1 < 511) dst[(size_t)(n0 + 1) * 64 + f] = o1;
}
__device__ __forceinline__ void nsa_scores(const bf16_t* Kp, int key0, int t, int kmin, const float* qs, const float* bias, int hb, float* pb, int slot, int lane, float* mx) {
  const int key = key0 + lane;
  const bool ok = (key >= kmin) && (key <= t);
  float s0 = 0.f, s1 = 0.f, s2 = 0.f;
  if (ok) {
    const uint4* kr = (const uint4*)(Kp + (size_t)key * 64);
#pragma unroll
    for (int c = 0; c < 8; ++c) {
      const uint4 w = kr[c]; const unsigned ww[4] = {w.x, w.y, w.z, w.w};
#pragma unroll
      for (int e = 0; e < 4; ++e) {
        const float k0 = __uint_as_float(ww[e] << 16), k1 = __uint_as_float(ww[e] & 0xffff0000u);
        const int d = c * 8 + e * 2;
        s0 += qs[d] * k0 + qs[d + 1] * k1; s1 += qs[64 + d] * k0 + qs[64 + d + 1] * k1; s2 += qs[128 + d] * k0 + qs[128 + d + 1] * k1;
      }
    }
    const int bk = t5_bucket(t - key);
    s0 += bias[bk * 6 + hb]; s1 += bias[bk * 6 + hb + 1]; s2 += bias[bk * 6 + hb + 2];
  } else { s0 = s1 = s2 = -INFINITY; }
  pb[slot * 64 + lane] = s0; pb[1024 + slot * 64 + lane] = s1; pb[2048 + slot * 64 + lane] = s2;
  mx[0] = fmaxf(mx[0], s0); mx[1] = fmaxf(mx[1], s1); mx[2] = fmaxf(mx[2], s2);
}
__device__ void nsa_item(const P& p, int layer, int item, float* sm) {
  const int tid = threadIdx.x, wave = tid >> 6, lane = tid & 63;
  const int bg = item >> 11, t = ((item & 2047) << 2) + wave, b = bg >> 1, g = bg & 1;
  const size_t r = (size_t)b * T_ + t;
  float* bias = sm;
  float* pb = sm + 192 + wave * 3520;
  float* qs = pb + 3072; float* impb = qs + 192; int* list = (int*)(impb + 128);
  if (tid < 192) bias[tid] = p.rel_bias[tid];
  __syncthreads();
  const bf16_t* HB = (const bf16_t*)(p.ws + OFF_HB);
  const int hb = g * 3;
#pragma unroll
  for (int h = 0; h < 3; ++h) qs[h * 64 + lane] = bf2f(HB[((size_t)(24 + hb + h) * M_ + r) * 64 + lane]);
  WSYNC();
  const float* gates = (const float*)(p.ws + OFF_GATES) + r * 24 + hb * 3;
  float out[3] = {0.f, 0.f, 0.f};
  const int nvis = (t >= 31) ? min((t - 31) / 16 + 1, 511) : 0;
  const float* KC = (const float*)(p.ws + OFF_KC) + (size_t)bg * 512 * 64;
  const float* VC = (const float*)(p.ws + OFF_VC) + (size_t)bg * 512 * 64;
  for (int n = lane; n < 1024; n += 64) { pb[n] = 0.f; pb[1024 + n] = 0.f; pb[2048 + n] = 0.f; }
  WSYNC();
  if (nvis > 0) {
    float mx[3] = {-INFINITY, -INFINITY, -INFINITY};
    for (int n = lane; n < nvis; n += 64) {
      const float* kr = KC + (size_t)n * 64; float s0 = 0.f, s1 = 0.f, s2 = 0.f;
      for (int d = 0; d < 64; ++d) { const float k = kr[d]; s0 += qs[d] * k; s1 += qs[64 + d] * k; s2 += qs[128 + d] * k; }
      const int bk = t5_bucket(t - (16 * n + 31));
      s0 += bias[bk * 6 + hb]; s1 += bias[bk * 6 + hb + 1]; s2 += bias[bk * 6 + hb + 2];
      pb[n] = s0; pb[1024 + n] = s1; pb[2048 + n] = s2;
      mx[0] = fmaxf(mx[0], s0); mx[1] = fmaxf(mx[1], s1); mx[2] = fmaxf(mx[2], s2);
    }
    float sum[3] = {0.f, 0.f, 0.f};
#pragma unroll
    for (int h = 0; h < 3; ++h) mx[h] = wave_max(mx[h]);
    for (int n = lane; n < nvis; n += 64) {
#pragma unroll
      for (int h = 0; h < 3; ++h) { const float e = expf(pb[h * 1024 + n] - mx[h]); pb[h * 1024 + n] = e; sum[h] += e; }
    }
#pragma unroll
    for (int h = 0; h < 3; ++h) sum[h] = 1.f / wave_sum(sum[h]);
    for (int n = lane; n < nvis; n += 64) {
#pragma unroll
      for (int h = 0; h < 3; ++h) pb[h * 1024 + n] *= sum[h];
    }
    WSYNC();
    float oc[3] = {0.f, 0.f, 0.f};
    for (int n = 0; n < nvis; ++n) { const float v = VC[(size_t)n * 64 + lane]; oc[0] += pb[n] * v; oc[1] += pb[1024 + n] * v; oc[2] += pb[2048 + n] * v; }
#pragma unroll
    for (int h = 0; h < 3; ++h) out[h] += gates[h * 3 + 0] * oc[h];
  }
  const int cur = t >> 6;
  {
    float im[2];
#pragma unroll
    for (int u = 0; u < 2; ++u) {
      const int j = lane + 64 * u; float a = 0.f;
#pragma unroll
      for (int h = 0; h < 3; ++h) {
        const float* ph = pb + h * 1024;
        const float pm1 = (j > 0) ? ph[4 * j - 1] : 0.f;
        a += pm1 + 2.f * ph[4 * j] + 2.f * ph[4 * j + 1] + 2.f * ph[4 * j + 2] + ph[4 * j + 3];
      }
      if (j == 0 || j == cur || j == cur - 1) a = 1e9f;
      if (j > cur) a = -1e9f;
      im[u] = a; impb[j] = a;
    }
    WSYNC();
    int rk0 = 0, rk1 = 0;
    for (int jj = 0; jj < 128; ++jj) { const float v = impb[jj];
      rk0 += (v > im[0]) || (v == im[0] && jj < lane); rk1 += (v > im[1]) || (v == im[1] && jj < lane + 64); }
    const bool sel0 = (rk0 < 16) && (lane <= cur), sel1 = (rk1 < 16) && (lane + 64 <= cur);
    const unsigned long long m0 = __ballot(sel0), m1 = __ballot(sel1);
    if (sel0) list[__popcll(m0 & ((1ull << lane) - 1ull))] = lane;
    if (sel1) list[__popcll(m0) + __popcll(m1 & ((1ull << lane) - 1ull))] = lane + 64;
    WSYNC();
    const int nsel = __popcll(m0) + __popcll(m1);
    const bf16_t* Ks = HB + ((size_t)(34 + g) * M_ + (size_t)b * T_) * 64;
    const bf16_t* Vs = HB + ((size_t)(36 + g) * M_ + (size_t)b * T_) * 64;
    float mx[3] = {-INFINITY, -INFINITY, -INFINITY};
    for (int s = 0; s < nsel; ++s) nsa_scores(Ks, list[s] * 64, t, 0, qs, bias, hb, pb, s, lane, mx);
    float sum[3] = {0.f, 0.f, 0.f};
#pragma unroll
    for (int h = 0; h < 3; ++h) mx[h] = wave_max(mx[h]);
    for (int s = 0; s < nsel; ++s) {
#pragma unroll
      for (int h = 0; h < 3; ++h) { const float e = expf(pb[h * 1024 + s * 64 + lane] - mx[h]); pb[h * 1024 + s * 64 + lane] = e; sum[h] += e; }
    }
#pragma unroll
    for (int h = 0; h < 3; ++h) sum[h] = 1.f / wave_sum(sum[h]);
    WSYNC();
    float os[3] = {0.f, 0.f, 0.f};
    for (int s = 0; s < nsel; ++s) {
      const bf16_t* vb = Vs + (size_t)list[s] * 64 * 64;
      for (int k = 0; k < 64; ++k) { const float v = bf2f(vb[k * 64 + lane]); os[0] += pb[s * 64 + k] * v; os[1] += pb[1024 + s * 64 + k] * v; os[2] += pb[2048 + s * 64 + k] * v; }
    }
#pragma unroll
    for (int h = 0; h < 3; ++h) out[h] += gates[h * 3 + 1] * os[h] * sum[h];
    WSYNC();
  }
  {
    const bf16_t* Kw = HB + ((size_t)(38 + g) * M_ + (size_t)b * T_) * 64;
    const bf16_t* Vw = HB + ((size_t)(40 + g) * M_ + (size_t)b * T_) * 64;
    float mx[3] = {-INFINITY, -INFINITY, -INFINITY};
    const int k0 = t - 511;
    for (int s = 0; s < 8; ++s) nsa_scores(Kw, k0 + 64 * s, t, 0, qs, bias, hb, pb, s, lane, mx);
    float sum[3] = {0.f, 0.f, 0.f};
#pragma unroll
    for (int h = 0; h < 3; ++h) mx[h] = wave_max(mx[h]);
    for (int s = 0; s < 8; ++s) {
#pragma unroll
      for (int h = 0; h < 3; ++h) { const float e = expf(pb[h * 1024 + s * 64 + lane] - mx[h]); pb[h * 1024 + s * 64 + lane] = e; sum[h] += e; }
    }
#pragma unroll
    for (int h = 0; h < 3; ++h) sum[h] = 1.f / wave_sum(sum[h]);
    WSYNC();
    float ow[3] = {0.f, 0.f, 0.f};
    for (int kk = 0; kk < 512; ++kk) {
      const int key = k0 + kk; if (key < 0) continue;
      const float v = bf2f(Vw[(size_t)key * 64 + lane]); ow[0] += pb[kk] * v; ow[1] += pb[1024 + kk] * v; ow[2] += pb[2048 + kk] * v;
    }
#pragma unroll
    for (int h = 0; h < 3; ++h) out[h] += gates[h * 3 + 2] * ow[h] * sum[h];
  }
  bf16_t* mix = (bf16_t*)(p.ws + OFF_MIX) + r * D_ + 384 + hb * 64 + lane;
#pragma unroll
  for (int h = 0; h < 3; ++h) mix[h * 64] = f2bf(out[h]);
}
__device__ void ph_mix1(const P& p, int layer, float* sm) {
  for (int item = blockIdx.x; item < 768 + 512 + 512; item += gridDim.x) {
    if (item < 768) ret_kv_item(p, item, sm);
    else if (item < 1280) cmp_item(p, layer, item - 768, sm);
    else gmlp_item(p, layer, item - 1280, sm);
    __syncthreads();
  }
}
__device__ void ph_mix2(const P& p, int layer, float* sm) {
  for (int item = blockIdx.x; item < 768 + 8192; item += gridDim.x) {
    if (item < 768) ret_out_item(p, item, sm);
    else nsa_item(p, layer, item - 768, sm);
    __syncthreads();
  }
}

__global__ void __launch_bounds__(NTHR) k_phase(P p, int phase, int layer) {
  extern __shared__ __attribute__((aligned(16))) float sm[];
  const float* xc = (layer == 0) ? p.x : p.out;
  switch (phase) {
    case 0: ph_init(p); break;
    case 1: ph_rowstat(p, xc); break;
    case 2: ph_gemm<0>(p, layer, xc, nullptr, sm); break;
    case 3: ph_mix1(p, layer, sm); break;
    case 4: ph_scan(p); break;
    case 5: ph_mix2(p, layer, sm); break;
    case 6: ph_gemm<1>(p, layer, xc, p.out, sm); break;
    case 7: ph_rowstat(p, p.out); break;
    case 8: ph_gemm<2>(p, layer, p.out, nullptr, sm); break;
    case 9: ph_gemm<3>(p, layer, p.out, p.out, sm); break;
  }
}

extern "C" void kernel_launch(void* const* d_in, const int* in_sizes, int n_in, void* d_out, int out_size, void* d_ws, size_t ws_size, hipStream_t stream) {
  P p{};
  p.x = (const float*)d_in[0]; p.attn_norm = (const float*)d_in[1]; p.w_in = (const float*)d_in[2]; p.w_out = (const float*)d_in[3];
  p.q_gain = (const float*)d_in[4]; p.k_gain = (const float*)d_in[5]; p.cmp_pe = (const float*)d_in[6]; p.cmp_w1 = (const float*)d_in[7];
  p.cmp_w2 = (const float*)d_in[8]; p.gm_ws = (const float*)d_in[9]; p.gm_b = (const float*)d_in[10]; p.ffn_norm = (const float*)d_in[11];
  p.w_gu = (const float*)d_in[12]; p.w_down = (const float*)d_in[13]; p.rel_bias = (const float*)d_in[14];
  p.out = (float*)d_out; p.ws = (unsigned char*)d_ws;
  constexpr int LDS = 80 * 1024;
  static bool attr = false;
  if (!attr) { (void)hipFuncSetAttribute((const void*)k_phase, hipFuncAttributeMaxDynamicSharedMemorySize, LDS); attr = true; }
  const int grid = 2048;
  hipLaunchKernelGGL(k_phase, dim3(grid), dim3(NTHR), LDS, stream, p, 0, 0);
  for (int layer = 0; layer < 2; ++layer)
    for (int ph = 1; ph <= 9; ++ph) hipLaunchKernelGGL(k_phase, dim3(grid), dim3(NTHR), LDS, stream, p, ph, layer);
}
```

```cpp
#include <hip/hip_runtime.h>
#include <hip/hip_cooperative_groups.h>
#include <stdint.h>
#include <stdio.h>
namespace cg = cooperative_groups;
namespace pg8 {
#define PG8_LAS __attribute__((address_space(3)))
typedef unsigned short bf16_t;
typedef short bf16x8 __attribute__((ext_vector_type(8)));
typedef float f32x4 __attribute__((ext_vector_type(4)));
typedef unsigned u32x4 __attribute__((ext_vector_type(4)));
constexpr int BM = 256, BK = 64, HALF = 128, HTB = HALF * BK * 2  , STAGE_BYTES = 8 * HTB, NXCD = 8, WGM = 8;

__host__ __device__ __forceinline__ int lds_byte(int r, int c) { const int st = (r >> 4) * 2 + (c >> 5), rr = r & 15, cc = c & 31, ob = rr * 64 + cc * 2; return st * 1024 + (ob ^ (((ob >> 9) & 1) << 5)); }
__host__ __device__ __forceinline__ void stage_rc(int b, int& R, int& C) { const int st = b / 1024, sb = b % 1024, swz = sb ^ (((sb >> 9) & 1) << 5); R = (st >> 1) * 16 + swz / 64; C = (st & 1) * 32 + (swz % 64) / 2; }
__host__ __device__ __forceinline__ int perm32(int rho) { const int n = rho >> 4, i = rho & 15; return 8 * (i >> 2) + 4 * n + (i & 3); }

struct Unit { int pm, pn; };
struct Gemm { const bf16_t* A; const bf16_t* Bt; int M, N, K; };

struct StaticOrder {
    int nM, nN, nwg, G, c;
    __host__ __device__ void init(int M, int N, int G_, int c_) { nM = M / BM; nN = N / BM; nwg = nM * nN; G = G_; c = c_; }
    __host__ __device__ bool next(int i, Unit& u) const {
        const long L = (long)i * G + c; if (L >= nwg) return false;
        int wgid = (int)L; { const int q = nwg / NXCD, r = nwg % NXCD, xcd = wgid % NXCD, off = wgid / NXCD; wgid = (xcd < r ? xcd * (q + 1) : r * (q + 1) + (xcd - r) * q) + off; }
        const int nig = WGM * nN, gid = wgid / nig, fm = gid * WGM, gsz = (nM - fm) < WGM ? (nM - fm) : WGM;
        u.pm = fm + ((wgid % nig) % gsz); u.pn = (wgid % nig) / gsz; return true;
    }
    __device__ __forceinline__ void a_ready(const Unit&) const {}
    __device__ __forceinline__ void done(const Unit&) const {}
};

struct OneUnit {
    int pm, pn; bool have;
    __host__ __device__ bool next(int i, Unit& u) const { if (i > 0 || !have) return false; u.pm = pm; u.pn = pn; return true; }
    __device__ __forceinline__ void a_ready(const Unit&) const {}
    __device__ __forceinline__ void done(const Unit&) const {}
};
__device__ __forceinline__ unsigned cvt_pk_bf16(float lo, float hi) { unsigned r; asm volatile("v_cvt_pk_bf16_f32 %0, %1, %2" : "=v"(r) : "v"(lo), "v"(hi)); return r; }
typedef float f32x2 __attribute__((ext_vector_type(2)));
template <class Epi, class Sched, bool ALIGN_EPI = false, bool SP2 = false>
__device__ __forceinline__ void gemm_phase(PG8_LAS unsigned char* lds, const Gemm g, const Sched& S, const Epi& E, const int tid) {
    const int wid = __builtin_amdgcn_readfirstlane(tid >> 6), lane = tid & 63, wr = wid >> 2, wc = wid & 3, fr = lane & 15, fq = lane >> 4;
    const int K = g.K, nt = K / BK;
    unsigned voffA[2], voffB[2];
#pragma unroll
    for (int i = 0; i < 2; ++i) { int R, C; stage_rc(tid * 16 + i * 8192, R, C); const int Rb = Epi::PERM ? ((R & ~31) + perm32(R & 31)) : R;
        voffA[i] = (unsigned)(R * K + C) * 2u; voffB[i] = (unsigned)(Rb * K + C) * 2u; }
    const size_t kstep = (size_t)(BK * 2);
    const size_t hstep = (size_t)HALF * K * 2;
    const size_t tstep = 2 * hstep;
    const unsigned ldsw = (unsigned)wid * 1024u;
    const int aoff = lds_byte(wr * 64 + fr, fq * 8), boff = lds_byte(wc * 32 + fr, fq * 8);
#define PG8_SA(b, h) (((b) * 2 + (h)) * HTB)
#define PG8_SB(b, h) ((4 + (b) * 2 + (h)) * HTB)
#define PG8_STAGE(bufoff, gbase, voff) do { _Pragma("unroll") for (int _i = 0; _i < 2; ++_i) \
        __builtin_amdgcn_global_load_lds((const unsigned*)((const char*)(gbase) + (voff)[_i]), (PG8_LAS unsigned*)(lds + (bufoff) + ldsw + _i * 8192), 16, 0, 0); } while (0)
#define PG8_LDA(dst, b, h) do { _Pragma("unroll") for (int m = 0; m < 4; ++m) _Pragma("unroll") for (int k = 0; k < 2; ++k) dst[m][k] = *(const PG8_LAS bf16x8*)(lds + PG8_SA(b, h) + aoff + m * 2048 + k * 1024); } while (0)
#define PG8_LDB(dst, b, h) do { _Pragma("unroll") for (int n = 0; n < 2; ++n) _Pragma("unroll") for (int k = 0; k < 2; ++k) dst[n][k] = *(const PG8_LAS bf16x8*)(lds + PG8_SB(b, h) + boff + n * 2048 + k * 1024); } while (0)
#define PG8_MMA(ai, bj, At, Bt) do { __builtin_amdgcn_s_setprio(1); _Pragma("unroll") for (int m = 0; m < 4; ++m) _Pragma("unroll") for (int n = 0; n < 2; ++n) _Pragma("unroll") for (int k = 0; k < 2; ++k) \
        acc[ai][bj][m][n] = __builtin_amdgcn_mfma_f32_16x16x32_bf16(Bt[n][k], At[m][k], acc[ai][bj][m][n], 0, 0, 0); __builtin_amdgcn_s_setprio(0); } while (0)
#define PG8_WAIT_V(n) asm volatile("s_waitcnt vmcnt(" #n ")" ::: "memory")
#define PG8_WAIT_L(n) asm volatile("s_waitcnt lgkmcnt(" #n ")" ::: "memory")
#define PG8_BAR __builtin_amdgcn_s_barrier()
#define PG8_SCHED __builtin_amdgcn_sched_barrier(0)
    Unit cur, nxt; int ui = 0;
    if (!S.next(0, cur)) return;
    f32x4 acc[2][2][4][2];
#pragma unroll
    for (int a = 0; a < 2; ++a)
#pragma unroll
        for (int b = 0; b < 2; ++b)
#pragma unroll
            for (int m = 0; m < 4; ++m)
#pragma unroll
                for (int n = 0; n < 2; ++n) acc[a][b][m][n] = (f32x4){0.f, 0.f, 0.f, 0.f};
    bf16x8 At[4][2], B0[2][2], B1[2][2];
    const char* cA = (const char*)g.A + (size_t)cur.pm * tstep; const char* cB = (const char*)g.Bt + (size_t)cur.pn * tstep;
    S.a_ready(cur);
    if constexpr (SP2) {
        PG8_STAGE(PG8_SB(0, 0), cB, voffB); PG8_STAGE(PG8_SB(0, 1), cB + hstep, voffB); PG8_STAGE(PG8_SA(0, 0), cA, voffA); PG8_STAGE(PG8_SA(0, 1), cA + hstep, voffA);
        if (wr == 1) PG8_BAR;
        PG8_WAIT_V(2); PG8_BAR;
        PG8_STAGE(PG8_SB(1, 0), cB + kstep, voffB); PG8_STAGE(PG8_SA(1, 0), cA + kstep, voffA); PG8_STAGE(PG8_SB(1, 1), cB + hstep + kstep, voffB);
        PG8_WAIT_V(6); PG8_BAR;
    } else {
        PG8_STAGE(PG8_SB(0, 0), cB, voffB); PG8_STAGE(PG8_SA(0, 0), cA, voffA); PG8_STAGE(PG8_SB(0, 1), cB + hstep, voffB); PG8_STAGE(PG8_SA(0, 1), cA + hstep, voffA);
        if (wr == 1) PG8_BAR;
        PG8_WAIT_V(4); PG8_BAR;
        PG8_STAGE(PG8_SB(1, 0), cB + kstep, voffB); PG8_STAGE(PG8_SA(1, 0), cA + kstep, voffA); PG8_STAGE(PG8_SB(1, 1), cB + hstep + kstep, voffB);
        PG8_WAIT_V(6); PG8_BAR;
    }
    for (;;) {
        const bool has_next = S.next(ui + 1, nxt);
        const char* nA = has_next ? (const char*)g.A + (size_t)nxt.pm * tstep : cA; const char* nB = has_next ? (const char*)g.Bt + (size_t)nxt.pn * tstep : cB;
        for (int t = 0; t < nt; t += 2) {
            const bool last = (t == nt - 2);
            const char* a1 = cA + (size_t)(t + 1) * kstep;
            const char* a2 = last ? nA : cA + (size_t)(t + 2) * kstep; const char* b2 = last ? nB : cB + (size_t)(t + 2) * kstep;
            const char* a3 = a2 + kstep; const char* b3 = b2 + kstep;
            if (last && has_next) S.a_ready(nxt);
            if constexpr (SP2) {
            PG8_LDB(B0, 0, 0); PG8_LDB(B1, 0, 1); PG8_SCHED; PG8_LDA(At, 0, 0); PG8_STAGE(PG8_SA(1, 1), a1 + hstep, voffA);
            PG8_WAIT_V(8); PG8_WAIT_L(0); PG8_BAR; PG8_MMA(0, 0, At, B0); PG8_MMA(0, 1, At, B1); PG8_BAR; PG8_SCHED;
            PG8_LDA(At, 0, 1); PG8_STAGE(PG8_SB(0, 0), b2, voffB); PG8_STAGE(PG8_SB(0, 1), b2 + hstep, voffB); PG8_STAGE(PG8_SA(0, 0), a2, voffA);
            PG8_WAIT_V(8); PG8_WAIT_L(0); PG8_BAR; PG8_MMA(1, 0, At, B0); PG8_MMA(1, 1, At, B1); PG8_BAR; PG8_SCHED;
            PG8_LDB(B0, 1, 0); PG8_LDB(B1, 1, 1); PG8_SCHED; PG8_LDA(At, 1, 0); PG8_STAGE(PG8_SA(0, 1), a2 + hstep, voffA);
            PG8_WAIT_V(8); PG8_WAIT_L(0); PG8_BAR; PG8_MMA(0, 0, At, B0); PG8_MMA(0, 1, At, B1); PG8_BAR; PG8_SCHED;
            PG8_LDA(At, 1, 1); PG8_STAGE(PG8_SB(1, 0), b3, voffB); PG8_STAGE(PG8_SB(1, 1), b3 + hstep, voffB); PG8_STAGE(PG8_SA(1, 0), a3, voffA);
            PG8_WAIT_V(8); PG8_WAIT_L(0); PG8_BAR; PG8_MMA(1, 0, At, B0); PG8_MMA(1, 1, At, B1); PG8_BAR; PG8_SCHED;
            } else {
            PG8_LDB(B0, 0, 0); PG8_SCHED; PG8_LDA(At, 0, 0); PG8_STAGE(PG8_SA(1, 1), a1 + hstep, voffA);
            PG8_WAIT_L(8); PG8_BAR; PG8_WAIT_L(0); PG8_MMA(0, 0, At, B0); PG8_BAR; PG8_SCHED;
            PG8_LDB(B1, 0, 1); PG8_STAGE(PG8_SB(0, 0), b2, voffB);
            PG8_BAR; PG8_WAIT_L(0); PG8_MMA(0, 1, At, B1); PG8_BAR;
            PG8_LDA(At, 0, 1); PG8_STAGE(PG8_SA(0, 0), a2, voffA);
            PG8_BAR; PG8_WAIT_L(0); PG8_MMA(1, 0, At, B0); PG8_BAR; PG8_SCHED;
            PG8_STAGE(PG8_SB(0, 1), b2 + hstep, voffB);
            PG8_WAIT_V(6); PG8_BAR; PG8_MMA(1, 1, At, B1); PG8_BAR;
            PG8_LDB(B0, 1, 0); PG8_SCHED; PG8_LDA(At, 1, 0); PG8_STAGE(PG8_SA(0, 1), a2 + hstep, voffA);
            PG8_WAIT_L(8); PG8_BAR; PG8_WAIT_L(0); PG8_MMA(0, 0, At, B0); PG8_BAR; PG8_SCHED;
            PG8_LDB(B1, 1, 1); PG8_STAGE(PG8_SB(1, 0), b3, voffB);
            PG8_BAR; PG8_WAIT_L(0); PG8_MMA(0, 1, At, B1); PG8_BAR;
            PG8_LDA(At, 1, 1); PG8_STAGE(PG8_SA(1, 0), a3, voffA);
            PG8_BAR; PG8_WAIT_L(0); PG8_MMA(1, 0, At, B0); PG8_BAR; PG8_SCHED;
            PG8_STAGE(PG8_SB(1, 1), b3 + hstep, voffB);
            PG8_WAIT_V(6); PG8_BAR; PG8_MMA(1, 1, At, B1); PG8_BAR;
            }
        }
        if constexpr (ALIGN_EPI) { if (wr == 0) PG8_BAR; }
        if constexpr (!Epi::AFTER_DRAIN) { E(acc, cur, wr, wc, fr, fq); S.done(cur); }
        if (!has_next) break;
#pragma unroll
        for (int a = 0; a < 2; ++a)
#pragma unroll
            for (int b = 0; b < 2; ++b)
#pragma unroll
                for (int m = 0; m < 4; ++m)
#pragma unroll
                    for (int n = 0; n < 2; ++n) acc[a][b][m][n] = (f32x4){0.f, 0.f, 0.f, 0.f};
        cur = nxt; cA = nA; cB = nB; ++ui;
        if constexpr (ALIGN_EPI) { if (wr == 1) PG8_BAR; }
    }
    PG8_WAIT_V(0);
    if constexpr (!ALIGN_EPI) { if (wr == 0) PG8_BAR; }
    PG8_BAR;
    if constexpr (Epi::AFTER_DRAIN) { E.fused(acc, cur, wr, wc, fr, fq, lds, wid, lane); S.done(cur); }
#undef PG8_SA
#undef PG8_SB
#undef PG8_STAGE
#undef PG8_LDA
#undef PG8_LDB
#undef PG8_MMA
#undef PG8_WAIT_V
#undef PG8_WAIT_L
#undef PG8_BAR
#undef PG8_SCHED
}
}

#ifndef PG8_SP2
#define PG8_SP2 true
#endif
#ifndef PG8_ALIGN
#define PG8_ALIGN true
#endif

typedef unsigned short bf16_t;
typedef float f32x4 __attribute__((ext_vector_type(4)));
typedef unsigned u32x4 __attribute__((ext_vector_type(4)));
#define LAS __attribute__((address_space(3)))

#define T_ 8192
#define M_ 16384
#define D_ 1024
#define INW 3218
#define NPROJ 3328
#define DFF 2816
#define EPS 1e-6f
#define NTHR 512

struct Cx { int tid, bid, G, wv; };
__device__ __forceinline__ int lane_id() { int l; asm volatile("v_mbcnt_lo_u32_b32 %0, -1, 0\n\tv_mbcnt_hi_u32_b32 %0, -1, %0" : "=v"(l)); return l; }
struct P {
  const float *x, *attn_norm, *w_in, *w_out, *q_gain, *k_gain, *cmp_pe, *cmp_w1, *cmp_w2, *gm_ws, *gm_b, *ffn_norm, *w_gu, *w_down, *rel_bias;
  float* out; unsigned char* ws;
};

constexpr size_t MiB = 1u << 20;
constexpr size_t OFF_HB = 0;
constexpr size_t OFF_ACT = 0;
constexpr size_t OFF_MIX = 100 * MiB;
constexpr size_t OFF_GATES = 132 * MiB;
constexpr size_t OFF_KC = 134 * MiB;
constexpr size_t OFF_VC = 134 * MiB + 512 * 1024;
constexpr size_t OFF_RS = 135 * MiB;
constexpr size_t OFF_ROPE = 148 * MiB;
constexpr size_t OFF_WIN = 152 * MiB;
constexpr size_t OFF_WO = 165 * MiB;
constexpr size_t OFF_WGU = 169 * MiB;
constexpr size_t OFF_WD = 191 * MiB;
constexpr size_t OFF_XB = 204 * MiB;
constexpr size_t OFF_SSQ = 236 * MiB;
constexpr size_t OFF_SELQ = 237 * MiB;
constexpr size_t OFF_CTR = 238 * MiB;
constexpr size_t OFF_BAR = 238 * MiB + 65536;
constexpr size_t OFF_RT = 239 * MiB;
constexpr size_t OFF_W1T = 245 * MiB;
constexpr size_t OFF_C1 = 246 * MiB;
constexpr size_t OFF_WSB = 246 * MiB + 65536;
constexpr size_t OFF_BTAB = 247 * MiB;

constexpr int LDS_BYTES = 147456;

__device__ __forceinline__ float bf2f(bf16_t v) { return __uint_as_float(((unsigned)v) << 16); }
__device__ __forceinline__ bf16_t f2bf(float f) { unsigned u = __float_as_uint(f); u += 0x7fffu + ((u >> 16) & 1u); return (bf16_t)(u >> 16); }
__device__ __forceinline__ unsigned pk2(float lo, float hi) { unsigned r; asm("v_cvt_pk_bf16_f32 %0, %1, %2" : "=v"(r) : "v"(lo), "v"(hi)); return r; }
__device__ __forceinline__ float gelu_tanh(float x) { const float y = -2.3022082f * (x + 0.044715f * x * x * x); return x * __builtin_amdgcn_rcpf(1.f + __builtin_amdgcn_exp2f(y)); }
__device__ __forceinline__ float sigmoidf(float x) { return __builtin_amdgcn_rcpf(1.f + __builtin_amdgcn_exp2f(-1.4426950408889634f * x)); }
#define rsqrtf(x) __builtin_amdgcn_rsqf(x)
__device__ __forceinline__ float wave_sum(float v) {
#pragma unroll
  for (int o = 1; o < 64; o <<= 1) v += __shfl_xor(v, o);
  return v;
}
__device__ __forceinline__ float wave_max(float v) {
#pragma unroll
  for (int o = 1; o < 64; o <<= 1) v = fmaxf(v, __shfl_xor(v, o));
  return v;
}
__device__ __forceinline__ int t5_bucket(int n) {
  if (n < 16) return n;
  int b = 16;
  b += (n >= 19); b += (n >= 21); b += (n >= 24); b += (n >= 27); b += (n >= 31); b += (n >= 35); b += (n >= 40); b += (n >= 46);
  b += (n >= 52); b += (n >= 59); b += (n >= 67); b += (n >= 77); b += (n >= 87); b += (n >= 99); b += (n >= 113);
  return b;
}
#define WSYNC() do { __builtin_amdgcn_fence(__ATOMIC_RELEASE, "wavefront"); __builtin_amdgcn_wave_barrier(); __builtin_amdgcn_fence(__ATOMIC_ACQUIRE, "wavefront"); } while (0)

__device__ __forceinline__ int proj_col0(int g) { return (g < 42) ? 64 * g : 2706 + 64 * (g - 42); }
__device__ __forceinline__ float row_rstd(const float* ssq, int row, int fq) {
  const f32x4 s = *(const f32x4*)(ssq + (size_t)row * 16 + 4 * fq);
  float t = (s[0] + s[1]) + (s[2] + s[3]);
  t += __shfl_xor(t, 16); t += __shfl_xor(t, 32);
  return rsqrtf(t * (1.f / D_) + EPS);
}
struct EpiProj {
  static constexpr bool PERM = true, AFTER_DRAIN = false;
  const float* ssq; bf16_t* HB; float* gates; const float2* rope; const float* q_gain; const float* k_gain;
  __device__ __forceinline__ void operator()(const f32x4 (&acc)[2][2][4][2], const pg8::Unit& u, int wr, int wc, int fr, int fq) const {
    const int gidx = u.pn * 4 + wc;
    if (gidx > 50) return;
    int type; float sc = 1.f; const float* gn = nullptr;
    float dec_l2 = 0.f;
    if (gidx < 12) { type = 0; sc = (gidx >= 6) ? 0.125f : 1.f; const float lg2 = log2f(1.f - exp2f(-5.f - (float)(gidx % 6))); dec_l2 = (gidx >= 6) ? -lg2 : lg2; }
    else if (gidx < 24) type = 1;
    else if (gidx < 30) { type = 2; gn = q_gain; sc = 0.125f * 1.4426950408889634f; }
    else if (gidx == 34 || gidx == 35) { type = 2; gn = k_gain + 64; }
    else if (gidx == 38 || gidx == 39) { type = 2; gn = k_gain + 128; }
    else if (gidx < 42) type = 1;
    else if (gidx < 46) type = 3;
    else if (gidx < 50) type = 4;
    else type = 5;
    float gv[2][8];
#pragma unroll
    for (int bj = 0; bj < 2; ++bj)
#pragma unroll
      for (int i = 0; i < 8; ++i) gv[bj][i] = (type == 2) ? gn[32 * bj + 8 * fq + i] * sc : 1.f;
#pragma unroll
    for (int ai = 0; ai < 2; ++ai)
#pragma unroll
      for (int m = 0; m < 4; ++m) {
        const int row = u.pm * 256 + ai * 128 + wr * 64 + m * 16 + fr;
        const float rstd = row_rstd(ssq, row, fq);
        float v[2][8];
#pragma unroll
        for (int bj = 0; bj < 2; ++bj)
#pragma unroll
          for (int n = 0; n < 2; ++n)
#pragma unroll
            for (int e = 0; e < 4; ++e) v[bj][4 * n + e] = acc[ai][bj][m][n][e] * rstd;
        if (type == 0) {
          const float2* tb = rope + (size_t)(row & (T_ - 1)) * 32 + 8 * fq;
          const float scr = sc * exp2f((float)(row & 127) * dec_l2);
#pragma unroll
          for (int i = 0; i < 8; ++i) { const float2 cs = tb[i]; const float x1 = v[0][i], x2 = v[1][i]; v[0][i] = (x1 * cs.x - x2 * cs.y) * scr; v[1][i] = (x2 * cs.x + x1 * cs.y) * scr; }
        }
        if (type == 3 || type == 4) {
#pragma unroll
          for (int bj = 0; bj < 2; ++bj)
#pragma unroll
            for (int i = 0; i < 8; ++i) v[bj][i] = gelu_tanh(v[bj][i]);
        }
        if (type == 2 || type == 4) {
          float ss = 0.f;
#pragma unroll
          for (int bj = 0; bj < 2; ++bj)
#pragma unroll
            for (int i = 0; i < 8; ++i) ss += v[bj][i] * v[bj][i];
          ss += __shfl_xor(ss, 16); ss += __shfl_xor(ss, 32);
          const float rs = rsqrtf(ss * (1.f / 64.f) + EPS);
#pragma unroll
          for (int bj = 0; bj < 2; ++bj)
#pragma unroll
            for (int i = 0; i < 8; ++i) v[bj][i] = v[bj][i] * rs * gv[bj][i];
        }
        if (type == 5) {
          float* gp = gates + (size_t)row * 24 + 8 * fq;
#pragma unroll
          for (int i = 0; i < 8; ++i) if (8 * fq + i < 18) gp[i] = sigmoidf(v[0][i]);
        } else {
          bf16_t* dst = HB + ((size_t)gidx * M_ + row) * 64 + 8 * fq;
#pragma unroll
          for (int bj = 0; bj < 2; ++bj) { u32x4 w; w.x = pk2(v[bj][0], v[bj][1]); w.y = pk2(v[bj][2], v[bj][3]); w.z = pk2(v[bj][4], v[bj][5]); w.w = pk2(v[bj][6], v[bj][7]); *(u32x4*)(dst + 32 * bj) = w; }
        }
      }
  }
};
struct EpiRes {
  static constexpr bool PERM = true, AFTER_DRAIN = false;
  const float* xin32; float* xout32; bf16_t* xb; float* ssq;
  __device__ __forceinline__ void operator()(const f32x4 (&acc)[2][2][4][2], const pg8::Unit& u, int wr, int wc, int fr, int fq) const {
#pragma unroll
    for (int ai = 0; ai < 2; ++ai)
#pragma unroll
      for (int m = 0; m < 4; ++m) {
        const int row = u.pm * 256 + ai * 128 + wr * 64 + m * 16 + fr;
        float ss = 0.f;
#pragma unroll
        for (int bj = 0; bj < 2; ++bj) {
          const size_t o = (size_t)row * D_ + u.pn * 256 + bj * 128 + wc * 32 + 8 * fq;
          f32x4 x0, x1;
          if (xin32) { x0 = *(const f32x4*)(xin32 + o); x1 = *(const f32x4*)(xin32 + o + 4); }
          else { const u32x4 w = *(const u32x4*)(xb + o); x0 = (f32x4){__uint_as_float(w.x << 16), __uint_as_float(w.x & 0xffff0000u), __uint_as_float(w.y << 16), __uint_as_float(w.y & 0xffff0000u)};
                 x1 = (f32x4){__uint_as_float(w.z << 16), __uint_as_float(w.z & 0xffff0000u), __uint_as_float(w.w << 16), __uint_as_float(w.w & 0xffff0000u)}; }
          const f32x4 y0 = x0 + acc[ai][bj][m][0], y1 = x1 + acc[ai][bj][m][1];
          if (xout32) { *(f32x4*)(xout32 + o) = y0; *(f32x4*)(xout32 + o + 4) = y1; }
          else { u32x4 w; w.x = pk2(y0[0], y0[1]); w.y = pk2(y0[2], y0[3]); w.z = pk2(y1[0], y1[1]); w.w = pk2(y1[2], y1[3]); *(u32x4*)(xb + o) = w;
            ss += (y0[0] * y0[0] + y0[1] * y0[1]) + (y0[2] * y0[2] + y0[3] * y0[3]) + (y1[0] * y1[0] + y1[1] * y1[1]) + (y1[2] * y1[2] + y1[3] * y1[3]); }
        }
        if (!xout32) { ss += __shfl_xor(ss, 16); ss += __shfl_xor(ss, 32);
          if (fq == 0) ssq[(size_t)row * 16 + u.pn * 4 + wc] = ss; }
      }
  }
};
struct EpiGU {
  static constexpr bool PERM = true, AFTER_DRAIN = false;
  const float* ssq; bf16_t* act;
  __device__ __forceinline__ void operator()(const f32x4 (&acc)[2][2][4][2], const pg8::Unit& u, int wr, int wc, int fr, int fq) const {
#pragma unroll
    for (int ai = 0; ai < 2; ++ai)
#pragma unroll
      for (int m = 0; m < 4; ++m) {
        const int row = u.pm * 256 + ai * 128 + wr * 64 + m * 16 + fr;
        const float rstd = row_rstd(ssq, row, fq);
        float a[8];
#pragma unroll
        for (int n = 0; n < 2; ++n)
#pragma unroll
          for (int e = 0; e < 4; ++e) { const float g = acc[ai][0][m][n][e] * rstd, up = acc[ai][1][m][n][e] * rstd; a[4 * n + e] = g * sigmoidf(g) * up; }
        u32x4 w; w.x = pk2(a[0], a[1]); w.y = pk2(a[2], a[3]); w.z = pk2(a[4], a[5]); w.w = pk2(a[6], a[7]);
        *(u32x4*)(act + (size_t)row * DFF + u.pn * 128 + wc * 32 + 8 * fq) = w;
      }
  }
};

__device__ __forceinline__ void transpose_item(const float* W, int K, int ldw, const float* gain, bf16_t* WT, int v0, int src0, int nvalid, int k0, LAS float* scr, int lane) {
  const int col = lane & 31;
  float wv[32];
#pragma unroll
  for (int i = 0; i < 32; ++i) { const int kk = 2 * i + (lane >> 5); wv[i] = (col < nvalid) ? W[(size_t)(k0 + kk) * ldw + src0 + col] : 0.f; }
#pragma unroll
  for (int i = 0; i < 32; ++i) { const int kk = 2 * i + (lane >> 5); scr[kk * 33 + col] = gain ? wv[i] * gain[k0 + kk] : wv[i]; }
  asm volatile("s_waitcnt lgkmcnt(0)" ::: "memory");
  const int c = lane & 7;
#pragma unroll
  for (int j = 0; j < 4; ++j) { const int n = (lane >> 3) + 8 * j; const LAS float* s = scr + (8 * c) * 33 + n;
    u32x4 o; o.x = pk2(s[0 * 33], s[1 * 33]); o.y = pk2(s[2 * 33], s[3 * 33]); o.z = pk2(s[4 * 33], s[5 * 33]); o.w = pk2(s[6 * 33], s[7 * 33]);
    *(u32x4*)(WT + (size_t)(v0 + n) * K + k0 + 8 * c) = o; }
  asm volatile("s_waitcnt lgkmcnt(0)" ::: "memory");
}
__device__ __forceinline__ void convert_weights(const P& p, LAS unsigned char* lds, int wave, int lane, int gw, int NGW, int it0, int it1) {
  LAS float* scr = (LAS float*)(lds + wave * 16384);
  for (int it = it0 + gw; it < it1; it += NGW) {
    const int layer = it / 6400; int r = it % 6400;
    if (r < 1664) {
      const int vb = r >> 4, kb = r & 15, v0 = vb * 32, pn = v0 >> 8, bj = (v0 >> 7) & 1, wc = (v0 >> 5) & 3, g = pn * 4 + wc;
      int src0 = 0, nvalid = 32;
      if (g < 50) src0 = proj_col0(g) + 32 * bj; else if (g == 50 && bj == 0) { src0 = 2688; nvalid = 18; } else nvalid = 0;
      transpose_item(p.w_in + (size_t)layer * D_ * INW, D_, INW, p.attn_norm + layer * D_, (bf16_t*)(p.ws + OFF_WIN) + (size_t)layer * NPROJ * D_, v0, src0, nvalid, kb * 64, scr, lane);
      continue;
    }
    r -= 1664;
    if (r < 512) { const int vb = r >> 4, kb = r & 15;
      transpose_item(p.w_out + (size_t)layer * D_ * D_, D_, D_, nullptr, (bf16_t*)(p.ws + OFF_WO) + (size_t)layer * D_ * D_, vb * 32, vb * 32, 32, kb * 64, scr, lane); continue; }
    r -= 512;
    if (r < 2816) { const int vb = r >> 4, kb = r & 15, v0 = vb * 32, pn = v0 >> 8, bj = (v0 >> 7) & 1, c0 = v0 & 127;
      transpose_item(p.w_gu + (size_t)layer * D_ * 2 * DFF, D_, 2 * DFF, p.ffn_norm + layer * D_, (bf16_t*)(p.ws + OFF_WGU) + (size_t)layer * 2 * DFF * D_, v0, bj * DFF + 128 * pn + c0, 32, kb * 64, scr, lane); continue; }
    r -= 2816;
    { const int vb = r / 44, kb = r % 44;
      transpose_item(p.w_down + (size_t)layer * DFF * D_, DFF, D_, nullptr, (bf16_t*)(p.ws + OFF_WD) + (size_t)layer * D_ * DFF, vb * 32, vb * 32, 32, kb * 64, scr, lane); }
  }
}
__device__ __forceinline__ void ph_prologue(const Cx& cx, const P& p, LAS unsigned char* lds) {
  const int tid = cx.tid, lane = tid & 63, wave = tid >> 6;
  LAS float* scr = (LAS float*)(lds + wave * 16384);
  const int gw = cx.bid * 8 + wave, NGW = cx.G * 8;
  convert_weights(p, lds, wave, lane, gw, NGW, 0, 1664);
  bf16_t* XB = (bf16_t*)(p.ws + OFF_XB); float* ssq = (float*)(p.ws + OFF_SSQ);
  for (int r = gw; r < M_; r += 2 * NGW) {
    const int r2 = r + NGW;
    const f32x4* xa = (const f32x4*)(p.x + (size_t)r * D_); const f32x4* xb2 = (const f32x4*)(p.x + (size_t)((r2 < M_) ? r2 : r) * D_);
    f32x4 va[4], vb[4];
#pragma unroll
    for (int j = 0; j < 4; ++j) { va[j] = xa[lane + 64 * j]; vb[j] = xb2[lane + 64 * j]; }
    float sa = 0.f, sb = 0.f;
#pragma unroll
    for (int j = 0; j < 4; ++j) { sa += (va[j][0] * va[j][0] + va[j][1] * va[j][1]) + (va[j][2] * va[j][2] + va[j][3] * va[j][3]); sb += (vb[j][0] * vb[j][0] + vb[j][1] * vb[j][1]) + (vb[j][2] * vb[j][2] + vb[j][3] * vb[j][3]);
      *(uint2*)(XB + (size_t)r * D_ + (lane + 64 * j) * 4) = make_uint2(pk2(va[j][0], va[j][1]), pk2(va[j][2], va[j][3]));
      if (r2 < M_) *(uint2*)(XB + (size_t)r2 * D_ + (lane + 64 * j) * 4) = make_uint2(pk2(vb[j][0], vb[j][1]), pk2(vb[j][2], vb[j][3])); }
    sa = wave_sum(sa); sb = wave_sum(sb);
    if (lane < 16) { ssq[(size_t)r * 16 + lane] = (lane == 0) ? sa : 0.f; if (r2 < M_) ssq[(size_t)r2 * 16 + lane] = (lane == 0) ? sb : 0.f; }
  }
  if (cx.bid == 0 && tid < 128) ((unsigned*)(p.ws + OFF_CTR))[tid] = 0u;
  for (int it = gw; it < 256; it += NGW) { const int mj = it >> 6, vb = (it >> 5) & 1, kb = it & 31;
    transpose_item(p.cmp_w1 + (size_t)mj * 2048 * 64, 2048, 64, nullptr, (bf16_t*)(p.ws + OFF_W1T) + (size_t)mj * 64 * 2048, vb * 32, vb * 32, 32, kb * 64, scr, lane); }
  for (int it = gw; it < 256; it += NGW) { const int mj = it >> 6, f = it & 63; const float* w1 = p.cmp_w1 + (size_t)mj * 2048 * 64 + f; const float* pe = p.cmp_pe + (size_t)mj * 2048;
    float a = 0.f; for (int i = lane; i < 2048; i += 64) a += pe[i] * w1[(size_t)i * 64];
    a = wave_sum(a); if (lane == 0) ((float*)(p.ws + OFF_C1))[it] = a; }
  for (int i = cx.bid * NTHR + tid; i < 6 * 768; i += cx.G * NTHR) { const int hd = i / 768, k = i % 768; float v = 0.f;
    if (k < 115) v = (k == 0) ? -1e30f : p.rel_bias[t5_bucket(k - 1) * 6 + hd] * 1.4426950408889634f;
    else if (k >= 128 && k < 642) { const int kk = k - 128; v = (kk == 0 || kk == 513) ? -1e30f : p.rel_bias[t5_bucket(kk - 1) * 6 + hd] * 1.4426950408889634f; }
    ((float*)(p.ws + OFF_BTAB))[i] = v; }
  for (int i = cx.bid * NTHR + tid; i < 2 * 4 * 128 * 128; i += cx.G * NTHR) { const int tt = (i >> 7) & 127, ss = i & 127; ((bf16_t*)(p.ws + OFF_WSB))[i] = (ss <= tt) ? f2bf(p.gm_ws[i]) : (bf16_t)0; }
  float2* tab = (float2*)(p.ws + OFF_ROPE);
  for (int i = cx.bid * NTHR + tid; i < T_ * 32; i += cx.G * NTHR) {
    const int t = i >> 5, k = i & 31;
    const float inv = powf(10000.0f, -(float)k / 32.0f);
    const float ang = (float)t * inv;
    tab[i] = make_float2(cosf(ang), sinf(ang));
  }
}
namespace att {
using bf16x8 = __attribute__((ext_vector_type(8))) short;
using s16x4 = __attribute__((ext_vector_type(4))) short;
using f32x16 = __attribute__((ext_vector_type(16))) float;
constexpr int NW = 8, QBLK = 32, QB = 256, KVBLK = 64;
constexpr int SLOTB = 8192, LDS_K = 0, LDS_V = 3 * SLOTB, LDS_WS = 6 * SLOTB, LDS_OST = LDS_WS + NW * 256, LDS_TAB = LDS_OST + NW * 8192, LDS_SELW = LDS_TAB + 2304, LDS_END = LDS_SELW + NW * 512;
static_assert(LDS_END <= 131072, "attention LDS");
constexpr float NEGBIG = -1e30f;
#define SBAR() __builtin_amdgcn_sched_barrier(0)
#define PIN(x) asm volatile("" : "+v"(x))
#define MFMA(a, b, c) __builtin_amdgcn_mfma_f32_32x32x16_bf16(a, b, c, 0, 0, 0)
#define WAIT_BAR(N) asm volatile("s_waitcnt vmcnt(" #N ") lgkmcnt(0)\n\ts_barrier" ::: "memory")
__device__ __forceinline__ int crow(int r, int hi) { return (r & 3) + 8 * (r >> 2) + 4 * hi; }
__device__ __forceinline__ unsigned cvtpk(float lo, float hi) { unsigned r; asm("v_cvt_pk_bf16_f32 %0, %1, %2" : "=v"(r) : "v"(lo), "v"(hi)); return r; }
__device__ __forceinline__ void glds16(const void* g, unsigned lds_base) {
  unsigned sv; asm volatile("s_mov_b32 %0, m0\n\ts_mov_b32 m0, %2\n\ts_nop 0\n\tglobal_load_lds_dwordx4 %1, off\n\ts_mov_b32 m0, %0" : "=&s"(sv) : "v"(g), "s"(lds_base) : "memory"); }
typedef __attribute__((address_space(3))) const char* lds_cptr;
typedef short v4i16_t __attribute__((ext_vector_type(4)));
__device__ __forceinline__ void kload2(bf16x8* kf, lds_cptr kp, int d0) { kf[2 * d0] = *(const __attribute__((address_space(3))) bf16x8*)(kp + d0 * 2048); kf[2 * d0 + 1] = *(const __attribute__((address_space(3))) bf16x8*)(kp + d0 * 2048 + 512); }
__device__ __forceinline__ s16x4 vtr(lds_cptr p) { return __builtin_bit_cast(s16x4, __builtin_amdgcn_ds_read_tr16_b64_v4i16((__attribute__((address_space(3))) v4i16_t*)p)); }
#define MX3(a, b, c) __builtin_fmaxf(__builtin_fmaxf((a), (b)), (c))
__device__ __forceinline__ float rowmax(const f32x16& p0, const f32x16& p1) {
  float a = MX3(p0[0], p0[1], p1[0]), b = MX3(p0[2], p0[3], p1[1]); a = MX3(a, p1[2], p1[3]);
#pragma unroll
  for (int r = 4; r < 16; r += 4) { a = MX3(a, p0[r], p0[r + 1]); b = MX3(b, p0[r + 2], p0[r + 3]); a = MX3(a, p1[r], p1[r + 1]); b = MX3(b, p1[r + 2], p1[r + 3]); }
  float m = __builtin_fmaxf(a, b); auto rr = __builtin_amdgcn_permlane32_swap(__float_as_uint(m), __float_as_uint(m), false, false);
  return __builtin_fmaxf(__uint_as_float(rr[0]), __uint_as_float(rr[1])); }
template <int S, int IMAX>
__device__ __forceinline__ void bias_hook(f32x16& p0, f32x16& p1, int dl, const __attribute__((address_space(3))) float* tab) {
#pragma unroll
  for (int r = 0; r < 16; ++r) { const int c = (r & 3) + 8 * (r >> 2); const int d0 = dl - S * c, d1 = d0 - 32 * S;
    p0[r] += tab[1 + min(max(d0, -1), IMAX)]; p1[r] += tab[1 + min(max(d1, -1), IMAX)]; } }

template <int MODE>
__device__ __forceinline__ void nsa_pass(const int tid, const bf16_t* Qrows, const bf16_t* __restrict__ Kt0, const bf16_t* __restrict__ Vt0, const int NT, const int dq, const float b31,
                                         const float* gate, char* lds, const bool first) {
  constexpr int S = (MODE == 2) ? 16 : 1, IMAX = (MODE == 1) ? 512 : 113; constexpr float REF = 8.f;
  const int lane = tid & 63, r32 = lane & 31, hi = lane >> 5; const int wid = __builtin_amdgcn_readfirstlane(tid >> 6);
  const bf16_t* Qw = Qrows + (size_t)(wid * QBLK) * 64;
  const unsigned lds0 = (unsigned)(uintptr_t)lds; float* wsf = (float*)(lds + LDS_WS) + wid * 64;
  const __attribute__((address_space(3))) float* tab = (const __attribute__((address_space(3))) float*)(uintptr_t)(lds0 + LDS_TAB);
  const __attribute__((address_space(3))) unsigned* selw = (const __attribute__((address_space(3))) unsigned*)(uintptr_t)(lds0 + LDS_SELW + wid * 512);
  const bf16_t* ksrc = Kt0 + (size_t)lane * 64 + wid * 8;
  const bf16_t* vsrc = Vt0 + (size_t)(16 * (wid & 3) + (lane >> 2)) * 64 + (wid >> 2) * 32 + (lane & 3) * 8;
  const unsigned kdst = lds0 + LDS_K + wid * 1024, vdst = lds0 + LDS_V + wid * 1024;
#define DMA_K(t, slot) glds16(ksrc + (size_t)(t) * KVBLK * 64, (unsigned)__builtin_amdgcn_readfirstlane(kdst + (slot)))
#define DMA_V(t, slot) glds16(vsrc + (size_t)(t) * KVBLK * 64, (unsigned)__builtin_amdgcn_readfirstlane(vdst + (slot)))
  const lds_cptr vp0 = (lds_cptr)(uintptr_t)lds0 + LDS_V + ((lane >> 4) & 1) * 32 + (lane & 3) * 8 + (4 * hi + ((lane & 15) >> 2)) * 64;
  const lds_cptr kp0 = (lds_cptr)(uintptr_t)lds0 + LDS_K + hi * 1024 + r32 * 16;
  DMA_K(0, 0); DMA_V(0, 0); DMA_K(1, SLOTB);
  bf16x8 qr[4];
#pragma unroll
  for (int d0 = 0; d0 < 4; ++d0) qr[d0] = *reinterpret_cast<const bf16x8*>(&Qw[(size_t)r32 * 64 + d0 * 16 + hi * 8]);
  float l_reg = 0.f; f32x16 o[2]; o[0] = f32x16{}; o[1] = f32x16{};
  f32x16 zero16 = f32x16{}; PIN(zero16);
  const int qrel = wid * QBLK + r32;
  const int dlq = dq + qrel - S * 4 * hi;
  f32x16 pA0, pA1, pB0, pB1; bf16x8 kf[8]; s16x4 vlo[8], vhi[8]; u32x4 pw0, pw1, pw2, pw3;
  int sl_prev = 0, sl_cur = 0, sl_next = SLOTB;
#define ROT() do { sl_prev = sl_cur; sl_cur = sl_next; sl_next = (sl_next == 2 * SLOTB) ? 0 : sl_next + SLOTB; } while (0)
#define EX(v) __builtin_amdgcn_exp2f((v) + nmh)
#define SELBIT(t) ((MODE == 0) ? (((selw[(t)] >> r32) & 1u) != 0u) : true)
  DMA_K(2, 2 * SLOTB);
  WAIT_BAR(3);
  _Pragma("unroll") for (int d0 = 0; d0 < 4; ++d0) kload2(kf, kp0, d0);
  pA0 = MFMA(kf[0], qr[0], zero16); pA1 = MFMA(kf[1], qr[0], zero16); pA0 = MFMA(kf[2], qr[1], pA0); pA1 = MFMA(kf[3], qr[1], pA1);
  pA0 = MFMA(kf[4], qr[2], pA0); pA1 = MFMA(kf[5], qr[2], pA1); pA0 = MFMA(kf[6], qr[3], pA0); pA1 = MFMA(kf[7], qr[3], pA1);
  { const bool band0 = (MODE != 0) || (NT < 8);
    if (band0) bias_hook<S, IMAX>(pA0, pA1, dlq, tab);
    const float bc = band0 ? 0.f : b31; const bool sb = SELBIT(0);
    const float nmh = sb ? bc - REF : NEGBIG;
#pragma unroll
    for (int r = 0; r < 16; ++r) { pA0[r] = EX(pA0[r]); pA1[r] = EX(pA1[r]); } }
  WAIT_BAR(0);
  DMA_K(3, 0); DMA_V(1, SLOTB); ROT();
  _Pragma("unroll") for (int d0 = 0; d0 < 4; ++d0) kload2(kf, kp0 + sl_cur, d0);
  WAIT_BAR(2);
#define PKW(P, i) cvtpk(P[i], P[i + 1])
#define PAF(k) __builtin_bit_cast(bf16x8, pw##k)
#define VFR(i) (bf16x8){vlo[i][0], vlo[i][1], vlo[i][2], vlo[i][3], vhi[i][0], vhi[i][1], vhi[i][2], vhi[i][3]}
#define VRD(i) do { vlo[i] = vtr(vp_ + (((i) >> 2) * 4096 + ((i) & 3) * 1024)); vhi[i] = vtr(vp_ + (((i) >> 2) * 4096 + ((i) & 3) * 1024 + 512)); } while (0)
#define KRD(G, d0) do { if (G) { kload2(kf, kp0 + sl_next, d0); SBAR(); } } while (0)
#define GAPA(MF, a0, a1, a2, a3, W0, W1, PW) do { MF; sacc += a0; sacc += a1; sacc += a2; sacc += a3; W0; W1; PIN(PW); PIN(sacc); SBAR(); } while (0)
#define GAPB(MF, X, i) do { MF; X[i] = EX(X[i]); X[i + 1] = EX(X[i + 1]); X[i + 2] = EX(X[i + 2]); X[i + 3] = EX(X[i + 3]); PIN(X); SBAR(); } while (0)
#define STEP(C0, C1, P0, P1, t, MASK, GK, GV, GL) do { SBAR(); \
    const lds_cptr vp_ = vp0 + sl_prev; \
    VRD(0); SBAR(); float sacc = P0[0] + P0[1]; \
                    GAPA(C0 = MFMA(kf[0], qr[0], zero16), P0[2], P0[3], P0[4], P0[5],     pw0[0] = PKW(P0, 0),  pw0[1] = PKW(P0, 2),  pw0); \
    VRD(4); SBAR(); GAPA(C1 = MFMA(kf[1], qr[0], zero16), P0[6], P0[7], P0[8], P0[9],     pw0[2] = PKW(P0, 4),  pw0[3] = PKW(P0, 6),  pw0); \
    VRD(1); SBAR(); GAPA(C0 = MFMA(kf[2], qr[1], C0),    P0[10], P0[11], P0[12], P0[13], pw1[0] = PKW(P0, 8),  pw1[1] = PKW(P0, 10), pw1); \
    VRD(5); SBAR(); GAPA(C1 = MFMA(kf[3], qr[1], C1),    P0[14], P0[15], P1[0], P1[1],   pw1[2] = PKW(P0, 12), pw1[3] = PKW(P0, 14), pw1); \
    VRD(2); SBAR(); GAPA(C0 = MFMA(kf[4], qr[2], C0),    P1[2], P1[3], P1[4], P1[5],     pw2[0] = PKW(P1, 0),  pw2[1] = PKW(P1, 2),  pw2); \
    VRD(6); SBAR(); GAPA(C1 = MFMA(kf[5], qr[2], C1),    P1[6], P1[7], P1[8], P1[9],     pw2[2] = PKW(P1, 4),  pw2[3] = PKW(P1, 6),  pw2); \
    VRD(3); SBAR(); GAPA(C0 = MFMA(kf[6], qr[3], C0),    P1[10], P1[11], P1[12], P1[13], pw3[0] = PKW(P1, 8),  pw3[1] = PKW(P1, 10), pw3); \
    VRD(7); SBAR(); GAPA(C1 = MFMA(kf[7], qr[3], C1),    P1[14], P1[15], 0.f, 0.f,       pw3[2] = PKW(P1, 12), pw3[3] = PKW(P1, 14), pw3); \
    l_reg += sacc; \
    if (GK) DMA_K((t) + 3, sl_cur); if (GV) DMA_V((t) + 1, sl_next); \
    if (MASK) bias_hook<S, IMAX>(C0, C1, dlq - S * 64 * (t), tab); \
    const float bc_ = (MASK) ? 0.f : b31; const bool sb_ = SELBIT(t); \
    const float nmh = sb_ ? bc_ - REF : NEGBIG; SBAR(); \
    GAPB(o[0] = MFMA(PAF(0), VFR(0), o[0]), C0, 0);              GAPB(o[1] = MFMA(PAF(0), VFR(4), o[1]), C0, 4); \
    KRD(GL, 0); GAPB(o[0] = MFMA(PAF(1), VFR(1), o[0]), C0, 8);  KRD(GL, 1); GAPB(o[1] = MFMA(PAF(1), VFR(5), o[1]), C0, 12); \
    KRD(GL, 2); GAPB(o[0] = MFMA(PAF(2), VFR(2), o[0]), C1, 0);  KRD(GL, 3); GAPB(o[1] = MFMA(PAF(2), VFR(6), o[1]), C1, 4); \
    GAPB(o[0] = MFMA(PAF(3), VFR(3), o[0]), C1, 8);              GAPB(o[1] = MFMA(PAF(3), VFR(7), o[1]), C1, 12); \
    } while (0)
  int t = 1;
  if (MODE == 0) {
    for (; t + 7 < NT; t += 2) {
      STEP(pB0, pB1, pA0, pA1, t, false, true, true, true);     WAIT_BAR(2); ROT();
      STEP(pA0, pA1, pB0, pB1, t + 1, false, true, true, true); WAIT_BAR(2); ROT();
    }
  }
#define ENDW(tt) do { if ((tt) + 3 < NT) { WAIT_BAR(2); } else if ((tt) + 2 < NT) { WAIT_BAR(1); } else { WAIT_BAR(0); } } while (0)
  for (; t + 1 < NT; t += 2) {
    STEP(pB0, pB1, pA0, pA1, t, true, (t + 3 < NT), (t + 1 < NT), (t + 1 < NT));         ENDW(t);     ROT();
    STEP(pA0, pA1, pB0, pB1, t + 1, true, (t + 4 < NT), (t + 2 < NT), (t + 2 < NT));     ENDW(t + 1); ROT();
  }
  STEP(pB0, pB1, pA0, pA1, NT - 1, true, false, false, false);
  { float sacc = pB0[0] + pB0[1];
#pragma unroll
    for (int r = 2; r < 16; ++r) sacc += pB0[r];
#pragma unroll
    for (int r = 0; r < 16; ++r) sacc += pB1[r];
    l_reg += sacc;
    pw0 = (u32x4){PKW(pB0, 0), PKW(pB0, 2), PKW(pB0, 4), PKW(pB0, 6)}; pw1 = (u32x4){PKW(pB0, 8), PKW(pB0, 10), PKW(pB0, 12), PKW(pB0, 14)};
    pw2 = (u32x4){PKW(pB1, 0), PKW(pB1, 2), PKW(pB1, 4), PKW(pB1, 6)}; pw3 = (u32x4){PKW(pB1, 8), PKW(pB1, 10), PKW(pB1, 12), PKW(pB1, 14)};
    const lds_cptr vp_ = vp0 + sl_cur; _Pragma("unroll") for (int i = 0; i < 8; ++i) VRD(i);
    o[0] = MFMA(PAF(0), VFR(0), o[0]); o[1] = MFMA(PAF(0), VFR(4), o[1]); o[0] = MFMA(PAF(1), VFR(1), o[0]); o[1] = MFMA(PAF(1), VFR(5), o[1]);
    o[0] = MFMA(PAF(2), VFR(2), o[0]); o[1] = MFMA(PAF(2), VFR(6), o[1]); o[0] = MFMA(PAF(3), VFR(3), o[0]); o[1] = MFMA(PAF(3), VFR(7), o[1]); }
  { auto rr = __builtin_amdgcn_permlane32_swap(__float_as_uint(l_reg), __float_as_uint(l_reg), false, false); l_reg = __uint_as_float(rr[0]) + __uint_as_float(rr[1]); }
  if (hi == 0) wsf[32 + r32] = (l_reg > 0.f) ? gate[(size_t)qrel * 24] / l_reg : 0.f;
  asm volatile("s_waitcnt lgkmcnt(0)" ::: "memory");
  float rli[16];
#pragma unroll
  for (int r = 0; r < 16; ++r) rli[r] = wsf[32 + crow(r, hi)];
  float* stg = (float*)(lds + LDS_OST) + wid * 2048;
  if (first) {
#pragma unroll
    for (int r = 0; r < 16; ++r) { const int orow = crow(r, hi);
#pragma unroll
      for (int d0 = 0; d0 < 2; ++d0) stg[orow * 64 + d0 * 32 + r32] = o[d0][r] * rli[r]; }
  } else {
#pragma unroll
    for (int r = 0; r < 16; ++r) { const int orow = crow(r, hi);
#pragma unroll
      for (int d0 = 0; d0 < 2; ++d0) stg[orow * 64 + d0 * 32 + r32] += o[d0][r] * rli[r]; }
  }
  asm volatile("s_waitcnt lgkmcnt(0)\n\ts_barrier" ::: "memory");
#undef DMA_K
#undef DMA_V
#undef ROT
#undef EX
#undef SELBIT
#undef PKW
#undef PAF
#undef VFR
#undef VRD
#undef KRD
#undef ENDW
#undef GAPA
#undef GAPB
#undef STEP
}
#undef SBAR
#undef PIN
#undef MFMA
#undef WAIT_BAR
#undef MX3
}

__device__ __forceinline__ float ret_loggamma(int h) { return log1pf(-exp2f(-5.f - (float)h)); }
__device__ __forceinline__ void ret_kv_item(const Cx& cx, const P& p, int item, float* sm) {
  const int c = item & 63, bh = item >> 6, b = bh / 6, h = bh % 6, tid = cx.tid;
  const bf16_t* HB = (const bf16_t*)(p.ws + OFF_HB);
  const bf16_t* Kp = HB + ((size_t)(6 + h) * M_ + b * T_ + c * 128) * 64;
  const bf16_t* Vp = HB + ((size_t)(12 + h) * M_ + b * T_ + c * 128) * 64;
  float* Ks = sm; float* Vs = sm + 8192;
  const float lg = ret_loggamma(h);
  for (int i = tid; i < 8192; i += NTHR) { const int m = i >> 6; Ks[i] = bf2f(Kp[i]) * expf((float)(127 - m) * lg); Vs[i] = bf2f(Vp[i]); }
  __syncthreads();
  const int d = tid >> 3, e0 = (tid & 7) * 8;
  float acc[8];
#pragma unroll
  for (int j = 0; j < 8; ++j) acc[j] = 0.f;
  for (int m = 0; m < 128; ++m) { const float kd = Ks[m * 64 + d];
#pragma unroll
    for (int j = 0; j < 8; ++j) acc[j] += kd * Vs[m * 64 + e0 + j]; }
  float* S = (float*)(p.ws + OFF_RS) + (size_t)item * 4096 + d * 64 + e0;
#pragma unroll
  for (int j = 0; j < 8; ++j) S[j] = acc[j];
}
__device__ __forceinline__ void ph_scan(const Cx& cx, const P& p) {
  float* S = (float*)(p.ws + OFF_RS);
  for (int i = cx.bid * NTHR + cx.tid; i < 12 * 4096; i += cx.G * NTHR) {
    const int bh = i >> 12, de = i & 4095, h = bh % 6;
    const float cd = expf(128.f * ret_loggamma(h));
    float R = 0.f;
    for (int c = 0; c < 64; ++c) { float* q = S + ((size_t)(bh * 64 + c) * 4096 + de); const float kv = *q; *q = R; R = cd * R + kv; }
  }
}
__device__ __forceinline__ void ret_out_item(const Cx& cx, const P& p, int item, float* sm) {
  const int c = item & 63, bh = item >> 6, b = bh / 6, h = bh % 6, tid = cx.tid;
  const bf16_t* HB = (const bf16_t*)(p.ws + OFF_HB);
  const size_t r0 = (size_t)b * T_ + c * 128;
  const bf16_t* Qp = HB + ((size_t)(0 + h) * M_ + r0) * 64;
  const bf16_t* Kp = HB + ((size_t)(6 + h) * M_ + r0) * 64;
  const bf16_t* Vp = HB + ((size_t)(12 + h) * M_ + r0) * 64;
  const bf16_t* Gp = HB + ((size_t)(18 + h) * M_ + r0) * 64;
  const float* R = (const float*)(p.ws + OFF_RS) + (size_t)item * 4096;
  float* Qs = sm;
  float* red = sm + 128 * 65;
  bf16_t* Ks = (bf16_t*)(red + 512);
  bf16_t* Vs = Ks + 8192;
  const float lg = ret_loggamma(h);
  for (int i = tid; i < 8192; i += NTHR) { Ks[i] = Kp[i]; Vs[i] = Vp[i]; Qs[(i >> 6) * 65 + (i & 63)] = bf2f(Qp[i]); }
  __syncthreads();
  const int n = tid & 127, qt = tid >> 7;
  const float* qr = Qs + n * 65;
  float o[16];
#pragma unroll
  for (int j = 0; j < 16; ++j) o[j] = 0.f;
  for (int m = 0; m <= n; ++m) {
    float s = 0.f;
#pragma unroll 8
    for (int d = 0; d < 64; ++d) s += qr[d] * bf2f(Ks[m * 64 + d]);
    s *= expf((float)(n - m) * lg);
#pragma unroll
    for (int j = 0; j < 16; ++j) o[j] += s * bf2f(Vs[m * 64 + qt * 16 + j]);
  }
  const float xi = expf((float)(n + 1) * lg);
  for (int d = 0; d < 64; ++d) { const float qd = qr[d] * xi;
#pragma unroll
    for (int j = 0; j < 16; ++j) o[j] += qd * R[d * 64 + qt * 16 + j]; }
  float ss = 0.f;
#pragma unroll
  for (int j = 0; j < 16; ++j) ss += o[j] * o[j];
  red[tid] = ss;
  __syncthreads();
  const float rs = rsqrtf(((red[n] + red[n + 128]) + (red[n + 256] + red[n + 384])) * (1.f / 64.f) + EPS);
  bf16_t* mix = (bf16_t*)(p.ws + OFF_MIX) + (r0 + n) * D_ + h * 64 + qt * 16;
#pragma unroll
  for (int j = 0; j < 16; ++j) { const float g = bf2f(Gp[n * 64 + qt * 16 + j]); mix[j] = f2bf(o[j] * rs * (g * sigmoidf(g))); }
}
__device__ __forceinline__ void gmlp_item(const Cx& cx, const P& p, int layer, int item, float* sm) {
  const int g = item & 3, bc = item >> 2, tid = cx.tid;
  const size_t r0 = (size_t)bc * 128;
  const bf16_t* HB = (const bf16_t*)(p.ws + OFF_HB);
  const bf16_t* Up = HB + ((size_t)(42 + g) * M_ + r0) * 64;
  const bf16_t* Vp = HB + ((size_t)(46 + g) * M_ + r0) * 64;
  float* Vs = sm;
  for (int i = tid; i < 8192; i += NTHR) Vs[i] = bf2f(Vp[i]);
  __syncthreads();
  const int t = tid >> 2, qt = tid & 3;
  const float* wrow = p.gm_ws + ((size_t)(layer * 4 + g) * 128 + t) * 128;
  float acc[16];
#pragma unroll
  for (int j = 0; j < 16; ++j) acc[j] = 0.f;
  for (int s = 0; s <= t; ++s) { const float w = wrow[s];
#pragma unroll
    for (int j = 0; j < 16; ++j) acc[j] += w * Vs[s * 64 + qt * 16 + j]; }
  const float bias = p.gm_b[(layer * 4 + g) * 128 + t];
  bf16_t* mix = (bf16_t*)(p.ws + OFF_MIX) + (r0 + t) * D_ + 768 + g * 64 + qt * 16;
#pragma unroll
  for (int j = 0; j < 16; ++j) mix[j] = f2bf(bf2f(Up[t * 64 + qt * 16 + j]) * (acc[j] + bias));
}
__device__ __forceinline__ void cmp_item(const Cx& cx, const P& p, int layer, int item, float* sm) {
  const int o8 = item & 63, j = (item >> 6) & 1, bg = item >> 7, b = bg >> 1, g = bg & 1, tid = cx.tid;
  const int slot = 30 + j * 2 + g;
  const bf16_t* src = (const bf16_t*)(p.ws + OFF_HB) + ((size_t)slot * M_ + (size_t)b * T_) * 64;
  float* xs = sm; float* pes = sm + 144 * 64; float* hid = pes + 2048;
  const int tok0 = 128 * o8;
  for (int i = tid; i < 144 * 64; i += NTHR) { const int tok = tok0 + (i >> 6); xs[i] = (tok < T_) ? bf2f(src[(size_t)tok * 64 + (i & 63)]) : 0.f; }
  for (int i = tid; i < 2048; i += NTHR) pes[i] = p.cmp_pe[(size_t)(layer * 2 + j) * 2048 + i];
  __syncthreads();
  const int f = tid & 63, nq = tid >> 6;
  const float* w1 = p.cmp_w1 + (size_t)(layer * 2 + j) * 2048 * 64;
  float a0 = 0.f;
  for (int i = 0; i < 2048; ++i) { const int l = i >> 6, d = i & 63; a0 += (xs[(16 * nq + l) * 64 + d] + pes[i]) * w1[(size_t)i * 64 + f]; }
  hid[nq * 64 + f] = gelu_tanh(a0);
  __syncthreads();
  const float* w2 = p.cmp_w2 + (size_t)(layer * 2 + j) * 4096;
  float o0 = 0.f;
  for (int ff = 0; ff < 64; ++ff) o0 += hid[nq * 64 + ff] * w2[ff * 64 + f];
  if (j == 0) { const float s0 = wave_sum(o0 * o0); o0 = o0 * rsqrtf(s0 * (1.f / 64.f) + EPS) * p.k_gain[(layer * 3 + 0) * 64 + f]; }
  bf16_t* dst = (bf16_t*)(p.ws + (j == 0 ? OFF_KC : OFF_VC)) + (size_t)bg * 512 * 64;
  const int n0 = 8 * o8 + nq;
  dst[(size_t)n0 * 64 + f] = (n0 < 511) ? f2bf(o0) : (bf16_t)0;
}
#define L2E 1.4426950408889634f
__device__ __forceinline__ void topk_unit(const Cx& cx, const P& p, int u, char* lds) {
  using att::bf16x8; using att::f32x16;
  const int tid = cx.tid, lane = tid & 63, r32 = lane & 31, hi = lane >> 5, wid = cx.wv, grp = wid & 3, half = wid >> 2;
  const int qb = 63 - (u >> 2), bg = u & 3, b = bg >> 1, g = bg & 1, q0 = qb * 128;
  const int ntile64 = ((((q0 + 127) >> 4) + 1) + 63) >> 6;
  const bf16_t* KCb = (const bf16_t*)(p.ws + OFF_KC) + (size_t)bg * 512 * 64;
  const unsigned lds0 = (unsigned)(uintptr_t)lds;
  constexpr int L_IMP = 65536, L_LSUM = 131072 + 1024, L_TAB = 139264;
  for (int i = tid; i < ntile64 * 512; i += NTHR) { const int n = i >> 3, c = i & 7;
    *(u32x4*)(lds + (n >> 6) * 8192 + c * 1024 + (n & 63) * 16) = *(const u32x4*)(KCb + (size_t)n * 64 + c * 8); }
  float* tabw = (float*)(lds + L_TAB);
  for (int i = tid; i < 3 * 115; i += NTHR) { const int h = i / 115, k = i % 115; tabw[i] = ((const float*)(p.ws + OFF_BTAB))[(g * 3 + h) * 768 + k]; }
  float* impw = (float*)(lds + L_IMP) + wid * 2048;
#pragma unroll
  for (int s2 = 0; s2 < 32; ++s2) impw[s2 * 64 + lane] = 0.f;
  __syncthreads();
  const __attribute__((address_space(3))) float* tab = (const __attribute__((address_space(3))) float*)(uintptr_t)(lds0 + L_TAB);
  const att::lds_cptr kp0 = (att::lds_cptr)(uintptr_t)lds0 + hi * 1024 + r32 * 16;
  const int tq0 = q0 + grp * 32, t = tq0 + r32, cur = tq0 >> 6;
  const int NT32 = ((tq0 >> 4) + 1 + 31) >> 5;
  const int Th = (NT32 + 1) >> 1, T0 = half ? Th : 0, T1 = half ? NT32 : Th;
  const int nfar = (tq0 - 144) >> 4;
  const int Tnear0 = (nfar >= 31) ? ((nfar - 31) >> 5) + 1 : 0;
  const bf16_t* HB = (const bf16_t*)(p.ws + OFF_HB);
  float b31[3];
#pragma unroll
  for (int h = 0; h < 3; ++h) b31[h] = p.rel_bias[31 * 6 + g * 3 + h] * L2E;
  const int dl0 = t - 31 - 64 * hi;
  f32x16 zero16 = f32x16{}; asm volatile("" : "+v"(zero16));
#define TK_SCORES(T, h, sv) do { const att::lds_cptr kp_ = kp0 + ((T) >> 1) * 8192 + ((T) & 1) * 512; \
    const bf16x8 k0_ = *(const __attribute__((address_space(3))) bf16x8*)(kp_), k1_ = *(const __attribute__((address_space(3))) bf16x8*)(kp_ + 2048), \
                 k2_ = *(const __attribute__((address_space(3))) bf16x8*)(kp_ + 4096), k3_ = *(const __attribute__((address_space(3))) bf16x8*)(kp_ + 6144); \
    sv = __builtin_amdgcn_mfma_f32_32x32x16_bf16(k0_, qr[0], zero16, 0, 0, 0); sv = __builtin_amdgcn_mfma_f32_32x32x16_bf16(k1_, qr[1], sv, 0, 0, 0); \
    sv = __builtin_amdgcn_mfma_f32_32x32x16_bf16(k2_, qr[2], sv, 0, 0, 0); sv = __builtin_amdgcn_mfma_f32_32x32x16_bf16(k3_, qr[3], sv, 0, 0, 0); \
    if ((T) >= Tnear0) { const int dl_ = dl0 - 512 * (T); _Pragma("unroll") for (int r = 0; r < 16; ++r) { const int c_ = (r & 3) + 8 * (r >> 2); sv[r] = __builtin_amdgcn_exp2f(sv[r] + tab[(h) * 115 + 1 + min(max(dl_ - 16 * c_, -1), 113)]); } } \
    else { _Pragma("unroll") for (int r = 0; r < 16; ++r) sv[r] = __builtin_amdgcn_exp2f(sv[r] + b31[h]); } } while (0)
  float U[3][32]; float l[3];
#pragma unroll
  for (int h = 0; h < 3; ++h) {
    const bf16_t* Qh = HB + ((size_t)(24 + g * 3 + h) * M_ + (size_t)b * T_ + tq0) * 64;
    bf16x8 qr[4];
#pragma unroll
    for (int d0 = 0; d0 < 4; ++d0) qr[d0] = *reinterpret_cast<const bf16x8*>(Qh + (size_t)r32 * 64 + d0 * 16 + hi * 8);
    float lh = 0.f, carry = 0.f;
    if (half == 1 && T0 < T1) { f32x16 sv; TK_SCORES(T0 - 1, h, sv); carry = __shfl_xor(sv[15], 32); }
#pragma unroll
    for (int tt = 0; tt < 8; ++tt) {
      const int T = T0 + tt;
      if (T < T1) {
        f32x16 sv; TK_SCORES(T, h, sv);
        float body[4], pt[4], a = 0.f;
#pragma unroll
        for (int g4 = 0; g4 < 4; ++g4) { const float s3 = (sv[4 * g4] + sv[4 * g4 + 1]) + sv[4 * g4 + 2]; body[g4] = 2.f * s3 + sv[4 * g4 + 3]; a += s3 + sv[4 * g4 + 3]; }
        lh += a;
#pragma unroll
        for (int k = 0; k < 4; ++k) pt[k] = __shfl_xor(sv[4 * k + 3], 32);
        U[h][tt * 4 + 0] = body[0] + (hi ? pt[0] : carry); U[h][tt * 4 + 1] = body[1] + (hi ? pt[1] : pt[0]);
        U[h][tt * 4 + 2] = body[2] + (hi ? pt[2] : pt[1]); U[h][tt * 4 + 3] = body[3] + (hi ? pt[3] : pt[2]);
        carry = pt[3];
      } else { U[h][tt * 4 + 0] = 0.f; U[h][tt * 4 + 1] = 0.f; U[h][tt * 4 + 2] = 0.f; U[h][tt * 4 + 3] = 0.f; }
    }
    l[h] = lh;
  }
  { float* ls = (float*)(lds + L_LSUM);
#pragma unroll
    for (int h = 0; h < 3; ++h) ls[((grp * 2 + half) * 3 + h) * 64 + lane] = l[h]; }
  __syncthreads();
  { const float* ls = (const float*)(lds + L_LSUM); float rl[3];
#pragma unroll
    for (int h = 0; h < 3; ++h) { float lt = ls[((grp * 2 + 0) * 3 + h) * 64 + lane] + ls[((grp * 2 + 1) * 3 + h) * 64 + lane]; lt += __shfl_xor(lt, 32); rl[h] = (lt > 0.f) ? 1.f / lt : 0.f; }
#pragma unroll
    for (int i = 0; i < 32; ++i) impw[i * 64 + lane] = (U[0][i] * rl[0] + U[1][i] * rl[1]) + U[2][i] * rl[2]; }
#undef TK_SCORES
  __syncthreads();
  if (half == 0) {
    const float* ia = (const float*)(lds + L_IMP) + wid * 2048 + lane; const float* ibp = ia + 4 * 2048;
    unsigned v[64];
#pragma unroll
    for (int i = 0; i < 64; ++i) { const int sl = i & 31; const int j = 8 * (((i < 32) ? 0 : Th) + (sl >> 2)) + 2 * (sl & 3) + hi;
      const float x = (i < 32) ? ia[sl * 64] : ibp[sl * 64]; v[i] = (j >= 1 && j <= cur - 2) ? __float_as_uint(x) : 0u; }
    unsigned tau = 0u;
    if (cur >= 16) {
      unsigned thr = 0x7fffffffu;
#pragma unroll 1
      for (int rnd = 0; rnd < 13; ++rnd) {
        unsigned m0 = 0u, m1 = 0u, m2 = 0u, m3 = 0u;
#pragma unroll
        for (int i = 0; i < 64; i += 4) { m0 = max(m0, (v[i] < thr) ? v[i] : 0u); m1 = max(m1, (v[i + 1] < thr) ? v[i + 1] : 0u); m2 = max(m2, (v[i + 2] < thr) ? v[i + 2] : 0u); m3 = max(m3, (v[i + 3] < thr) ? v[i + 3] : 0u); }
        unsigned m = max(max(m0, m1), max(m2, m3));
        m = max(m, (unsigned)__shfl_xor((int)m, 32));
        thr = m;
      }
      tau = thr;
    }
    unsigned w0 = 0u, w1 = 0u, w2 = 0u, w3 = 0u;
#pragma unroll
    for (int i = 0; i < 64; ++i) { const int sl = i & 31; const int j = 8 * (((i < 32) ? 0 : Th) + (sl >> 2)) + 2 * (sl & 3) + hi;
      const bool ok = (j >= 1 && j <= cur - 2) && (v[i] >= tau); const unsigned m = ok ? (1u << (j & 31)) : 0u; const int wq = j >> 5;
      w0 |= (wq == 0) ? m : 0u; w1 |= (wq == 1) ? m : 0u; w2 |= (wq == 2) ? m : 0u; w3 |= (wq == 3) ? m : 0u; }
    w0 |= (unsigned)__shfl_xor((int)w0, 32); w1 |= (unsigned)__shfl_xor((int)w1, 32); w2 |= (unsigned)__shfl_xor((int)w2, 32); w3 |= (unsigned)__shfl_xor((int)w3, 32);
#pragma unroll
    for (int f = 0; f < 3; ++f) { const int jf = (f == 0) ? 0 : (f == 1) ? cur - 1 : cur; if (jf >= 0) { const unsigned m = 1u << (jf & 31); const int wq = jf >> 5;
        w0 |= (wq == 0) ? m : 0u; w1 |= (wq == 1) ? m : 0u; w2 |= (wq == 2) ? m : 0u; w3 |= (wq == 3) ? m : 0u; } }
    if (hi == 0) *(uint4*)((unsigned*)(p.ws + OFF_SELQ) + ((size_t)bg * T_ + t) * 4) = make_uint4(w0, w1, w2, w3);
  }
  __syncthreads();
}
__device__ __forceinline__ void nsa_unit(const Cx& cx, const P& p, int u, char* lds) {
  const int tid = cx.tid, lane = tid & 63, r32 = lane & 31, wid = tid >> 6;
  const int qb = 31 - u / 12, bgh = u % 12, b = bgh / 6, g = (bgh / 3) & 1, h = bgh % 3, head = g * 3 + h;
  const size_t rowb = (size_t)b * T_; const int q0 = qb * 256;
  const bf16_t* HB = (const bf16_t*)(p.ws + OFF_HB);
  const bf16_t* Qrows = HB + ((size_t)(24 + head) * M_ + rowb + q0) * 64;
  const float* gate0 = (const float*)(p.ws + OFF_GATES) + (rowb + q0) * 24 + head * 3;
  float* tabw = (float*)(lds + att::LDS_TAB);
  const float b31 = p.rel_bias[31 * 6 + head] * L2E;
  { const uint4 mq = *(const uint4*)((const unsigned*)(p.ws + OFF_SELQ) + ((size_t)(b * 2 + g) * T_ + q0 + wid * 32 + r32) * 4);
    unsigned* sw = (unsigned*)(lds + att::LDS_SELW) + wid * 128;
    const int nblk = 4 * qb + 4;
#pragma unroll
    for (int w4 = 0; w4 < 4; ++w4) { const unsigned w = (w4 == 0) ? mq.x : (w4 == 1) ? mq.y : (w4 == 2) ? mq.z : mq.w;
      if (32 * w4 < nblk) { for (int j = 0; j < 32; ++j) { const unsigned long long bal = __ballot((w >> j) & 1u); if (lane == 0) sw[32 * w4 + j] = (unsigned)bal; } } } }
  const float* btab = (const float*)(p.ws + OFF_BTAB) + head * 768;
  if (tid < 115) tabw[tid] = btab[tid];
  att::nsa_pass<0>(tid, Qrows, HB + ((size_t)(34 + g) * M_ + rowb) * 64, HB + ((size_t)(36 + g) * M_ + rowb) * 64, 4 * qb + 4, q0, b31, gate0 + 1, lds, true);
  for (int i = tid; i < 514; i += NTHR) tabw[i] = btab[128 + i];
  { const int t0 = (qb >= 2) ? 4 * qb - 8 : 0;
    att::nsa_pass<1>(tid, Qrows, HB + ((size_t)(38 + g) * M_ + rowb + 64 * t0) * 64, HB + ((size_t)(40 + g) * M_ + rowb + 64 * t0) * 64, 4 * qb + 4 - t0, q0 - 64 * t0, b31, gate0 + 2, lds, false); }
  if (tid < 115) tabw[tid] = btab[tid];
  { const int nt = (qb < 16) ? 4 : (qb < 24) ? 6 : 8;
    att::nsa_pass<2>(tid, Qrows, (const bf16_t*)(p.ws + OFF_KC) + (size_t)(b * 2 + g) * 512 * 64, (const bf16_t*)(p.ws + OFF_VC) + (size_t)(b * 2 + g) * 512 * 64, nt, q0 - 31, b31, gate0, lds, false); }
  { const float* stg = (const float*)(lds + att::LDS_OST) + wid * 2048;
    bf16_t* mixw = (bf16_t*)(p.ws + OFF_MIX) + (rowb + q0 + wid * 32) * D_ + 384 + head * 64;
#pragma unroll
    for (int i = 0; i < 4; ++i) { const int row = i * 8 + (lane >> 3), ch = lane & 7;
      const f32x4 a0 = *(const f32x4*)(stg + row * 64 + ch * 8), a1 = *(const f32x4*)(stg + row * 64 + ch * 8 + 4);
      u32x4 w; w.x = pk2(a0[0], a0[1]); w.y = pk2(a0[2], a0[3]); w.z = pk2(a1[0], a1[1]); w.w = pk2(a1[2], a1[3]);
      *(u32x4*)(mixw + (size_t)row * D_ + ch * 8) = w; }
    asm volatile("s_waitcnt lgkmcnt(0)\n\ts_barrier" ::: "memory"); }
}
namespace mx {
using att::bf16x8; using att::s16x4; using att::f32x16; using att::lds_cptr;
#define MX_MFMA(a, b, c) __builtin_amdgcn_mfma_f32_32x32x16_bf16(a, b, c, 0, 0, 0)
__device__ __forceinline__ void dma_k_tile(const bf16_t* src, unsigned ldsaddr, int lane, int wid) { att::glds16(src + (size_t)lane * 64 + wid * 8, (unsigned)__builtin_amdgcn_readfirstlane(ldsaddr + wid * 1024)); }
__device__ __forceinline__ void dma_v_tile(const bf16_t* src, unsigned ldsaddr, int lane, int wid) { att::glds16(src + (size_t)(16 * (wid & 3) + (lane >> 2)) * 64 + (wid >> 2) * 32 + (lane & 3) * 8, (unsigned)__builtin_amdgcn_readfirstlane(ldsaddr + wid * 1024)); }
__device__ __forceinline__ int vlane_off(int lane) { return ((lane >> 4) & 1) * 32 + (lane & 3) * 8 + (4 * (lane >> 5) + ((lane & 15) >> 2)) * 64; }
__device__ __forceinline__ bf16x8 vfrag(lds_cptr vp, int i) { const s16x4 lo = att::vtr(vp + (i >> 2) * 4096 + (i & 3) * 1024), hi = att::vtr(vp + (i >> 2) * 4096 + (i & 3) * 1024 + 512);
  return (bf16x8){lo[0], lo[1], lo[2], lo[3], hi[0], hi[1], hi[2], hi[3]}; }
__device__ __forceinline__ bf16x8 kfrag(lds_cptr kp, int d0, int n) { return *(const __attribute__((address_space(3))) bf16x8*)(kp + d0 * 2048 + n * 512); }
#define MX_WAIT_ALL() asm volatile("s_waitcnt vmcnt(0) lgkmcnt(0)\n\ts_barrier" ::: "memory")
__device__ __forceinline__ float loggamma2(int h) { return log2f(1.f - exp2f(-5.f - (float)h)); }

__device__ __forceinline__ void ret_kv_unit(const Cx& cx, const P& p, int u, char* lds) {
  const int tid = cx.tid, lane = tid & 63, r32 = lane & 31, hi = lane >> 5, wid = cx.wv;
  const int bh = u >> 5, cp = u & 31, b = bh / 6, h = bh % 6;
  const size_t r0 = (size_t)b * T_ + cp * 256;
  const bf16_t* HB = (const bf16_t*)(p.ws + OFF_HB);
  const bf16_t* Kp = HB + ((size_t)(6 + h) * M_ + r0) * 64; const bf16_t* Vp = HB + ((size_t)(12 + h) * M_ + r0) * 64;
  const unsigned lds0 = (unsigned)(uintptr_t)lds;
#pragma unroll
  for (int i = 0; i < 4; ++i) { dma_v_tile(Vp + (size_t)i * 4096, lds0 + i * 8192, lane, wid); dma_v_tile(Kp + (size_t)i * 4096, lds0 + 32768 + i * 8192, lane, wid); }
  MX_WAIT_ALL();
  const int ch = wid >> 2, eb = (wid >> 1) & 1, db = wid & 1;
  f32x16 acc = f32x16{};
#pragma unroll
  for (int kt = 0; kt < 2; ++kt) { const lds_cptr vv = (lds_cptr)(uintptr_t)(lds0 + (ch * 2 + kt) * 8192) + vlane_off(lane), vk = vv + 32768;
#pragma unroll
    for (int ks = 0; ks < 4; ++ks) acc = MX_MFMA(vfrag(vv, 4 * eb + ks), vfrag(vk, 4 * db + ks), acc); }
  const float sc = exp2f(127.f * loggamma2(h));
  float* ST = (float*)(p.ws + OFF_RS) + ((size_t)bh * 64 + cp * 2 + ch) * 4096;
#pragma unroll
  for (int r = 0; r < 16; ++r) ST[(32 * eb + att::crow(r, hi)) * 64 + 32 * db + r32] = acc[r] * sc;
  MX_WAIT_ALL();
}
__device__ __forceinline__ void ret_scan(const Cx& cx, const P& p) {
  const float* __restrict__ ST = (const float*)(p.ws + OFF_RS); bf16_t* __restrict__ RT = (bf16_t*)(p.ws + OFF_RT);
  for (int i = cx.bid * NTHR + cx.tid; i < 12 * 4096; i += cx.G * NTHR) {
    const int bh = i >> 12, ed = i & 4095, h = bh % 6; const float lg = loggamma2(h), cd = exp2f(128.f * lg), g1 = exp2f(lg);
    const size_t o0 = (size_t)bh * 64 * 4096 + ed;
    float R = 0.f;
#pragma unroll
    for (int c0 = 0; c0 < 64; c0 += 16) {
      float kv[16];
#pragma unroll
      for (int k = 0; k < 16; ++k) kv[k] = ST[o0 + (size_t)(c0 + k) * 4096];
#pragma unroll
      for (int k = 0; k < 16; ++k) { RT[o0 + (size_t)(c0 + k) * 4096] = f2bf(R * g1); R = cd * R + kv[k]; }
    }
  }
}
__device__ __forceinline__ void ret_out_unit(const Cx& cx, const P& p, int u, char* lds) {
  const int tid = cx.tid, lane = tid & 63, r32 = lane & 31, hi = lane >> 5, wid = cx.wv;
  const int bh = u >> 5, cp = u & 31, b = bh / 6, h = bh % 6;
  const size_t r0 = (size_t)b * T_ + cp * 256;
  const bf16_t* HB = (const bf16_t*)(p.ws + OFF_HB);
  const bf16_t* Qp = HB + ((size_t)(0 + h) * M_ + r0) * 64; const bf16_t* Kp = HB + ((size_t)(6 + h) * M_ + r0) * 64;
  const bf16_t* Vp = HB + ((size_t)(12 + h) * M_ + r0) * 64; const bf16_t* Gp = HB + ((size_t)(18 + h) * M_ + r0) * 64;
  const unsigned lds0 = (unsigned)(uintptr_t)lds;
#pragma unroll
  for (int i = 0; i < 4; ++i) { dma_k_tile(Kp + (size_t)i * 4096, lds0 + i * 8192, lane, wid); dma_v_tile(Vp + (size_t)i * 4096, lds0 + 32768 + i * 8192, lane, wid); }
  const int ch = wid >> 2, rt = wid & 3, rw = ch * 128 + rt * 32;
  bf16x8 qr[4], rtf[2][4];
  const bf16_t* RT = (const bf16_t*)(p.ws + OFF_RT) + ((size_t)bh * 64 + cp * 2 + ch) * 4096;
#pragma unroll
  for (int d0 = 0; d0 < 4; ++d0) qr[d0] = *reinterpret_cast<const bf16x8*>(Qp + (size_t)(rw + r32) * 64 + d0 * 16 + hi * 8);
#pragma unroll
  for (int eb = 0; eb < 2; ++eb)
#pragma unroll
    for (int ks = 0; ks < 4; ++ks) rtf[eb][ks] = *reinterpret_cast<const bf16x8*>(RT + (size_t)(32 * eb + r32) * 64 + 16 * ks + 8 * hi);
  MX_WAIT_ALL();
  f32x16 o[2]; o[0] = f32x16{}; o[1] = f32x16{};
  const f32x16 zero16 = f32x16{};
  const int n = rt * 32 + r32;
  for (int kt = 0; kt <= (rt >> 1); ++kt) {
    const int tile = ch * 2 + kt;
    const lds_cptr kp = (lds_cptr)(uintptr_t)(lds0 + tile * 8192) + hi * 1024 + r32 * 16;
    f32x16 p0 = MX_MFMA(kfrag(kp, 0, 0), qr[0], zero16), p1 = MX_MFMA(kfrag(kp, 0, 1), qr[0], zero16);
#pragma unroll
    for (int d0 = 1; d0 < 4; ++d0) { p0 = MX_MFMA(kfrag(kp, d0, 0), qr[d0], p0); p1 = MX_MFMA(kfrag(kp, d0, 1), qr[d0], p1); }
    if (kt == (rt >> 1)) {
#pragma unroll
      for (int r = 0; r < 16; ++r) { const int m = 64 * kt + att::crow(r, hi); if (m > n) p0[r] = 0.f; if (m + 32 > n) p1[r] = 0.f; }
    }
    u32x4 pw0, pw1, pw2, pw3;
    pw0 = (u32x4){att::cvtpk(p0[0], p0[1]), att::cvtpk(p0[2], p0[3]), att::cvtpk(p0[4], p0[5]), att::cvtpk(p0[6], p0[7])};
    pw1 = (u32x4){att::cvtpk(p0[8], p0[9]), att::cvtpk(p0[10], p0[11]), att::cvtpk(p0[12], p0[13]), att::cvtpk(p0[14], p0[15])};
    pw2 = (u32x4){att::cvtpk(p1[0], p1[1]), att::cvtpk(p1[2], p1[3]), att::cvtpk(p1[4], p1[5]), att::cvtpk(p1[6], p1[7])};
    pw3 = (u32x4){att::cvtpk(p1[8], p1[9]), att::cvtpk(p1[10], p1[11]), att::cvtpk(p1[12], p1[13]), att::cvtpk(p1[14], p1[15])};
    const lds_cptr vp = (lds_cptr)(uintptr_t)(lds0 + 32768 + tile * 8192) + vlane_off(lane);
#pragma unroll
    for (int d0 = 0; d0 < 2; ++d0) {
      o[d0] = MX_MFMA(__builtin_bit_cast(bf16x8, pw0), vfrag(vp, 4 * d0 + 0), o[d0]); o[d0] = MX_MFMA(__builtin_bit_cast(bf16x8, pw1), vfrag(vp, 4 * d0 + 1), o[d0]);
      o[d0] = MX_MFMA(__builtin_bit_cast(bf16x8, pw2), vfrag(vp, 4 * d0 + 2), o[d0]); o[d0] = MX_MFMA(__builtin_bit_cast(bf16x8, pw3), vfrag(vp, 4 * d0 + 3), o[d0]); }
  }
#pragma unroll
  for (int eb = 0; eb < 2; ++eb)
#pragma unroll
    for (int ks = 0; ks < 4; ++ks) o[eb] = MX_MFMA(qr[ks], rtf[eb][ks], o[eb]);
  float* stg = (float*)(lds + 65536) + wid * 2048;
#pragma unroll
  for (int r = 0; r < 16; ++r) { const int orow = att::crow(r, hi); stg[orow * 64 + r32] = o[0][r]; stg[orow * 64 + 32 + r32] = o[1][r]; }
  asm volatile("s_waitcnt lgkmcnt(0)" ::: "memory");
  bf16_t* mix = (bf16_t*)(p.ws + OFF_MIX) + (r0 + rw) * D_ + h * 64;
#pragma unroll
  for (int i = 0; i < 4; ++i) { const int row = i * 8 + (lane >> 3), c8 = lane & 7;
    const f32x4 a0 = *(const f32x4*)(stg + row * 64 + c8 * 8), a1 = *(const f32x4*)(stg + row * 64 + c8 * 8 + 4);
    float ss = (a0[0] * a0[0] + a0[1] * a0[1]) + (a0[2] * a0[2] + a0[3] * a0[3]) + (a1[0] * a1[0] + a1[1] * a1[1]) + (a1[2] * a1[2] + a1[3] * a1[3]);
    ss += __shfl_xor(ss, 1); ss += __shfl_xor(ss, 2); ss += __shfl_xor(ss, 4);
    const float rs = rsqrtf(ss * (1.f / 64.f) + EPS);
    const u32x4 gw = *(const u32x4*)(Gp + (size_t)(rw + row) * 64 + c8 * 8);
    float gv[8] = {__uint_as_float(gw.x << 16), __uint_as_float(gw.x & 0xffff0000u), __uint_as_float(gw.y << 16), __uint_as_float(gw.y & 0xffff0000u),
                   __uint_as_float(gw.z << 16), __uint_as_float(gw.z & 0xffff0000u), __uint_as_float(gw.w << 16), __uint_as_float(gw.w & 0xffff0000u)};
    float ov[8] = {a0[0], a0[1], a0[2], a0[3], a1[0], a1[1], a1[2], a1[3]};
#pragma unroll
    for (int k = 0; k < 8; ++k) ov[k] = ov[k] * rs * (gv[k] * sigmoidf(gv[k]));
    u32x4 w; w.x = pk2(ov[0], ov[1]); w.y = pk2(ov[2], ov[3]); w.z = pk2(ov[4], ov[5]); w.w = pk2(ov[6], ov[7]);
    *(u32x4*)(mix + (size_t)row * D_ + c8 * 8) = w; }
  MX_WAIT_ALL();
}
__device__ __forceinline__ void gmlp_unit(const Cx& cx, const P& p, int layer, int u, char* lds) {
  const int tid = cx.tid, lane = tid & 63, r32 = lane & 31, hi = lane >> 5, wid = cx.wv;
  const int g = u & 3, bc = u >> 2; const size_t r0 = (size_t)bc * 128;
  const bf16_t* HB = (const bf16_t*)(p.ws + OFF_HB);
  const bf16_t* Up = HB + ((size_t)(42 + g) * M_ + r0) * 64; const bf16_t* Vp = HB + ((size_t)(46 + g) * M_ + r0) * 64;
  const unsigned lds0 = (unsigned)(uintptr_t)lds;
  dma_v_tile(Vp, lds0, lane, wid); dma_v_tile(Vp + 4096, lds0 + 8192, lane, wid);
  const int rt = wid & 3, dh = wid >> 2;
  const bf16_t* Wr = (const bf16_t*)(p.ws + OFF_WSB) + ((size_t)(layer * 4 + g) * 128 + rt * 32 + r32) * 128;
  MX_WAIT_ALL();
  f32x16 acc = f32x16{};
  for (int ks = 0; ks < 2 * rt + 2; ++ks) {
    const uint2 alo = *(const uint2*)(Wr + 16 * ks + 4 * hi), ahi = *(const uint2*)(Wr + 16 * ks + 8 + 4 * hi);
    const u32x4 aw = (u32x4){alo.x, alo.y, ahi.x, ahi.y};
    const lds_cptr vp = (lds_cptr)(uintptr_t)(lds0 + (ks >> 2) * 8192) + vlane_off(lane);
    acc = MX_MFMA(__builtin_bit_cast(bf16x8, aw), vfrag(vp, 4 * dh + (ks & 3)), acc);
  }
  float* stg = (float*)(lds + 16384) + wid * 1024;
#pragma unroll
  for (int r = 0; r < 16; ++r) stg[att::crow(r, hi) * 32 + r32] = acc[r];
  asm volatile("s_waitcnt lgkmcnt(0)" ::: "memory");
  bf16_t* mix = (bf16_t*)(p.ws + OFF_MIX) + (r0 + rt * 32) * D_ + 768 + g * 64 + dh * 32;
#pragma unroll
  for (int i = 0; i < 2; ++i) { const int row = i * 16 + (lane >> 2), c8 = lane & 3, t = rt * 32 + row;
    const f32x4 a0 = *(const f32x4*)(stg + row * 32 + c8 * 8), a1 = *(const f32x4*)(stg + row * 32 + c8 * 8 + 4);
    const float bias = p.gm_b[(layer * 4 + g) * 128 + t];
    const u32x4 uw = *(const u32x4*)(Up + (size_t)t * 64 + dh * 32 + c8 * 8);
    u32x4 w; w.x = pk2(__uint_as_float(uw.x << 16) * (a0[0] + bias), __uint_as_float(uw.x & 0xffff0000u) * (a0[1] + bias));
    w.y = pk2(__uint_as_float(uw.y << 16) * (a0[2] + bias), __uint_as_float(uw.y & 0xffff0000u) * (a0[3] + bias));
    w.z = pk2(__uint_as_float(uw.z << 16) * (a1[0] + bias), __uint_as_float(uw.z & 0xffff0000u) * (a1[1] + bias));
    w.w = pk2(__uint_as_float(uw.w << 16) * (a1[2] + bias), __uint_as_float(uw.w & 0xffff0000u) * (a1[3] + bias));
    *(u32x4*)(mix + (size_t)row * D_ + c8 * 8) = w; }
  MX_WAIT_ALL();
}
__device__ __forceinline__ void cmp_unit(const Cx& cx, const P& p, int layer, int u, char* lds) {
  const int tid = cx.tid, lane = tid & 63, r32 = lane & 31, hi = lane >> 5, wid = cx.wv;
  const int nt = u & 15, bgj = u >> 4, bg = bgj >> 1, j = bgj & 1, b = bg >> 1, g = bg & 1;
  const int nrow = min(nt * 32 + r32, 510);
  const bf16_t* xf = (const bf16_t*)(p.ws + OFF_HB) + ((size_t)(30 + j * 2 + g) * M_ + (size_t)b * T_) * 64 + (size_t)nrow * 1024;
  const bf16_t* W1T = (const bf16_t*)(p.ws + OFF_W1T) + (size_t)(layer * 2 + j) * 64 * 2048;
  f32x16 acc[2]; acc[0] = f32x16{}; acc[1] = f32x16{};
#pragma unroll 4
  for (int ks = 0; ks < 16; ++ks) { const int i0 = 256 * wid + 16 * ks + 8 * hi;
    const bf16x8 bx = *reinterpret_cast<const bf16x8*>(xf + i0);
    const bf16x8 a0 = *reinterpret_cast<const bf16x8*>(W1T + (size_t)r32 * 2048 + i0), a1 = *reinterpret_cast<const bf16x8*>(W1T + (size_t)(32 + r32) * 2048 + i0);
    acc[0] = MX_MFMA(a0, bx, acc[0]); acc[1] = MX_MFMA(a1, bx, acc[1]); }
  float* red = (float*)lds;
#pragma unroll
  for (int fb = 0; fb < 2; ++fb)
#pragma unroll
    for (int r = 0; r < 16; ++r) red[((wid * 2 + fb) * 16 + r) * 64 + lane] = acc[fb][r];
  MX_WAIT_ALL();
  if (wid == 0) {
    const float* c1 = (const float*)(p.ws + OFF_C1) + (layer * 2 + j) * 64;
    bf16x8 hb[2][2];
#pragma unroll
    for (int fb = 0; fb < 2; ++fb) { float hv[16];
#pragma unroll
      for (int r = 0; r < 16; ++r) { float a = c1[32 * fb + att::crow(r, hi)];
#pragma unroll
        for (int w = 0; w < 8; ++w) a += red[((w * 2 + fb) * 16 + r) * 64 + lane];
        hv[r] = gelu_tanh(a); }
#pragma unroll
      for (int s2 = 0; s2 < 2; ++s2) { const u32x4 w = (u32x4){att::cvtpk(hv[8 * s2], hv[8 * s2 + 1]), att::cvtpk(hv[8 * s2 + 2], hv[8 * s2 + 3]), att::cvtpk(hv[8 * s2 + 4], hv[8 * s2 + 5]), att::cvtpk(hv[8 * s2 + 6], hv[8 * s2 + 7])};
        hb[fb][s2] = __builtin_bit_cast(bf16x8, w); } }
    const float* w2 = p.cmp_w2 + (size_t)(layer * 2 + j) * 4096;
    f32x16 oc[2]; oc[0] = f32x16{}; oc[1] = f32x16{};
#pragma unroll
    for (int eb = 0; eb < 2; ++eb)
#pragma unroll
      for (int fb = 0; fb < 2; ++fb)
#pragma unroll
        for (int s2 = 0; s2 < 2; ++s2) { float wv[8];
#pragma unroll
          for (int jj = 0; jj < 8; ++jj) wv[jj] = w2[(32 * fb + 16 * s2 + 8 * (jj >> 2) + 4 * hi + (jj & 3)) * 64 + 32 * eb + r32];
          const u32x4 aw = (u32x4){pk2(wv[0], wv[1]), pk2(wv[2], wv[3]), pk2(wv[4], wv[5]), pk2(wv[6], wv[7])};
          oc[eb] = MX_MFMA(__builtin_bit_cast(bf16x8, aw), hb[fb][s2], oc[eb]); }
    if (j == 0) { float ss = 0.f;
#pragma unroll
      for (int eb = 0; eb < 2; ++eb)
#pragma unroll
        for (int r = 0; r < 16; ++r) ss += oc[eb][r] * oc[eb][r];
      ss += __shfl_xor(ss, 32);
      const float rs = rsqrtf(ss * (1.f / 64.f) + EPS);
#pragma unroll
      for (int eb = 0; eb < 2; ++eb)
#pragma unroll
        for (int r = 0; r < 16; ++r) oc[eb][r] *= rs * p.k_gain[(layer * 3 + 0) * 64 + 32 * eb + att::crow(r, hi)]; }
    bf16_t* dst = (bf16_t*)(p.ws + (j == 0 ? OFF_KC : OFF_VC)) + ((size_t)bg * 512 + nt * 32 + r32) * 64;
    const bool real = (nt * 32 + r32) < 511;
    if (real) {
#pragma unroll
      for (int eb = 0; eb < 2; ++eb)
#pragma unroll
        for (int r = 0; r < 16; ++r) dst[32 * eb + att::crow(r, hi)] = f2bf(oc[eb][r]); }
  }
  MX_WAIT_ALL();
}
#undef MX_MFMA
}

__device__ __forceinline__ void ph_mix1(const Cx& cx, const P& p, int layer, char* lds, int rank, int nranks) {
  for (int item = rank; item < 128 + 384; item += nranks) {
    Cx c2 = cx; c2.tid = cx.wv * 64 + lane_id(); asm volatile("" : "+v"(c2.tid));
    if (item < 128) mx::cmp_unit(c2, p, layer, item, lds); else mx::ret_kv_unit(c2, p, item - 128, lds);
  }
}
__device__ __forceinline__ void ph_mix2(const Cx& cx, const P& p, int layer, char* lds) {
  for (int u = cx.bid; u < 256; u += cx.G) { Cx c2 = cx; c2.tid = cx.wv * 64 + lane_id(); asm volatile("" : "+v"(c2.tid)); topk_unit(c2, p, u, lds); }
  { Cx c3 = cx; c3.bid = cx.G - 1 - cx.bid; mx::ret_scan(c3, p); }
  if (layer == 0) convert_weights(p, (LAS unsigned char*)lds, cx.wv, lane_id(), cx.bid * 8 + cx.wv, cx.G * 8, 6400, 8576);
}
__device__ __forceinline__ void ph_mix3(const Cx& cx, const P& p, int layer, char* lds) {
  const int nconv = (layer == 0) ? 148 : 0;
  unsigned* ctr = (unsigned*)(p.ws + OFF_CTR) + layer * 64;
  int* slot = (int*)(lds + 131072);
  for (;;) {
    __syncthreads();
    if (cx.wv == 0 && lane_id() == 0) *slot = (int)atomicAdd(ctr, 1u);
    __syncthreads();
    const int item = __builtin_amdgcn_readfirstlane(*slot);
    if (item >= 384 + 384 + 512 + nconv) break;
    Cx c2 = cx; c2.tid = cx.wv * 64 + lane_id(); asm volatile("" : "+v"(c2.tid));
    if (item < 384) nsa_unit(c2, p, item, lds); else if (item < 768) mx::ret_out_unit(c2, p, item - 384, lds);
    else if (item < 1280) mx::gmlp_unit(c2, p, layer, item - 768, lds);
    else { const int c0 = 1664 + (item - 1280) * 32; convert_weights(p, (LAS unsigned char*)lds, cx.wv, lane_id(), cx.wv, 8, c0, min(c0 + 32, 6400)); }
  }
}
typedef unsigned gu32_t;
#define XB_TMO      128
#define XB_XCNT(j)  (256  + 64 * (j))
#define XB_XSUB(j)  (1280 + 64 * (j))
#define XB_XGEN(j)  (2304 + 64 * (j))
#define XB_TOP      3328
#define XB_TOPGEN   3392
#define XCD_BAR_WORDS 3456
#define XB_SPIN_CAP (1u << 18)

__device__ __forceinline__ unsigned xb_ld(unsigned* p)              { return __hip_atomic_load(p, __ATOMIC_RELAXED, __HIP_MEMORY_SCOPE_AGENT); }
__device__ __forceinline__ unsigned xb_add(unsigned* p, unsigned v) { return __hip_atomic_fetch_add(p, v, __ATOMIC_RELAXED, __HIP_MEMORY_SCOPE_AGENT); }
__device__ __forceinline__ unsigned xb_xcc_id() { return (unsigned)__builtin_amdgcn_s_getreg((3 << 11) | 20) & 0xFu; }
#define XB_SPIN(cond, bar) do { unsigned _sp = 0; while (cond) { __builtin_amdgcn_s_sleep(1); \
    if ((++_sp & 255u) == 0u) { if (xb_ld(&(bar)[XB_TMO])) break; if (_sp > XB_SPIN_CAP) { atomicAdd(&(bar)[XB_TMO], 1u); break; } } } } while (0)

struct XcdBarrier {
    unsigned* bar; unsigned x;
    volatile LAS unsigned* st;
    int wv;
};

__device__ __forceinline__ XcdBarrier xcd_barrier_post(unsigned* bar, volatile LAS unsigned* st, int wv) {
    XcdBarrier b; b.bar = bar; b.x = xb_xcc_id(); b.st = st; b.wv = wv;
    if (wv == 0 && lane_id() == 0) (void)xb_add(&bar[XB_XCNT(b.x)], 1u);
    return b;
}
__device__ __forceinline__ void xcd_barrier_complete(unsigned* bar, unsigned x, unsigned& nloc, unsigned& nx) {
    const unsigned G = gridDim.x * gridDim.y * gridDim.z;
    unsigned sum, cnt, mine, sp = 0u;
    for (;;) {
        sum = 0u; cnt = 0u; mine = 0u;
#pragma unroll
        for (unsigned j = 0; j < 16; ++j) { const unsigned c = xb_ld(&bar[XB_XCNT(j)]); sum += c; cnt += (c > 0u) ? 1u : 0u; mine = (j == x) ? c : mine; }
        if (sum == G) break;
        __builtin_amdgcn_s_sleep(1);
        if ((++sp & 255u) == 0u) { if (xb_ld(&bar[XB_TMO])) break; if (sp > XB_SPIN_CAP) { atomicAdd(&bar[XB_TMO], 1u); break; } }
    }
    nloc = mine > 0u ? mine : 1u; nx = cnt > 0u ? cnt : 1u;
}

__device__ __forceinline__ void xcd_barrier(const XcdBarrier& b) {
    asm volatile("s_waitcnt vmcnt(0)" ::: "memory");
    __syncthreads();
    if (b.wv == 0 && lane_id() == 0) {
        unsigned* bar = b.bar;
        __builtin_amdgcn_s_waitcnt(0);
        unsigned nloc = b.st[0], nx = b.st[1];
        if (nloc == 0u) { xcd_barrier_complete(bar, b.x, nloc, nx); b.st[0] = nloc; b.st[1] = nx; }
        const unsigned old = xb_add(&bar[XB_XSUB(b.x)], 1u);
        const unsigned gen = old / nloc;
        if (old + 1u == (gen + 1u) * nloc) {
            __builtin_amdgcn_fence(__ATOMIC_RELEASE, "agent");
            asm volatile("s_waitcnt vmcnt(0)" ::: "memory");
            const unsigned og = xb_add(&bar[XB_TOP], 1u);
            const unsigned tg = og / nx;
            if (og + 1u == (tg + 1u) * nx) xb_add(&bar[XB_TOPGEN], 1u);
            else XB_SPIN(xb_ld(&bar[XB_TOPGEN]) == tg, bar);
            __builtin_amdgcn_fence(__ATOMIC_ACQUIRE, "agent");
            xb_add(&bar[XB_XGEN(b.x)], 1u);
            asm volatile("s_waitcnt vmcnt(0)" ::: "memory");
        } else {
            XB_SPIN(xb_ld(&bar[XB_XGEN(b.x)]) == gen, bar);
            __builtin_amdgcn_fence(__ATOMIC_ACQUIRE, "agent");
            asm volatile("s_waitcnt vmcnt(0)" ::: "memory");
        }
    }
    __syncthreads();
}

__global__ void __launch_bounds__(NTHR, 2) k_mega(P pk) {
  extern __shared__ __attribute__((aligned(16))) unsigned char lds_raw[];
  LAS unsigned char* lds = (LAS unsigned char*)lds_raw;
  float* sm = (float*)lds_raw;
  const int wave_s = __builtin_amdgcn_readfirstlane((int)threadIdx.x >> 6);
  { volatile LAS unsigned* bst = (volatile LAS unsigned*)(lds + 131072 + 64);
    if (threadIdx.x < 2) bst[threadIdx.x] = 0u;
    __syncthreads();
    (void)xcd_barrier_post((unsigned*)(pk.ws + OFF_BAR), bst, wave_s); }
#define GSYNC() do { kargp_t kb_ = (kargp_t)__builtin_amdgcn_kernarg_segment_ptr(); asm volatile("" : "+s"(kb_)); XcdBarrier xb_; xb_.bar = (unsigned*)(kb_->ws + OFF_BAR); xb_.x = xb_xcc_id(); \
    xb_.st = (volatile LAS unsigned*)(lds + 131072 + 64); xb_.wv = wave_s; xcd_barrier(xb_); } while (0)
#define LOADP(p, k) do { p.x = k->x; p.attn_norm = k->attn_norm; p.w_in = k->w_in; p.w_out = k->w_out; p.q_gain = k->q_gain; p.k_gain = k->k_gain; p.cmp_pe = k->cmp_pe; p.cmp_w1 = k->cmp_w1; p.cmp_w2 = k->cmp_w2; \
    p.gm_ws = k->gm_ws; p.gm_b = k->gm_b; p.ffn_norm = k->ffn_norm; p.w_gu = k->w_gu; p.w_down = k->w_down; p.rel_bias = k->rel_bias; p.out = k->out; p.ws = k->ws; } while (0)
  typedef const __attribute__((address_space(4))) P* kargp_t;
#define PB Cx cx; P p; { int t_ = wave_s * 64 + lane_id(), b_ = blockIdx.x; kargp_t k_ = (kargp_t)__builtin_amdgcn_kernarg_segment_ptr(); asm volatile("" : "+v"(t_), "+s"(b_), "+s"(k_)); LOADP(p, k_); cx.tid = t_; cx.bid = b_; cx.G = gridDim.x; cx.wv = wave_s; }
  { PB; ph_prologue(cx, p, lds); }
  GSYNC();
#pragma unroll 1
  for (int layer = 0; layer < 2; ++layer) {
    { PB; pg8::Gemm g{(const bf16_t*)(p.ws + OFF_XB), (const bf16_t*)(p.ws + OFF_WIN) + (size_t)layer * NPROJ * D_, M_, 3072, D_}; pg8::StaticOrder S; S.init(M_, 3072, cx.G, cx.bid);
      EpiProj E{(const float*)(p.ws + OFF_SSQ), (bf16_t*)(p.ws + OFF_HB), (float*)(p.ws + OFF_GATES), (const float2*)(p.ws + OFF_ROPE), p.q_gain + layer * 64, p.k_gain + layer * 192};
      pg8::gemm_phase<EpiProj, pg8::StaticOrder, PG8_ALIGN, PG8_SP2>(lds, g, S, E, cx.tid); }
    GSYNC();
    { PB; if (cx.bid < 64) {
        pg8::Gemm g2{(const bf16_t*)(p.ws + OFF_XB), (const bf16_t*)(p.ws + OFF_WIN) + (size_t)layer * NPROJ * D_, M_, NPROJ, D_}; pg8::OneUnit S2{cx.bid, 12, true};
        EpiProj E{(const float*)(p.ws + OFF_SSQ), (bf16_t*)(p.ws + OFF_HB), (float*)(p.ws + OFF_GATES), (const float2*)(p.ws + OFF_ROPE), p.q_gain + layer * 64, p.k_gain + layer * 192};
        pg8::gemm_phase<EpiProj, pg8::OneUnit, false, PG8_SP2>(lds, g2, S2, E, cx.tid);
      } else ph_mix1(cx, p, layer, (char*)lds_raw, cx.bid - 64, cx.G - 64); }
    GSYNC();
    { PB; ph_mix2(cx, p, layer, (char*)lds_raw); } GSYNC();
    { PB; ph_mix3(cx, p, layer, (char*)lds_raw); } GSYNC();
    { PB; pg8::Gemm g{(const bf16_t*)(p.ws + OFF_MIX), (const bf16_t*)(p.ws + OFF_WO) + (size_t)layer * D_ * D_, M_, D_, D_}; pg8::StaticOrder S; S.init(M_, D_, cx.G, cx.bid);
      EpiRes E{(layer == 0) ? p.x : nullptr, nullptr, (bf16_t*)(p.ws + OFF_XB), (float*)(p.ws + OFF_SSQ)};
      pg8::gemm_phase<EpiRes, pg8::StaticOrder, PG8_ALIGN, PG8_SP2>(lds, g, S, E, cx.tid); }
    GSYNC();
    { PB; pg8::Gemm g{(const bf16_t*)(p.ws + OFF_XB), (const bf16_t*)(p.ws + OFF_WGU) + (size_t)layer * 2 * DFF * D_, M_, 2 * DFF, D_}; pg8::StaticOrder S; S.init(M_, 2 * DFF, cx.G, cx.bid);
      EpiGU E{(const float*)(p.ws + OFF_SSQ), (bf16_t*)(p.ws + OFF_ACT)};
      pg8::gemm_phase<EpiGU, pg8::StaticOrder, PG8_ALIGN, PG8_SP2>(lds, g, S, E, cx.tid);
      { const int c0 = (cx.G > 128) ? 128 : 0; if (layer == 0 && cx.bid >= c0) convert_weights(p, lds, cx.wv, cx.tid & 63, (cx.bid - c0) * 8 + cx.wv, (cx.G - c0) * 8, 8576, 12800); } }
    GSYNC();
    { PB; pg8::Gemm g{(const bf16_t*)(p.ws + OFF_ACT), (const bf16_t*)(p.ws + OFF_WD) + (size_t)layer * D_ * DFF, M_, D_, DFF}; pg8::StaticOrder S; S.init(M_, D_, cx.G, cx.bid);
      EpiRes E{nullptr, (layer == 1) ? p.out : nullptr, (bf16_t*)(p.ws + OFF_XB), (float*)(p.ws + OFF_SSQ)};
      pg8::gemm_phase<EpiRes, pg8::StaticOrder, PG8_ALIGN, PG8_SP2>(lds, g, S, E, cx.tid); }
    GSYNC();
  }
}

extern "C" void kernel_launch(void* const* d_in, const int* in_sizes, int n_in, void* d_out, int out_size, void* d_ws, size_t ws_size, hipStream_t stream) {
  P p{};
  p.x = (const float*)d_in[0]; p.attn_norm = (const float*)d_in[1]; p.w_in = (const float*)d_in[2]; p.w_out = (const float*)d_in[3];
  p.q_gain = (const float*)d_in[4]; p.k_gain = (const float*)d_in[5]; p.cmp_pe = (const float*)d_in[6]; p.cmp_w1 = (const float*)d_in[7];
  p.cmp_w2 = (const float*)d_in[8]; p.gm_ws = (const float*)d_in[9]; p.gm_b = (const float*)d_in[10]; p.ffn_norm = (const float*)d_in[11];
  p.w_gu = (const float*)d_in[12]; p.w_down = (const float*)d_in[13]; p.rel_bias = (const float*)d_in[14];
  p.out = (float*)d_out; p.ws = (unsigned char*)d_ws;
  static int grid = 0;
  if (!grid) {
    (void)hipFuncSetAttribute((const void*)k_mega, hipFuncAttributeMaxDynamicSharedMemorySize, LDS_BYTES);
    int dev = 0, cus = 0, per_cu = 0;
    (void)hipGetDevice(&dev);
    (void)hipDeviceGetAttribute(&cus, hipDeviceAttributeMultiprocessorCount, dev);
    (void)hipOccupancyMaxActiveBlocksPerMultiprocessor(&per_cu, (const void*)k_mega, NTHR, LDS_BYTES);
    if (per_cu < 1) per_cu = 1;
    grid = cus;
  }
  (void)hipMemsetAsync((char*)d_ws + OFF_BAR, 0, 16384, stream);
  void* args[] = {&p};
  hipError_t e = hipLaunchCooperativeKernel((const void*)k_mega, dim3(grid), dim3(NTHR), args, LDS_BYTES, stream);
  if (e != hipSuccess) fprintf(stderr, "cooperative launch failed: %s (grid %d)\n", hipGetErrorString(e), grid);
}
```

```cpp
#include <hip/hip_runtime.h>
#include <hip/hip_cooperative_groups.h>
#include <stdint.h>
#include <stdio.h>
namespace cg = cooperative_groups;
namespace pg8 {
#define PG8_LAS __attribute__((address_space(3)))
typedef unsigned short bf16_t;
typedef short bf16x8 __attribute__((ext_vector_type(8)));
typedef float f32x4 __attribute__((ext_vector_type(4)));
typedef unsigned u32x4 __attribute__((ext_vector_type(4)));
constexpr int BM = 256, BK = 64, HALF = 128, HTB = HALF * BK * 2  , STAGE_BYTES = 8 * HTB, NXCD = 8, WGM = 8;

__host__ __device__ __forceinline__ int lds_byte(int r, int c) { const int st = (r >> 4) * 2 + (c >> 5), rr = r & 15, cc = c & 31, ob = rr * 64 + cc * 2; return st * 1024 + (ob ^ (((ob >> 9) & 1) << 5)); }
__host__ __device__ __forceinline__ void stage_rc(int b, int& R, int& C) { const int st = b / 1024, sb = b % 1024, swz = sb ^ (((sb >> 9) & 1) << 5); R = (st >> 1) * 16 + swz / 64; C = (st & 1) * 32 + (swz % 64) / 2; }
__host__ __device__ __forceinline__ int perm32(int rho) { const int n = rho >> 4, i = rho & 15; return 8 * (i >> 2) + 4 * n + (i & 3); }

struct Unit { int pm, pn; };
struct Gemm { const bf16_t* A; const bf16_t* Bt; int M, N, K; };

struct StaticOrder {
    int nM, nN, nwg, G, c;
    __host__ __device__ void init(int M, int N, int G_, int c_) { nM = M / BM; nN = N / BM; nwg = nM * nN; G = G_; c = c_; }
    __host__ __device__ bool next(int i, Unit& u) const {
        const long L = (long)i * G + c; if (L >= nwg) return false;
        int wgid = (int)L; { const int q = nwg / NXCD, r = nwg % NXCD, xcd = wgid % NXCD, off = wgid / NXCD; wgid = (xcd < r ? xcd * (q + 1) : r * (q + 1) + (xcd - r) * q) + off; }
        const int nig = WGM * nN, gid = wgid / nig, fm = gid * WGM, gsz = (nM - fm) < WGM ? (nM - fm) : WGM;
        u.pm = fm + ((wgid % nig) % gsz); u.pn = (wgid % nig) / gsz; return true;
    }
    __device__ __forceinline__ void a_ready(const Unit&) const {}
    __device__ __forceinline__ void done(const Unit&) const {}
};

struct OneUnit {
    int pm, pn; bool have;
    __host__ __device__ bool next(int i, Unit& u) const { if (i > 0 || !have) return false; u.pm = pm; u.pn = pn; return true; }
    __device__ __forceinline__ void a_ready(const Unit&) const {}
    __device__ __forceinline__ void done(const Unit&) const {}
};
__device__ __forceinline__ unsigned cvt_pk_bf16(float lo, float hi) { unsigned r; asm volatile("v_cvt_pk_bf16_f32 %0, %1, %2" : "=v"(r) : "v"(lo), "v"(hi)); return r; }
typedef float f32x2 __attribute__((ext_vector_type(2)));
template <class Epi, class Sched, bool ALIGN_EPI = false, bool SP2 = false>
__device__ __forceinline__ void gemm_phase(PG8_LAS unsigned char* lds, const Gemm g, const Sched& S, const Epi& E, const int tid) {
    const int wid = __builtin_amdgcn_readfirstlane(tid >> 6), lane = tid & 63, wr = wid >> 2, wc = wid & 3, fr = lane & 15, fq = lane >> 4;
    const int K = g.K, nt = K / BK;
    unsigned voffA[2], voffB[2];
#pragma unroll
    for (int i = 0; i < 2; ++i) { int R, C; stage_rc(tid * 16 + i * 8192, R, C); const int Rb = Epi::PERM ? ((R & ~31) + perm32(R & 31)) : R;
        voffA[i] = (unsigned)(R * K + C) * 2u; voffB[i] = (unsigned)(Rb * K + C) * 2u; }
    const size_t kstep = (size_t)(BK * 2);
    const size_t hstep = (size_t)HALF * K * 2;
    const size_t tstep = 2 * hstep;
    const unsigned ldsw = (unsigned)wid * 1024u;
    const int aoff = lds_byte(wr * 64 + fr, fq * 8), boff = lds_byte(wc * 32 + fr, fq * 8);
#define PG8_SA(b, h) (((b) * 2 + (h)) * HTB)
#define PG8_SB(b, h) ((4 + (b) * 2 + (h)) * HTB)
#define PG8_STAGE(bufoff, gbase, voff) do { _Pragma("unroll") for (int _i = 0; _i < 2; ++_i) \
        __builtin_amdgcn_global_load_lds((const unsigned*)((const char*)(gbase) + (voff)[_i]), (PG8_LAS unsigned*)(lds + (bufoff) + ldsw + _i * 8192), 16, 0, 0); } while (0)
#define PG8_LDA(dst, b, h) do { _Pragma("unroll") for (int m = 0; m < 4; ++m) _Pragma("unroll") for (int k = 0; k < 2; ++k) dst[m][k] = *(const PG8_LAS bf16x8*)(lds + PG8_SA(b, h) + aoff + m * 2048 + k * 1024); } while (0)
#define PG8_LDB(dst, b, h) do { _Pragma("unroll") for (int n = 0; n < 2; ++n) _Pragma("unroll") for (int k = 0; k < 2; ++k) dst[n][k] = *(const PG8_LAS bf16x8*)(lds + PG8_SB(b, h) + boff + n * 2048 + k * 1024); } while (0)
#define PG8_MMA(ai, bj, At, Bt) do { __builtin_amdgcn_s_setprio(1); _Pragma("unroll") for (int m = 0; m < 4; ++m) _Pragma("unroll") for (int n = 0; n < 2; ++n) _Pragma("unroll") for (int k = 0; k < 2; ++k) \
        acc[ai][bj][m][n] = __builtin_amdgcn_mfma_f32_16x16x32_bf16(Bt[n][k], At[m][k], acc[ai][bj][m][n], 0, 0, 0); __builtin_amdgcn_s_setprio(0); } while (0)
#define PG8_WAIT_V(n) asm volatile("s_waitcnt vmcnt(" #n ")" ::: "memory")
#define PG8_WAIT_L(n) asm volatile("s_waitcnt lgkmcnt(" #n ")" ::: "memory")
#define PG8_BAR __builtin_amdgcn_s_barrier()
#define PG8_SCHED __builtin_amdgcn_sched_barrier(0)
    Unit cur, nxt; int ui = 0;
    if (!S.next(0, cur)) return;
    f32x4 acc[2][2][4][2];
#pragma unroll
    for (int a = 0; a < 2; ++a)
#pragma unroll
        for (int b = 0; b < 2; ++b)
#pragma unroll
            for (int m = 0; m < 4; ++m)
#pragma unroll
                for (int n = 0; n < 2; ++n) acc[a][b][m][n] = (f32x4){0.f, 0.f, 0.f, 0.f};
    bf16x8 At[4][2], B0[2][2], B1[2][2];
    const char* cA = (const char*)g.A + (size_t)cur.pm * tstep; const char* cB = (const char*)g.Bt + (size_t)cur.pn * tstep;
    S.a_ready(cur);
    if constexpr (SP2) {
        PG8_STAGE(PG8_SB(0, 0), cB, voffB); PG8_STAGE(PG8_SB(0, 1), cB + hstep, voffB); PG8_STAGE(PG8_SA(0, 0), cA, voffA); PG8_STAGE(PG8_SA(0, 1), cA + hstep, voffA);
        if (wr == 1) PG8_BAR;
        PG8_WAIT_V(2); PG8_BAR;
        PG8_STAGE(PG8_SB(1, 0), cB + kstep, voffB); PG8_STAGE(PG8_SA(1, 0), cA + kstep, voffA); PG8_STAGE(PG8_SB(1, 1), cB + hstep + kstep, voffB);
        PG8_WAIT_V(6); PG8_BAR;
    } else {
        PG8_STAGE(PG8_SB(0, 0), cB, voffB); PG8_STAGE(PG8_SA(0, 0), cA, voffA); PG8_STAGE(PG8_SB(0, 1), cB + hstep, voffB); PG8_STAGE(PG8_SA(0, 1), cA + hstep, voffA);
        if (wr == 1) PG8_BAR;
        PG8_WAIT_V(4); PG8_BAR;
        PG8_STAGE(PG8_SB(1, 0), cB + kstep, voffB); PG8_STAGE(PG8_SA(1, 0), cA + kstep, voffA); PG8_STAGE(PG8_SB(1, 1), cB + hstep + kstep, voffB);
        PG8_WAIT_V(6); PG8_BAR;
    }
    for (;;) {
        const bool has_next = S.next(ui + 1, nxt);
        const char* nA = has_next ? (const char*)g.A + (size_t)nxt.pm * tstep : cA; const char* nB = has_next ? (const char*)g.Bt + (size_t)nxt.pn * tstep : cB;
        for (int t = 0; t < nt; t += 2) {
            const bool last = (t == nt - 2);
            const char* a1 = cA + (size_t)(t + 1) * kstep;
            const char* a2 = last ? nA : cA + (size_t)(t + 2) * kstep; const char* b2 = last ? nB : cB + (size_t)(t + 2) * kstep;
            const char* a3 = a2 + kstep; const char* b3 = b2 + kstep;
            if (last && has_next) S.a_ready(nxt);
            if constexpr (SP2) {
            PG8_LDB(B0, 0, 0); PG8_LDB(B1, 0, 1); PG8_SCHED; PG8_LDA(At, 0, 0); PG8_STAGE(PG8_SA(1, 1), a1 + hstep, voffA);
            PG8_WAIT_V(8); PG8_WAIT_L(0); PG8_BAR; PG8_MMA(0, 0, At, B0); PG8_MMA(0, 1, At, B1); PG8_BAR; PG8_SCHED;
            PG8_LDA(At, 0, 1); PG8_STAGE(PG8_SB(0, 0), b2, voffB); PG8_STAGE(PG8_SB(0, 1), b2 + hstep, voffB); PG8_STAGE(PG8_SA(0, 0), a2, voffA);
            PG8_WAIT_V(8); PG8_WAIT_L(0); PG8_BAR; PG8_MMA(1, 0, At, B0); PG8_MMA(1, 1, At, B1); PG8_BAR; PG8_SCHED;
            PG8_LDB(B0, 1, 0); PG8_LDB(B1, 1, 1); PG8_SCHED; PG8_LDA(At, 1, 0); PG8_STAGE(PG8_SA(0, 1), a2 + hstep, voffA);
            PG8_WAIT_V(8); PG8_WAIT_L(0); PG8_BAR; PG8_MMA(0, 0, At, B0); PG8_MMA(0, 1, At, B1); PG8_BAR; PG8_SCHED;
            PG8_LDA(At, 1, 1); PG8_STAGE(PG8_SB(1, 0), b3, voffB); PG8_STAGE(PG8_SB(1, 1), b3 + hstep, voffB); PG8_STAGE(PG8_SA(1, 0), a3, voffA);
            PG8_WAIT_V(8); PG8_WAIT_L(0); PG8_BAR; PG8_MMA(1, 0, At, B0); PG8_MMA(1, 1, At, B1); PG8_BAR; PG8_SCHED;
            } else {
            PG8_LDB(B0, 0, 0); PG8_SCHED; PG8_LDA(At, 0, 0); PG8_STAGE(PG8_SA(1, 1), a1 + hstep, voffA);
            PG8_WAIT_L(8); PG8_BAR; PG8_WAIT_L(0); PG8_MMA(0, 0, At, B0); PG8_BAR; PG8_SCHED;
            PG8_LDB(B1, 0, 1); PG8_STAGE(PG8_SB(0, 0), b2, voffB);
            PG8_BAR; PG8_WAIT_L(0); PG8_MMA(0, 1, At, B1); PG8_BAR;
            PG8_LDA(At, 0, 1); PG8_STAGE(PG8_SA(0, 0), a2, voffA);
            PG8_BAR; PG8_WAIT_L(0); PG8_MMA(1, 0, At, B0); PG8_BAR; PG8_SCHED;
            PG8_STAGE(PG8_SB(0, 1), b2 + hstep, voffB);
            PG8_WAIT_V(6); PG8_BAR; PG8_MMA(1, 1, At, B1); PG8_BAR;
            PG8_LDB(B0, 1, 0); PG8_SCHED; PG8_LDA(At, 1, 0); PG8_STAGE(PG8_SA(0, 1), a2 + hstep, voffA);
            PG8_WAIT_L(8); PG8_BAR; PG8_WAIT_L(0); PG8_MMA(0, 0, At, B0); PG8_BAR; PG8_SCHED;
            PG8_LDB(B1, 1, 1); PG8_STAGE(PG8_SB(1, 0), b3, voffB);
            PG8_BAR; PG8_WAIT_L(0); PG8_MMA(0, 1, At, B1); PG8_BAR;
            PG8_LDA(At, 1, 1); PG8_STAGE(PG8_SA(1, 0), a3, voffA);
            PG8_BAR; PG8_WAIT_L(0); PG8_MMA(1, 0, At, B0); PG8_BAR; PG8_SCHED;
            PG8_STAGE(PG8_SB(1, 1), b3 + hstep, voffB);
            PG8_WAIT_V(6); PG8_BAR; PG8_MMA(1, 1, At, B1); PG8_BAR;
            }
        }
        if constexpr (ALIGN_EPI) { if (wr == 0) PG8_BAR; }
        if constexpr (!Epi::AFTER_DRAIN) { E(acc, cur, wr, wc, fr, fq); S.done(cur); }
        if (!has_next) break;
#pragma unroll
        for (int a = 0; a < 2; ++a)
#pragma unroll
            for (int b = 0; b < 2; ++b)
#pragma unroll
                for (int m = 0; m < 4; ++m)
#pragma unroll
                    for (int n = 0; n < 2; ++n) acc[a][b][m][n] = (f32x4){0.f, 0.f, 0.f, 0.f};
        cur = nxt; cA = nA; cB = nB; ++ui;
        if constexpr (ALIGN_EPI) { if (wr == 1) PG8_BAR; }
    }
    PG8_WAIT_V(0);
    if constexpr (!ALIGN_EPI) { if (wr == 0) PG8_BAR; }
    PG8_BAR;
    if constexpr (Epi::AFTER_DRAIN) { E.fused(acc, cur, wr, wc, fr, fq, lds, wid, lane); S.done(cur); }
#undef PG8_SA
#undef PG8_SB
#undef PG8_STAGE
#undef PG8_LDA
#undef PG8_LDB
#undef PG8_MMA
#undef PG8_WAIT_V
#undef PG8_WAIT_L
#undef PG8_BAR
#undef PG8_SCHED
}
}

#ifndef PG8_SP2
#define PG8_SP2 true
#endif
#ifndef PG8_ALIGN
#define PG8_ALIGN true
#endif

typedef unsigned short bf16_t;
typedef float f32x4 __attribute__((ext_vector_type(4)));
typedef unsigned u32x4 __attribute__((ext_vector_type(4)));
#define LAS __attribute__((address_space(3)))

#define T_ 8192
#define M_ 16384
#define D_ 1024
#define INW 3218
#define NPROJ 3328
#define DFF 2816
#define EPS 1e-6f
#define NTHR 512

struct Cx { int tid, bid, G, wv; };
__device__ __forceinline__ int lane_id() { int l; asm volatile("v_mbcnt_lo_u32_b32 %0, -1, 0\n\tv_mbcnt_hi_u32_b32 %0, -1, %0" : "=v"(l)); return l; }
struct P {
  const float *x, *attn_norm, *w_in, *w_out, *q_gain, *k_gain, *cmp_pe, *cmp_w1, *cmp_w2, *gm_ws, *gm_b, *ffn_norm, *w_gu, *w_down, *rel_bias;
  float* out; unsigned char* ws;
};

constexpr size_t MiB = 1u << 20;
constexpr size_t OFF_HB = 0;
constexpr size_t OFF_ACT = 0;
constexpr size_t OFF_MIX = 100 * MiB;
constexpr size_t OFF_GATES = 132 * MiB;
constexpr size_t OFF_KC = 134 * MiB;
constexpr size_t OFF_VC = 134 * MiB + 512 * 1024;
constexpr size_t OFF_RS = 135 * MiB;
constexpr size_t OFF_ROPE = 148 * MiB;
constexpr size_t OFF_WIN = 152 * MiB;
constexpr size_t OFF_WO = 165 * MiB;
constexpr size_t OFF_WGU = 169 * MiB;
constexpr size_t OFF_WD = 191 * MiB;
constexpr size_t OFF_XB = 204 * MiB;
constexpr size_t OFF_SSQ = 236 * MiB;
constexpr size_t OFF_SELQ = 237 * MiB;
constexpr size_t OFF_CTR = 238 * MiB;
constexpr size_t OFF_BAR = 238 * MiB + 65536;
constexpr size_t OFF_RT = 239 * MiB;
constexpr size_t OFF_W1T = 245 * MiB;
constexpr size_t OFF_C1 = 246 * MiB;
constexpr size_t OFF_WSB = 246 * MiB + 65536;
constexpr size_t OFF_BTAB = 247 * MiB;

constexpr int LDS_BYTES = 147456;

__device__ __forceinline__ float bf2f(bf16_t v) { return __uint_as_float(((unsigned)v) << 16); }
__device__ __forceinline__ bf16_t f2bf(float f) { unsigned u = __float_as_uint(f); u += 0x7fffu + ((u >> 16) & 1u); return (bf16_t)(u >> 16); }
__device__ __forceinline__ unsigned pk2(float lo, float hi) { unsigned r; asm("v_cvt_pk_bf16_f32 %0, %1, %2" : "=v"(r) : "v"(lo), "v"(hi)); return r; }
__device__ __forceinline__ float gelu_tanh(float x) { const float y = -2.3022082f * (x + 0.044715f * x * x * x); return x * __builtin_amdgcn_rcpf(1.f + __builtin_amdgcn_exp2f(y)); }
__device__ __forceinline__ float sigmoidf(float x) { return __builtin_amdgcn_rcpf(1.f + __builtin_amdgcn_exp2f(-1.4426950408889634f * x)); }
#define rsqrtf(x) __builtin_amdgcn_rsqf(x)
__device__ __forceinline__ float wave_sum(float v) {
#pragma unroll
  for (int o = 1; o < 64; o <<= 1) v += __shfl_xor(v, o);
  return v;
}
__device__ __forceinline__ float wave_max(float v) {
#pragma unroll
  for (int o = 1; o < 64; o <<= 1) v = fmaxf(v, __shfl_xor(v, o));
  return v;
}
__device__ __forceinline__ int t5_bucket(int n) {
  if (n < 16) return n;
  int b = 16;
  b += (n >= 19); b += (n >= 21); b += (n >= 24); b += (n >= 27); b += (n >= 31); b += (n >= 35); b += (n >= 40); b += (n >= 46);
  b += (n >= 52); b += (n >= 59); b += (n >= 67); b += (n >= 77); b += (n >= 87); b += (n >= 99); b += (n >= 113);
  return b;
}
#define WSYNC() do { __builtin_amdgcn_fence(__ATOMIC_RELEASE, "wavefront"); __builtin_amdgcn_wave_barrier(); __builtin_amdgcn_fence(__ATOMIC_ACQUIRE, "wavefront"); } while (0)

__device__ __forceinline__ int proj_col0(int g) { return (g < 42) ? 64 * g : 2706 + 64 * (g - 42); }
__device__ __forceinline__ float row_rstd(const float* ssq, int row, int fq) {
  const f32x4 s = *(const f32x4*)(ssq + (size_t)row * 16 + 4 * fq);
  float t = (s[0] + s[1]) + (s[2] + s[3]);
  t += __shfl_xor(t, 16); t += __shfl_xor(t, 32);
  return rsqrtf(t * (1.f / D_) + EPS);
}
struct EpiProj {
  static constexpr bool PERM = true, AFTER_DRAIN = false;
  const float* ssq; bf16_t* HB; float* gates; const float2* rope; const float* q_gain; const float* k_gain;
  __device__ __forceinline__ void operator()(const f32x4 (&acc)[2][2][4][2], const pg8::Unit& u, int wr, int wc, int fr, int fq) const {
    const int gidx = u.pn * 4 + wc;
    if (gidx > 50) return;
    int type; float sc = 1.f; const float* gn = nullptr;
    float dec_l2 = 0.f;
    if (gidx < 12) { type = 0; sc = (gidx >= 6) ? 0.125f : 1.f; const float lg2 = log2f(1.f - exp2f(-5.f - (float)(gidx % 6))); dec_l2 = (gidx >= 6) ? -lg2 : lg2; }
    else if (gidx < 24) type = 1;
    else if (gidx < 30) { type = 2; gn = q_gain; sc = 0.125f * 1.4426950408889634f; }
    else if (gidx == 34 || gidx == 35) { type = 2; gn = k_gain + 64; }
    else if (gidx == 38 || gidx == 39) { type = 2; gn = k_gain + 128; }
    else if (gidx < 42) type = 1;
    else if (gidx < 46) type = 3;
    else if (gidx < 50) type = 4;
    else type = 5;
    float gv[2][8];
#pragma unroll
    for (int bj = 0; bj < 2; ++bj)
#pragma unroll
      for (int i = 0; i < 8; ++i) gv[bj][i] = (type == 2) ? gn[32 * bj + 8 * fq + i] * sc : 1.f;
#pragma unroll
    for (int ai = 0; ai < 2; ++ai)
#pragma unroll
      for (int m = 0; m < 4; ++m) {
        const int row = u.pm * 256 + ai * 128 + wr * 64 + m * 16 + fr;
        const float rstd = row_rstd(ssq, row, fq);
        float v[2][8];
#pragma unroll
        for (int bj = 0; bj < 2; ++bj)
#pragma unroll
          for (int n = 0; n < 2; ++n)
#pragma unroll
            for (int e = 0; e < 4; ++e) v[bj][4 * n + e] = acc[ai][bj][m][n][e] * rstd;
        if (type == 0) {
          const float2* tb = rope + (size_t)(row & (T_ - 1)) * 32 + 8 * fq;
          const float scr = sc * exp2f((float)(row & 127) * dec_l2);
#pragma unroll
          for (int i = 0; i < 8; ++i) { const float2 cs = tb[i]; const float x1 = v[0][i], x2 = v[1][i]; v[0][i] = (x1 * cs.x - x2 * cs.y) * scr; v[1][i] = (x2 * cs.x + x1 * cs.y) * scr; }
        }
        if (type == 3 || type == 4) {
#pragma unroll
          for (int bj = 0; bj < 2; ++bj)
#pragma unroll
            for (int i = 0; i < 8; ++i) v[bj][i] = gelu_tanh(v[bj][i]);
        }
        if (type == 2 || type == 4) {
          float ss = 0.f;
#pragma unroll
          for (int bj = 0; bj < 2; ++bj)
#pragma unroll
            for (int i = 0; i < 8; ++i) ss += v[bj][i] * v[bj][i];
          ss += __shfl_xor(ss, 16); ss += __shfl_xor(ss, 32);
          const float rs = rsqrtf(ss * (1.f / 64.f) + EPS);
#pragma unroll
          for (int bj = 0; bj < 2; ++bj)
#pragma unroll
            for (int i = 0; i < 8; ++i) v[bj][i] = v[bj][i] * rs * gv[bj][i];
        }
        if (type == 5) {
          float* gp = gates + (size_t)row * 24 + 8 * fq;
#pragma unroll
          for (int i = 0; i < 8; ++i) if (8 * fq + i < 18) gp[i] = sigmoidf(v[0][i]);
        } else {
          bf16_t* dst = HB + ((size_t)gidx * M_ + row) * 64 + 8 * fq;
#pragma unroll
          for (int bj = 0; bj < 2; ++bj) { u32x4 w; w.x = pk2(v[bj][0], v[bj][1]); w.y = pk2(v[bj][2], v[bj][3]); w.z = pk2(v[bj][4], v[bj][5]); w.w = pk2(v[bj][6], v[bj][7]); *(u32x4*)(dst + 32 * bj) = w; }
        }
      }
  }
};
struct EpiRes {
  static constexpr bool PERM = true, AFTER_DRAIN = false;
  const float* xin32; float* xout32; bf16_t* xb; float* ssq;
  __device__ __forceinline__ void operator()(const f32x4 (&acc)[2][2][4][2], const pg8::Unit& u, int wr, int wc, int fr, int fq) const {
#pragma unroll
    for (int ai = 0; ai < 2; ++ai)
#pragma unroll
      for (int m = 0; m < 4; ++m) {
        const int row = u.pm * 256 + ai * 128 + wr * 64 + m * 16 + fr;
        float ss = 0.f;
#pragma unroll
        for (int bj = 0; bj < 2; ++bj) {
          const size_t o = (size_t)row * D_ + u.pn * 256 + bj * 128 + wc * 32 + 8 * fq;
          f32x4 x0, x1;
          if (xin32) { x0 = *(const f32x4*)(xin32 + o); x1 = *(const f32x4*)(xin32 + o + 4); }
          else { const u32x4 w = *(const u32x4*)(xb + o); x0 = (f32x4){__uint_as_float(w.x << 16), __uint_as_float(w.x & 0xffff0000u), __uint_as_float(w.y << 16), __uint_as_float(w.y & 0xffff0000u)};
                 x1 = (f32x4){__uint_as_float(w.z << 16), __uint_as_float(w.z & 0xffff0000u), __uint_as_float(w.w << 16), __uint_as_float(w.w & 0xffff0000u)}; }
          const f32x4 y0 = x0 + acc[ai][bj][m][0], y1 = x1 + acc[ai][bj][m][1];
          if (xout32) { *(f32x4*)(xout32 + o) = y0; *(f32x4*)(xout32 + o + 4) = y1; }
          else { u32x4 w; w.x = pk2(y0[0], y0[1]); w.y = pk2(y0[2], y0[3]); w.z = pk2(y1[0], y1[1]); w.w = pk2(y1[2], y1[3]); *(u32x4*)(xb + o) = w;
            ss += (y0[0] * y0[0] + y0[1] * y0[1]) + (y0[2] * y0[2] + y0[3] * y0[3]) + (y1[0] * y1[0] + y1[1] * y1[1]) + (y1[2] * y1[2] + y1[3] * y1[3]); }
        }
        if (!xout32) { ss += __shfl_xor(ss, 16); ss += __shfl_xor(ss, 32);
          if (fq == 0) ssq[(size_t)row * 16 + u.pn * 4 + wc] = ss; }
      }
  }
};
struct EpiGU {
  static constexpr bool PERM = true, AFTER_DRAIN = false;
  const float* ssq; bf16_t* act;
  __device__ __forceinline__ void operator()(const f32x4 (&acc)[2][2][4][2], const pg8::Unit& u, int wr, int wc, int fr, int fq) const {
#pragma unroll
    for (int ai = 0; ai < 2; ++ai)
#pragma unroll
      for (int m = 0; m < 4; ++m) {
        const int row = u.pm * 256 + ai * 128 + wr * 64 + m * 16 + fr;
        const float rstd = row_rstd(ssq, row, fq);
        float a[8];
#pragma unroll
        for (int n = 0; n < 2; ++n)
#pragma unroll
          for (int e = 0; e < 4; ++e) { const float g = acc[ai][0][m][n][e] * rstd, up = acc[ai][1][m][n][e] * rstd; a[4 * n + e] = g * sigmoidf(g) * up; }
        u32x4 w; w.x = pk2(a[0], a[1]); w.y = pk2(a[2], a[3]); w.z = pk2(a[4], a[5]); w.w = pk2(a[6], a[7]);
        *(u32x4*)(act + (size_t)row * DFF + u.pn * 128 + wc * 32 + 8 * fq) = w;
      }
  }
};

__device__ __forceinline__ void transpose_item(const float* W, int K, int ldw, const float* gain, bf16_t* WT, int v0, int src0, int nvalid, int k0, LAS float* scr, int lane) {
  const int col = lane & 31;
  float wv[32];
#pragma unroll
  for (int i = 0; i < 32; ++i) { const int kk = 2 * i + (lane >> 5); wv[i] = (col < nvalid) ? W[(size_t)(k0 + kk) * ldw + src0 + col] : 0.f; }
#pragma unroll
  for (int i = 0; i < 32; ++i) { const int kk = 2 * i + (lane >> 5); scr[kk * 33 + col] = gain ? wv[i] * gain[k0 + kk] : wv[i]; }
  asm volatile("s_waitcnt lgkmcnt(0)" ::: "memory");
  const int c = lane & 7;
#pragma unroll
  for (int j = 0; j < 4; ++j) { const int n = (lane >> 3) + 8 * j; const LAS float* s = scr + (8 * c) * 33 + n;
    u32x4 o; o.x = pk2(s[0 * 33], s[1 * 33]); o.y = pk2(s[2 * 33], s[3 * 33]); o.z = pk2(s[4 * 33], s[5 * 33]); o.w = pk2(s[6 * 33], s[7 * 33]);
    *(u32x4*)(WT + (size_t)(v0 + n) * K + k0 + 8 * c) = o; }
  asm volatile("s_waitcnt lgkmcnt(0)" ::: "memory");
}
__device__ __forceinline__ void convert_weights(const P& p, LAS unsigned char* lds, int wave, int lane, int gw, int NGW, int it0, int it1) {
  LAS float* scr = (LAS float*)(lds + wave * 16384);
  for (int it = it0 + gw; it < it1; it += NGW) {
    const int layer = it / 6400; int r = it % 6400;
    if (r < 1664) {
      const int vb = r >> 4, kb = r & 15, v0 = vb * 32, pn = v0 >> 8, bj = (v0 >> 7) & 1, wc = (v0 >> 5) & 3, g = pn * 4 + wc;
      int src0 = 0, nvalid = 32;
      if (g < 50) src0 = proj_col0(g) + 32 * bj; else if (g == 50 && bj == 0) { src0 = 2688; nvalid = 18; } else nvalid = 0;
      transpose_item(p.w_in + (size_t)layer * D_ * INW, D_, INW, p.attn_norm + layer * D_, (bf16_t*)(p.ws + OFF_WIN) + (size_t)layer * NPROJ * D_, v0, src0, nvalid, kb * 64, scr, lane);
      continue;
    }
    r -= 1664;
    if (r < 512) { const int vb = r >> 4, kb = r & 15;
      transpose_item(p.w_out + (size_t)layer * D_ * D_, D_, D_, nullptr, (bf16_t*)(p.ws + OFF_WO) + (size_t)layer * D_ * D_, vb * 32, vb * 32, 32, kb * 64, scr, lane); continue; }
    r -= 512;
    if (r < 2816) { const int vb = r >> 4, kb = r & 15, v0 = vb * 32, pn = v0 >> 8, bj = (v0 >> 7) & 1, c0 = v0 & 127;
      transpose_item(p.w_gu + (size_t)layer * D_ * 2 * DFF, D_, 2 * DFF, p.ffn_norm + layer * D_, (bf16_t*)(p.ws + OFF_WGU) + (size_t)layer * 2 * DFF * D_, v0, bj * DFF + 128 * pn + c0, 32, kb * 64, scr, lane); continue; }
    r -= 2816;
    { const int vb = r / 44, kb = r % 44;
      transpose_item(p.w_down + (size_t)layer * DFF * D_, DFF, D_, nullptr, (bf16_t*)(p.ws + OFF_WD) + (size_t)layer * D_ * DFF, vb * 32, vb * 32, 32, kb * 64, scr, lane); }
  }
}
__device__ __forceinline__ void ph_prologue(const Cx& cx, const P& p, LAS unsigned char* lds) {
  const int tid = cx.tid, lane = tid & 63, wave = tid >> 6;
  LAS float* scr = (LAS float*)(lds + wave * 16384);
  const int gw = cx.bid * 8 + wave, NGW = cx.G * 8;
  convert_weights(p, lds, wave, lane, gw, NGW, 0, 1664);
  bf16_t* XB = (bf16_t*)(p.ws + OFF_XB); float* ssq = (float*)(p.ws + OFF_SSQ);
  for (int r = gw; r < M_; r += 2 * NGW) {
    const int r2 = r + NGW;
    const f32x4* xa = (const f32x4*)(p.x + (size_t)r * D_); const f32x4* xb2 = (const f32x4*)(p.x + (size_t)((r2 < M_) ? r2 : r) * D_);
    f32x4 va[4], vb[4];
#pragma unroll
    for (int j = 0; j < 4; ++j) { va[j] = xa[lane + 64 * j]; vb[j] = xb2[lane + 64 * j]; }
    float sa = 0.f, sb = 0.f;
#pragma unroll
    for (int j = 0; j < 4; ++j) { sa += (va[j][0] * va[j][0] + va[j][1] * va[j][1]) + (va[j][2] * va[j][2] + va[j][3] * va[j][3]); sb += (vb[j][0] * vb[j][0] + vb[j][1] * vb[j][1]) + (vb[j][2] * vb[j][2] + vb[j][3] * vb[j][3]);
      *(uint2*)(XB + (size_t)r * D_ + (lane + 64 * j) * 4) = make_uint2(pk2(va[j][0], va[j][1]), pk2(va[j][2], va[j][3]));
      if (r2 < M_) *(uint2*)(XB + (size_t)r2 * D_ + (lane + 64 * j) * 4) = make_uint2(pk2(vb[j][0], vb[j][1]), pk2(vb[j][2], vb[j][3])); }
    sa = wave_sum(sa); sb = wave_sum(sb);
    if (lane < 16) { ssq[(size_t)r * 16 + lane] = (lane == 0) ? sa : 0.f; if (r2 < M_) ssq[(size_t)r2 * 16 + lane] = (lane == 0) ? sb : 0.f; }
  }
  if (cx.bid == 0 && tid < 128) ((unsigned*)(p.ws + OFF_CTR))[tid] = 0u;
  for (int it = gw; it < 256; it += NGW) { const int mj = it >> 6, vb = (it >> 5) & 1, kb = it & 31;
    transpose_item(p.cmp_w1 + (size_t)mj * 2048 * 64, 2048, 64, nullptr, (bf16_t*)(p.ws + OFF_W1T) + (size_t)mj * 64 * 2048, vb * 32, vb * 32, 32, kb * 64, scr, lane); }
  for (int it = gw; it < 256; it += NGW) { const int mj = it >> 6, f = it & 63; const float* w1 = p.cmp_w1 + (size_t)mj * 2048 * 64 + f; const float* pe = p.cmp_pe + (size_t)mj * 2048;
    float a = 0.f; for (int i = lane; i < 2048; i += 64) a += pe[i] * w1[(size_t)i * 64];
    a = wave_sum(a); if (lane == 0) ((float*)(p.ws + OFF_C1))[it] = a; }
  for (int i = cx.bid * NTHR + tid; i < 6 * 768; i += cx.G * NTHR) { const int hd = i / 768, k = i % 768; float v = 0.f;
    if (k < 115) v = (k == 0) ? -1e30f : p.rel_bias[t5_bucket(k - 1) * 6 + hd] * 1.4426950408889634f;
    else if (k >= 128 && k < 642) { const int kk = k - 128; v = (kk == 0 || kk == 513) ? -1e30f : p.rel_bias[t5_bucket(kk - 1) * 6 + hd] * 1.4426950408889634f; }
    ((float*)(p.ws + OFF_BTAB))[i] = v; }
  for (int i = cx.bid * NTHR + tid; i < 2 * 4 * 128 * 128; i += cx.G * NTHR) { const int tt = (i >> 7) & 127, ss = i & 127; ((bf16_t*)(p.ws + OFF_WSB))[i] = (ss <= tt) ? f2bf(p.gm_ws[i]) : (bf16_t)0; }
  float2* tab = (float2*)(p.ws + OFF_ROPE);
  for (int i = cx.bid * NTHR + tid; i < T_ * 32; i += cx.G * NTHR) {
    const int t = i >> 5, k = i & 31;
    const float inv = powf(10000.0f, -(float)k / 32.0f);
    const float ang = (float)t * inv;
    tab[i] = make_float2(cosf(ang), sinf(ang));
  }
}
namespace att {
using bf16x8 = __attribute__((ext_vector_type(8))) short;
using s16x4 = __attribute__((ext_vector_type(4))) short;
using f32x16 = __attribute__((ext_vector_type(16))) float;
constexpr int NW = 8, QBLK = 32, QB = 256, KVBLK = 64;
constexpr int SLOTB = 8192, LDS_K = 0, LDS_V = 3 * SLOTB, LDS_WS = 6 * SLOTB, LDS_OST = LDS_WS + NW * 256, LDS_TAB = LDS_OST + NW * 8192, LDS_SELW = LDS_TAB + 2304, LDS_END = LDS_SELW + NW * 512;
static_assert(LDS_END <= 131072, "attention LDS");
constexpr float NEGBIG = -1e30f;
#define SBAR() __builtin_amdgcn_sched_barrier(0)
#define PIN(x) asm volatile("" : "+v"(x))
#define MFMA(a, b, c) __builtin_amdgcn_mfma_f32_32x32x16_bf16(a, b, c, 0, 0, 0)
#define WAIT_BAR(N) asm volatile("s_waitcnt vmcnt(" #N ") lgkmcnt(0)\n\ts_barrier" ::: "memory")
__device__ __forceinline__ int crow(int r, int hi) { return (r & 3) + 8 * (r >> 2) + 4 * hi; }
__device__ __forceinline__ unsigned cvtpk(float lo, float hi) { unsigned r; asm("v_cvt_pk_bf16_f32 %0, %1, %2" : "=v"(r) : "v"(lo), "v"(hi)); return r; }
__device__ __forceinline__ void glds16(const void* g, unsigned lds_base) {
  unsigned sv; asm volatile("s_mov_b32 %0, m0\n\ts_mov_b32 m0, %2\n\ts_nop 0\n\tglobal_load_lds_dwordx4 %1, off\n\ts_mov_b32 m0, %0" : "=&s"(sv) : "v"(g), "s"(lds_base) : "memory"); }
typedef __attribute__((address_space(3))) const char* lds_cptr;
typedef short v4i16_t __attribute__((ext_vector_type(4)));
__device__ __forceinline__ void kload2(bf16x8* kf, lds_cptr kp, int d0) { kf[2 * d0] = *(const __attribute__((address_space(3))) bf16x8*)(kp + d0 * 2048); kf[2 * d0 + 1] = *(const __attribute__((address_space(3))) bf16x8*)(kp + d0 * 2048 + 512); }
__device__ __forceinline__ s16x4 vtr(lds_cptr p) { return __builtin_bit_cast(s16x4, __builtin_amdgcn_ds_read_tr16_b64_v4i16((__attribute__((address_space(3))) v4i16_t*)p)); }
#define MX3(a, b, c) __builtin_fmaxf(__builtin_fmaxf((a), (b)), (c))
__device__ __forceinline__ float rowmax(const f32x16& p0, const f32x16& p1) {
  float a = MX3(p0[0], p0[1], p1[0]), b = MX3(p0[2], p0[3], p1[1]); a = MX3(a, p1[2], p1[3]);
#pragma unroll
  for (int r = 4; r < 16; r += 4) { a = MX3(a, p0[r], p0[r + 1]); b = MX3(b, p0[r + 2], p0[r + 3]); a = MX3(a, p1[r], p1[r + 1]); b = MX3(b, p1[r + 2], p1[r + 3]); }
  float m = __builtin_fmaxf(a, b); auto rr = __builtin_amdgcn_permlane32_swap(__float_as_uint(m), __float_as_uint(m), false, false);
  return __builtin_fmaxf(__uint_as_float(rr[0]), __uint_as_float(rr[1])); }
template <int S, int IMAX>
__device__ __forceinline__ void bias_hook(f32x16& p0, f32x16& p1, int dl, const __attribute__((address_space(3))) float* tab) {
#pragma unroll
  for (int r = 0; r < 16; ++r) { const int c = (r & 3) + 8 * (r >> 2); const int d0 = dl - S * c, d1 = d0 - 32 * S;
    p0[r] += tab[1 + min(max(d0, -1), IMAX)]; p1[r] += tab[1 + min(max(d1, -1), IMAX)]; } }

template <int MODE>
__device__ __forceinline__ void nsa_pass(const int tid, const bf16_t* Qrows, const bf16_t* __restrict__ Kt0, const bf16_t* __restrict__ Vt0, const int NT, const int dq, const float b31,
                                         const float* gate, char* lds, const bool first) {
  constexpr int S = (MODE == 2) ? 16 : 1, IMAX = (MODE == 1) ? 512 : 113; constexpr float REF = 8.f;
  const int lane = tid & 63, r32 = lane & 31, hi = lane >> 5; const int wid = __builtin_amdgcn_readfirstlane(tid >> 6);
  const bf16_t* Qw = Qrows + (size_t)(wid * QBLK) * 64;
  const unsigned lds0 = (unsigned)(uintptr_t)lds; float* wsf = (float*)(lds + LDS_WS) + wid * 64;
  const __attribute__((address_space(3))) float* tab = (const __attribute__((address_space(3))) float*)(uintptr_t)(lds0 + LDS_TAB);
  const __attribute__((address_space(3))) unsigned* selw = (const __attribute__((address_space(3))) unsigned*)(uintptr_t)(lds0 + LDS_SELW + wid * 512);
  const bf16_t* ksrc = Kt0 + (size_t)lane * 64 + wid * 8;
  const bf16_t* vsrc = Vt0 + (size_t)(16 * (wid & 3) + (lane >> 2)) * 64 + (wid >> 2) * 32 + (lane & 3) * 8;
  const unsigned kdst = lds0 + LDS_K + wid * 1024, vdst = lds0 + LDS_V + wid * 1024;
#define DMA_K(t, slot) glds16(ksrc + (size_t)(t) * KVBLK * 64, (unsigned)__builtin_amdgcn_readfirstlane(kdst + (slot)))
#define DMA_V(t, slot) glds16(vsrc + (size_t)(t) * KVBLK * 64, (unsigned)__builtin_amdgcn_readfirstlane(vdst + (slot)))
  const lds_cptr vp0 = (lds_cptr)(uintptr_t)lds0 + LDS_V + ((lane >> 4) & 1) * 32 + (lane & 3) * 8 + (4 * hi + ((lane & 15) >> 2)) * 64;
  const lds_cptr kp0 = (lds_cptr)(uintptr_t)lds0 + LDS_K + hi * 1024 + r32 * 16;
  DMA_K(0, 0); DMA_V(0, 0); DMA_K(1, SLOTB);
  bf16x8 qr[4];
#pragma unroll
  for (int d0 = 0; d0 < 4; ++d0) qr[d0] = *reinterpret_cast<const bf16x8*>(&Qw[(size_t)r32 * 64 + d0 * 16 + hi * 8]);
  float l_reg = 0.f; f32x16 o[2]; o[0] = f32x16{}; o[1] = f32x16{};
  f32x16 zero16 = f32x16{}; PIN(zero16);
  const int qrel = wid * QBLK + r32;
  const int dlq = dq + qrel - S * 4 * hi;
  f32x16 pA0, pA1, pB0, pB1; bf16x8 kf[8]; s16x4 vlo[8], vhi[8]; u32x4 pw0, pw1, pw2, pw3;
  int sl_prev = 0, sl_cur = 0, sl_next = SLOTB;
#define ROT() do { sl_prev = sl_cur; sl_cur = sl_next; sl_next = (sl_next == 2 * SLOTB) ? 0 : sl_next + SLOTB; } while (0)
#define EX(v) __builtin_amdgcn_exp2f((v) + nmh)
#define SELBIT(t) ((MODE == 0) ? (((selw[(t)] >> r32) & 1u) != 0u) : true)
  DMA_K(2, 2 * SLOTB);
  WAIT_BAR(3);
  _Pragma("unroll") for (int d0 = 0; d0 < 4; ++d0) kload2(kf, kp0, d0);
  pA0 = MFMA(kf[0], qr[0], zero16); pA1 = MFMA(kf[1], qr[0], zero16); pA0 = MFMA(kf[2], qr[1], pA0); pA1 = MFMA(kf[3], qr[1], pA1);
  pA0 = MFMA(kf[4], qr[2], pA0); pA1 = MFMA(kf[5], qr[2], pA1); pA0 = MFMA(kf[6], qr[3], pA0); pA1 = MFMA(kf[7], qr[3], pA1);
  { const bool band0 = (MODE != 0) || (NT < 8);
    if (band0) bias_hook<S, IMAX>(pA0, pA1, dlq, tab);
    const float bc = band0 ? 0.f : b31; const bool sb = SELBIT(0);
    const float nmh = sb ? bc - REF : NEGBIG;
#pragma unroll
    for (int r = 0; r < 16; ++r) { pA0[r] = EX(pA0[r]); pA1[r] = EX(pA1[r]); } }
  WAIT_BAR(0);
  DMA_K(3, 0); DMA_V(1, SLOTB); ROT();
  _Pragma("unroll") for (int d0 = 0; d0 < 4; ++d0) kload2(kf, kp0 + sl_cur, d0);
  WAIT_BAR(2);
#define PKW(P, i) cvtpk(P[i], P[i + 1])
#define PAF(k) __builtin_bit_cast(bf16x8, pw##k)
#define VFR(i) (bf16x8){vlo[i][0], vlo[i][1], vlo[i][2], vlo[i][3], vhi[i][0], vhi[i][1], vhi[i][2], vhi[i][3]}
#define VRD(i) do { vlo[i] = vtr(vp_ + (((i) >> 2) * 4096 + ((i) & 3) * 1024)); vhi[i] = vtr(vp_ + (((i) >> 2) * 4096 + ((i) & 3) * 1024 + 512)); } while (0)
#define KRD(G, d0) do { if (G) { kload2(kf, kp0 + sl_next, d0); SBAR(); } } while (0)
#define GAPA(MF, a0, a1, a2, a3, W0, W1, PW) do { MF; sacc += a0; sacc += a1; sacc += a2; sacc += a3; W0; W1; PIN(PW); PIN(sacc); SBAR(); } while (0)
#define GAPB(MF, X, i) do { MF; X[i] = EX(X[i]); X[i + 1] = EX(X[i + 1]); X[i + 2] = EX(X[i + 2]); X[i + 3] = EX(X[i + 3]); PIN(X); SBAR(); } while (0)
#define STEP(C0, C1, P0, P1, t, MASK, GK, GV, GL) do { SBAR(); \
    const lds_cptr vp_ = vp0 + sl_prev; \
    VRD(0); SBAR(); float sacc = P0[0] + P0[1]; \
                    GAPA(C0 = MFMA(kf[0], qr[0], zero16), P0[2], P0[3], P0[4], P0[5],     pw0[0] = PKW(P0, 0),  pw0[1] = PKW(P0, 2),  pw0); \
    VRD(4); SBAR(); GAPA(C1 = MFMA(kf[1], qr[0], zero16), P0[6], P0[7], P0[8], P0[9],     pw0[2] = PKW(P0, 4),  pw0[3] = PKW(P0, 6),  pw0); \
    VRD(1); SBAR(); GAPA(C0 = MFMA(kf[2], qr[1], C0),    P0[10], P0[11], P0[12], P0[13], pw1[0] = PKW(P0, 8),  pw1[1] = PKW(P0, 10), pw1); \
    VRD(5); SBAR(); GAPA(C1 = MFMA(kf[3], qr[1], C1),    P0[14], P0[15], P1[0], P1[1],   pw1[2] = PKW(P0, 12), pw1[3] = PKW(P0, 14), pw1); \
    VRD(2); SBAR(); GAPA(C0 = MFMA(kf[4], qr[2], C0),    P1[2], P1[3], P1[4], P1[5],     pw2[0] = PKW(P1, 0),  pw2[1] = PKW(P1, 2),  pw2); \
    VRD(6); SBAR(); GAPA(C1 = MFMA(kf[5], qr[2], C1),    P1[6], P1[7], P1[8], P1[9],     pw2[2] = PKW(P1, 4),  pw2[3] = PKW(P1, 6),  pw2); \
    VRD(3); SBAR(); GAPA(C0 = MFMA(kf[6], qr[3], C0),    P1[10], P1[11], P1[12], P1[13], pw3[0] = PKW(P1, 8),  pw3[1] = PKW(P1, 10), pw3); \
    VRD(7); SBAR(); GAPA(C1 = MFMA(kf[7], qr[3], C1),    P1[14], P1[15], 0.f, 0.f,       pw3[2] = PKW(P1, 12), pw3[3] = PKW(P1, 14), pw3); \
    l_reg += sacc; \
    if (GK) DMA_K((t) + 3, sl_cur); if (GV) DMA_V((t) + 1, sl_next); \
    if (MASK) bias_hook<S, IMAX>(C0, C1, dlq - S * 64 * (t), tab); \
    const float bc_ = (MASK) ? 0.f : b31; const bool sb_ = SELBIT(t); \
    const float nmh = sb_ ? bc_ - REF : NEGBIG; SBAR(); \
    GAPB(o[0] = MFMA(PAF(0), VFR(0), o[0]), C0, 0);              GAPB(o[1] = MFMA(PAF(0), VFR(4), o[1]), C0, 4); \
    KRD(GL, 0); GAPB(o[0] = MFMA(PAF(1), VFR(1), o[0]), C0, 8);  KRD(GL, 1); GAPB(o[1] = MFMA(PAF(1), VFR(5), o[1]), C0, 12); \
    KRD(GL, 2); GAPB(o[0] = MFMA(PAF(2), VFR(2), o[0]), C1, 0);  KRD(GL, 3); GAPB(o[1] = MFMA(PAF(2), VFR(6), o[1]), C1, 4); \
    GAPB(o[0] = MFMA(PAF(3), VFR(3), o[0]), C1, 8);              GAPB(o[1] = MFMA(PAF(3), VFR(7), o[1]), C1, 12); \
    } while (0)
  int t = 1;
  if (MODE == 0) {
    for (; t + 7 < NT; t += 2) {
      STEP(pB0, pB1, pA0, pA1, t, false, true, true, true);     WAIT_BAR(2); ROT();
      STEP(pA0, pA1, pB0, pB1, t + 1, false, true, true, true); WAIT_BAR(2); ROT();
    }
  }
#define ENDW(tt) do { if ((tt) + 3 < NT) { WAIT_BAR(2); } else if ((tt) + 2 < NT) { WAIT_BAR(1); } else { WAIT_BAR(0); } } while (0)
  for (; t + 1 < NT; t += 2) {
    STEP(pB0, pB1, pA0, pA1, t, true, (t + 3 < NT), (t + 1 < NT), (t + 1 < NT));         ENDW(t);     ROT();
    STEP(pA0, pA1, pB0, pB1, t + 1, true, (t + 4 < NT), (t + 2 < NT), (t + 2 < NT));     ENDW(t + 1); ROT();
  }
  STEP(pB0, pB1, pA0, pA1, NT - 1, true, false, false, false);
  { float sacc = pB0[0] + pB0[1];
#pragma unroll
    for (int r = 2; r < 16; ++r) sacc += pB0[r];
#pragma unroll
    for (int r = 0; r < 16; ++r) sacc += pB1[r];
    l_reg += sacc;
    pw0 = (u32x4){PKW(pB0, 0), PKW(pB0, 2), PKW(pB0, 4), PKW(pB0, 6)}; pw1 = (u32x4){PKW(pB0, 8), PKW(pB0, 10), PKW(pB0, 12), PKW(pB0, 14)};
    pw2 = (u32x4){PKW(pB1, 0), PKW(pB1, 2), PKW(pB1, 4), PKW(pB1, 6)}; pw3 = (u32x4){PKW(pB1, 8), PKW(pB1, 10), PKW(pB1, 12), PKW(pB1, 14)};
    const lds_cptr vp_ = vp0 + sl_cur; _Pragma("unroll") for (int i = 0; i < 8; ++i) VRD(i);
    o[0] = MFMA(PAF(0), VFR(0), o[0]); o[1] = MFMA(PAF(0), VFR(4), o[1]); o[0] = MFMA(PAF(1), VFR(1), o[0]); o[1] = MFMA(PAF(1), VFR(5), o[1]);
    o[0] = MFMA(PAF(2), VFR(2), o[0]); o[1] = MFMA(PAF(2), VFR(6), o[1]); o[0] = MFMA(PAF(3), VFR(3), o[0]); o[1] = MFMA(PAF(3), VFR(7), o[1]); }
  { auto rr = __builtin_amdgcn_permlane32_swap(__float_as_uint(l_reg), __float_as_uint(l_reg), false, false); l_reg = __uint_as_float(rr[0]) + __uint_as_float(rr[1]); }
  if (hi == 0) wsf[32 + r32] = (l_reg > 0.f) ? gate[(size_t)qrel * 24] / l_reg : 0.f;
  asm volatile("s_waitcnt lgkmcnt(0)" ::: "memory");
  float rli[16];
#pragma unroll
  for (int r = 0; r < 16; ++r) rli[r] = wsf[32 + crow(r, hi)];
  float* stg = (float*)(lds + LDS_OST) + wid * 2048;
  if (first) {
#pragma unroll
    for (int r = 0; r < 16; ++r) { const int orow = crow(r, hi);
#pragma unroll
      for (int d0 = 0; d0 < 2; ++d0) stg[orow * 64 + d0 * 32 + r32] = o[d0][r] * rli[r]; }
  } else {
#pragma unroll
    for (int r = 0; r < 16; ++r) { const int orow = crow(r, hi);
#pragma unroll
      for (int d0 = 0; d0 < 2; ++d0) stg[orow * 64 + d0 * 32 + r32] += o[d0][r] * rli[r]; }
  }
  asm volatile("s_waitcnt lgkmcnt(0)\n\ts_barrier" ::: "memory");
#undef DMA_K
#undef DMA_V
#undef ROT
#undef EX
#undef SELBIT
#undef PKW
#undef PAF
#undef VFR
#undef VRD
#undef KRD
#undef ENDW
#undef GAPA
#undef GAPB
#undef STEP
}
#undef SBAR
#undef PIN
#undef MFMA
#undef WAIT_BAR
#undef MX3
}

#define L2E 1.4426950408889634f
__device__ __forceinline__ void topk_unit(const Cx& cx, const P& p, int u, char* lds) {
  using att::bf16x8; using att::f32x16;
  const int tid = cx.tid, lane = tid & 63, r32 = lane & 31, hi = lane >> 5, wid = cx.wv, grp = wid & 3, half = wid >> 2;
  const int qb = 63 - (u >> 2), bg = u & 3, b = bg >> 1, g = bg & 1, q0 = qb * 128;
  const int ntile64 = ((((q0 + 127) >> 4) + 1) + 63) >> 6;
  const bf16_t* KCb = (const bf16_t*)(p.ws + OFF_KC) + (size_t)bg * 512 * 64;
  const unsigned lds0 = (unsigned)(uintptr_t)lds;
  constexpr int L_IMP = 65536, L_LSUM = 131072 + 1024, L_TAB = 139264;
  for (int i = tid; i < ntile64 * 512; i += NTHR) { const int n = i >> 3, c = i & 7;
    *(u32x4*)(lds + (n >> 6) * 8192 + c * 1024 + (n & 63) * 16) = *(const u32x4*)(KCb + (size_t)n * 64 + c * 8); }
  float* tabw = (float*)(lds + L_TAB);
  for (int i = tid; i < 3 * 115; i += NTHR) { const int h = i / 115, k = i % 115; tabw[i] = ((const float*)(p.ws + OFF_BTAB))[(g * 3 + h) * 768 + k]; }
  float* impw = (float*)(lds + L_IMP) + wid * 2048;
#pragma unroll
  for (int s2 = 0; s2 < 32; ++s2) impw[s2 * 64 + lane] = 0.f;
  __syncthreads();
  const __attribute__((address_space(3))) float* tab = (const __attribute__((address_space(3))) float*)(uintptr_t)(lds0 + L_TAB);
  const att::lds_cptr kp0 = (att::lds_cptr)(uintptr_t)lds0 + hi * 1024 + r32 * 16;
  const int tq0 = q0 + grp * 32, t = tq0 + r32, cur = tq0 >> 6;
  const int NT32 = ((tq0 >> 4) + 1 + 31) >> 5;
  const int Th = (NT32 + 1) >> 1, T0 = half ? Th : 0, T1 = half ? NT32 : Th;
  const int nfar = (tq0 - 144) >> 4;
  const int Tnear0 = (nfar >= 31) ? ((nfar - 31) >> 5) + 1 : 0;
  const bf16_t* HB = (const bf16_t*)(p.ws + OFF_HB);
  float b31[3];
#pragma unroll
  for (int h = 0; h < 3; ++h) b31[h] = p.rel_bias[31 * 6 + g * 3 + h] * L2E;
  const int dl0 = t - 31 - 64 * hi;
  f32x16 zero16 = f32x16{}; asm volatile("" : "+v"(zero16));
#define TK_SCORES(T, h, sv) do { const att::lds_cptr kp_ = kp0 + ((T) >> 1) * 8192 + ((T) & 1) * 512; \
    const bf16x8 k0_ = *(const __attribute__((address_space(3))) bf16x8*)(kp_), k1_ = *(const __attribute__((address_space(3))) bf16x8*)(kp_ + 2048), \
                 k2_ = *(const __attribute__((address_space(3))) bf16x8*)(kp_ + 4096), k3_ = *(const __attribute__((address_space(3))) bf16x8*)(kp_ + 6144); \
    sv = __builtin_amdgcn_mfma_f32_32x32x16_bf16(k0_, qr[0], zero16, 0, 0, 0); sv = __builtin_amdgcn_mfma_f32_32x32x16_bf16(k1_, qr[1], sv, 0, 0, 0); \
    sv = __builtin_amdgcn_mfma_f32_32x32x16_bf16(k2_, qr[2], sv, 0, 0, 0); sv = __builtin_amdgcn_mfma_f32_32x32x16_bf16(k3_, qr[3], sv, 0, 0, 0); \
    if ((T) >= Tnear0) { const int dl_ = dl0 - 512 * (T); _Pragma("unroll") for (int r = 0; r < 16; ++r) { const int c_ = (r & 3) + 8 * (r >> 2); sv[r] = __builtin_amdgcn_exp2f(sv[r] + tab[(h) * 115 + 1 + min(max(dl_ - 16 * c_, -1), 113)]); } } \
    else { _Pragma("unroll") for (int r = 0; r < 16; ++r) sv[r] = __builtin_amdgcn_exp2f(sv[r] + b31[h]); } } while (0)
  float U[3][32]; float l[3];
#pragma unroll
  for (int h = 0; h < 3; ++h) {
    const bf16_t* Qh = HB + ((size_t)(24 + g * 3 + h) * M_ + (size_t)b * T_ + tq0) * 64;
    bf16x8 qr[4];
#pragma unroll
    for (int d0 = 0; d0 < 4; ++d0) qr[d0] = *reinterpret_cast<const bf16x8*>(Qh + (size_t)r32 * 64 + d0 * 16 + hi * 8);
    float lh = 0.f, carry = 0.f;
    if (half == 1 && T0 < T1) { f32x16 sv; TK_SCORES(T0 - 1, h, sv); carry = __shfl_xor(sv[15], 32); }
#define TK_FINISH(tt_, sv_) do { float body[4], pt[4], a_ = 0.f; \
        _Pragma("unroll") for (int g4 = 0; g4 < 4; ++g4) { const float s3 = (sv_[4 * g4] + sv_[4 * g4 + 1]) + sv_[4 * g4 + 2]; body[g4] = 2.f * s3 + sv_[4 * g4 + 3]; a_ += s3 + sv_[4 * g4 + 3]; } \
        lh += a_; \
        _Pragma("unroll") for (int k = 0; k < 4; ++k) pt[k] = __shfl_xor(sv_[4 * k + 3], 32); \
        U[h][(tt_) * 4 + 0] = body[0] + (hi ? pt[0] : carry); U[h][(tt_) * 4 + 1] = body[1] + (hi ? pt[1] : pt[0]); \
        U[h][(tt_) * 4 + 2] = body[2] + (hi ? pt[2] : pt[1]); U[h][(tt_) * 4 + 3] = body[3] + (hi ? pt[3] : pt[2]); \
        carry = pt[3]; } while (0)
#pragma unroll
    for (int tp = 0; tp < 4; ++tp) {
      const int T = T0 + 2 * tp;
      if (T + 1 < T1 && T + 1 < Tnear0) {
        const att::lds_cptr ka_ = kp0 + (T >> 1) * 8192 + (T & 1) * 512, kb_ = kp0 + ((T + 1) >> 1) * 8192 + ((T + 1) & 1) * 512;
        f32x16 sa, sb;
        { const bf16x8 a0 = *(const __attribute__((address_space(3))) bf16x8*)(ka_), a1 = *(const __attribute__((address_space(3))) bf16x8*)(ka_ + 2048), a2 = *(const __attribute__((address_space(3))) bf16x8*)(ka_ + 4096), a3 = *(const __attribute__((address_space(3))) bf16x8*)(ka_ + 6144);
          const bf16x8 b0 = *(const __attribute__((address_space(3))) bf16x8*)(kb_), b1 = *(const __attribute__((address_space(3))) bf16x8*)(kb_ + 2048), b2 = *(const __attribute__((address_space(3))) bf16x8*)(kb_ + 4096), b3 = *(const __attribute__((address_space(3))) bf16x8*)(kb_ + 6144);
          sa = __builtin_amdgcn_mfma_f32_32x32x16_bf16(a0, qr[0], zero16, 0, 0, 0); sb = __builtin_amdgcn_mfma_f32_32x32x16_bf16(b0, qr[0], zero16, 0, 0, 0);
          sa = __builtin_amdgcn_mfma_f32_32x32x16_bf16(a1, qr[1], sa, 0, 0, 0);     sb = __builtin_amdgcn_mfma_f32_32x32x16_bf16(b1, qr[1], sb, 0, 0, 0);
          sa = __builtin_amdgcn_mfma_f32_32x32x16_bf16(a2, qr[2], sa, 0, 0, 0);     sb = __builtin_amdgcn_mfma_f32_32x32x16_bf16(b2, qr[2], sb, 0, 0, 0);
          sa = __builtin_amdgcn_mfma_f32_32x32x16_bf16(a3, qr[3], sa, 0, 0, 0);     sb = __builtin_amdgcn_mfma_f32_32x32x16_bf16(b3, qr[3], sb, 0, 0, 0); }
#pragma unroll
        for (int r = 0; r < 16; ++r) { sa[r] = __builtin_amdgcn_exp2f(sa[r] + b31[h]); sb[r] = __builtin_amdgcn_exp2f(sb[r] + b31[h]); }
        TK_FINISH(2 * tp, sa); TK_FINISH(2 * tp + 1, sb);
      } else {
        if (T < T1) { f32x16 sv; TK_SCORES(T, h, sv); TK_FINISH(2 * tp, sv); }
        else { U[h][tp * 8 + 0] = 0.f; U[h][tp * 8 + 1] = 0.f; U[h][tp * 8 + 2] = 0.f; U[h][tp * 8 + 3] = 0.f; }
        if (T + 1 < T1) { f32x16 sv; TK_SCORES(T + 1, h, sv); TK_FINISH(2 * tp + 1, sv); }
        else { U[h][tp * 8 + 4] = 0.f; U[h][tp * 8 + 5] = 0.f; U[h][tp * 8 + 6] = 0.f; U[h][tp * 8 + 7] = 0.f; }
      }
    }
#undef TK_FINISH
    l[h] = lh;
  }
  { float* ls = (float*)(lds + L_LSUM);
#pragma unroll
    for (int h = 0; h < 3; ++h) ls[((grp * 2 + half) * 3 + h) * 64 + lane] = l[h]; }
  __syncthreads();
  { const float* ls = (const float*)(lds + L_LSUM); float rl[3];
#pragma unroll
    for (int h = 0; h < 3; ++h) { float lt = ls[((grp * 2 + 0) * 3 + h) * 64 + lane] + ls[((grp * 2 + 1) * 3 + h) * 64 + lane]; lt += __shfl_xor(lt, 32); rl[h] = (lt > 0.f) ? 1.f / lt : 0.f; }
#pragma unroll
    for (int i = 0; i < 32; ++i) impw[i * 64 + lane] = (U[0][i] * rl[0] + U[1][i] * rl[1]) + U[2][i] * rl[2]; }
#undef TK_SCORES
  __syncthreads();
  {
    const int qq = 16 * half + (lane & 15), part = lane >> 4, srcw = part >> 1, shi = part & 1;
    const float* ip = (const float*)(lds + L_IMP) + (grp + 4 * srcw) * 2048 + qq + 32 * shi;
    const int tbase = srcw ? Th : 0;
    unsigned v[32];
#pragma unroll
    for (int i = 0; i < 32; ++i) { const int j = 8 * (tbase + (i >> 2)) + 2 * (i & 3) + shi; v[i] = (j >= 1 && j <= cur - 2) ? __float_as_uint(ip[i * 64]) : 0u; }
    unsigned tau = 0u;
    if (cur >= 16) {
      unsigned thr = 0x7fffffffu;
#pragma unroll 1
      for (int rnd = 0; rnd < 13; ++rnd) {
        unsigned m0 = 0u, m1 = 0u, m2 = 0u, m3 = 0u;
#pragma unroll
        for (int i = 0; i < 32; i += 4) { m0 = max(m0, (v[i] < thr) ? v[i] : 0u); m1 = max(m1, (v[i + 1] < thr) ? v[i + 1] : 0u); m2 = max(m2, (v[i + 2] < thr) ? v[i + 2] : 0u); m3 = max(m3, (v[i + 3] < thr) ? v[i + 3] : 0u); }
        unsigned m = max(max(m0, m1), max(m2, m3));
        m = max(m, (unsigned)__shfl_xor((int)m, 16)); m = max(m, (unsigned)__shfl_xor((int)m, 32));
        thr = m;
      }
      tau = thr;
    }
    unsigned w0 = 0u, w1 = 0u, w2 = 0u, w3 = 0u;
#pragma unroll
    for (int i = 0; i < 32; ++i) { const int j = 8 * (tbase + (i >> 2)) + 2 * (i & 3) + shi;
      const bool ok = (j >= 1 && j <= cur - 2) && (v[i] >= tau); const unsigned m = ok ? (1u << (j & 31)) : 0u; const int wq = j >> 5;
      w0 |= (wq == 0) ? m : 0u; w1 |= (wq == 1) ? m : 0u; w2 |= (wq == 2) ? m : 0u; w3 |= (wq == 3) ? m : 0u; }
    w0 |= (unsigned)__shfl_xor((int)w0, 16); w1 |= (unsigned)__shfl_xor((int)w1, 16); w2 |= (unsigned)__shfl_xor((int)w2, 16); w3 |= (unsigned)__shfl_xor((int)w3, 16);
    w0 |= (unsigned)__shfl_xor((int)w0, 32); w1 |= (unsigned)__shfl_xor((int)w1, 32); w2 |= (unsigned)__shfl_xor((int)w2, 32); w3 |= (unsigned)__shfl_xor((int)w3, 32);
#pragma unroll
    for (int f = 0; f < 3; ++f) { const int jf = (f == 0) ? 0 : (f == 1) ? cur - 1 : cur; if (jf >= 0) { const unsigned m = 1u << (jf & 31); const int wq = jf >> 5;
        w0 |= (wq == 0) ? m : 0u; w1 |= (wq == 1) ? m : 0u; w2 |= (wq == 2) ? m : 0u; w3 |= (wq == 3) ? m : 0u; } }
    if (part == 0) *(uint4*)((unsigned*)(p.ws + OFF_SELQ) + ((size_t)bg * T_ + tq0 + qq) * 4) = make_uint4(w0, w1, w2, w3);
  }
  __syncthreads();
}
__device__ __forceinline__ void nsa_unit(const Cx& cx, const P& p, int u, char* lds) {
  const int tid = cx.tid, lane = tid & 63, r32 = lane & 31, wid = tid >> 6;
  const int qb = 31 - u / 12, bgh = u % 12, b = bgh / 6, g = (bgh / 3) & 1, h = bgh % 3, head = g * 3 + h;
  const size_t rowb = (size_t)b * T_; const int q0 = qb * 256;
  const bf16_t* HB = (const bf16_t*)(p.ws + OFF_HB);
  const bf16_t* Qrows = HB + ((size_t)(24 + head) * M_ + rowb + q0) * 64;
  const float* gate0 = (const float*)(p.ws + OFF_GATES) + (rowb + q0) * 24 + head * 3;
  float* tabw = (float*)(lds + att::LDS_TAB);
  const float b31 = p.rel_bias[31 * 6 + head] * L2E;
  { const uint4 mq = *(const uint4*)((const unsigned*)(p.ws + OFF_SELQ) + ((size_t)(b * 2 + g) * T_ + q0 + wid * 32 + r32) * 4);
    unsigned* sw = (unsigned*)(lds + att::LDS_SELW) + wid * 128;
    const int nblk = 4 * qb + 4;
#pragma unroll
    for (int w4 = 0; w4 < 4; ++w4) { const unsigned w = (w4 == 0) ? mq.x : (w4 == 1) ? mq.y : (w4 == 2) ? mq.z : mq.w;
      if (32 * w4 < nblk) { for (int j = 0; j < 32; ++j) { const unsigned long long bal = __ballot((w >> j) & 1u); if (lane == 0) sw[32 * w4 + j] = (unsigned)bal; } } } }
  const float* btab = (const float*)(p.ws + OFF_BTAB) + head * 768;
  if (tid < 115) tabw[tid] = btab[tid];
  att::nsa_pass<0>(tid, Qrows, HB + ((size_t)(34 + g) * M_ + rowb) * 64, HB + ((size_t)(36 + g) * M_ + rowb) * 64, 4 * qb + 4, q0, b31, gate0 + 1, lds, true);
  for (int i = tid; i < 514; i += NTHR) tabw[i] = btab[128 + i];
  { const int t0 = (qb >= 2) ? 4 * qb - 8 : 0;
    att::nsa_pass<1>(tid, Qrows, HB + ((size_t)(38 + g) * M_ + rowb + 64 * t0) * 64, HB + ((size_t)(40 + g) * M_ + rowb + 64 * t0) * 64, 4 * qb + 4 - t0, q0 - 64 * t0, b31, gate0 + 2, lds, false); }
  if (tid < 115) tabw[tid] = btab[tid];
  { const int nt = (qb < 16) ? 4 : (qb < 24) ? 6 : 8;
    att::nsa_pass<2>(tid, Qrows, (const bf16_t*)(p.ws + OFF_KC) + (size_t)(b * 2 + g) * 512 * 64, (const bf16_t*)(p.ws + OFF_VC) + (size_t)(b * 2 + g) * 512 * 64, nt, q0 - 31, b31, gate0, lds, false); }
  { const float* stg = (const float*)(lds + att::LDS_OST) + wid * 2048;
    bf16_t* mixw = (bf16_t*)(p.ws + OFF_MIX) + (rowb + q0 + wid * 32) * D_ + 384 + head * 64;
#pragma unroll
    for (int i = 0; i < 4; ++i) { const int row = i * 8 + (lane >> 3), ch = lane & 7;
      const f32x4 a0 = *(const f32x4*)(stg + row * 64 + ch * 8), a1 = *(const f32x4*)(stg + row * 64 + ch * 8 + 4);
      u32x4 w; w.x = pk2(a0[0], a0[1]); w.y = pk2(a0[2], a0[3]); w.z = pk2(a1[0], a1[1]); w.w = pk2(a1[2], a1[3]);
      *(u32x4*)(mixw + (size_t)row * D_ + ch * 8) = w; }
    asm volatile("s_waitcnt lgkmcnt(0)\n\ts_barrier" ::: "memory"); }
}
namespace mx {
using att::bf16x8; using att::s16x4; using att::f32x16; using att::lds_cptr;
#define MX_MFMA(a, b, c) __builtin_amdgcn_mfma_f32_32x32x16_bf16(a, b, c, 0, 0, 0)
__device__ __forceinline__ void dma_k_tile(const bf16_t* src, unsigned ldsaddr, int lane, int wid) { att::glds16(src + (size_t)lane * 64 + wid * 8, (unsigned)__builtin_amdgcn_readfirstlane(ldsaddr + wid * 1024)); }
__device__ __forceinline__ void dma_v_tile(const bf16_t* src, unsigned ldsaddr, int lane, int wid) { att::glds16(src + (size_t)(16 * (wid & 3) + (lane >> 2)) * 64 + (wid >> 2) * 32 + (lane & 3) * 8, (unsigned)__builtin_amdgcn_readfirstlane(ldsaddr + wid * 1024)); }
__device__ __forceinline__ int vlane_off(int lane) { return ((lane >> 4) & 1) * 32 + (lane & 3) * 8 + (4 * (lane >> 5) + ((lane & 15) >> 2)) * 64; }
__device__ __forceinline__ bf16x8 vfrag(lds_cptr vp, int i) { const s16x4 lo = att::vtr(vp + (i >> 2) * 4096 + (i & 3) * 1024), hi = att::vtr(vp + (i >> 2) * 4096 + (i & 3) * 1024 + 512);
  return (bf16x8){lo[0], lo[1], lo[2], lo[3], hi[0], hi[1], hi[2], hi[3]}; }
__device__ __forceinline__ bf16x8 kfrag(lds_cptr kp, int d0, int n) { return *(const __attribute__((address_space(3))) bf16x8*)(kp + d0 * 2048 + n * 512); }
#define MX_WAIT_ALL() asm volatile("s_waitcnt vmcnt(0) lgkmcnt(0)\n\ts_barrier" ::: "memory")
__device__ __forceinline__ float loggamma2(int h) { return log2f(1.f - exp2f(-5.f - (float)h)); }

__device__ __forceinline__ void ret_kv_unit(const Cx& cx, const P& p, int u, char* lds) {
  const int tid = cx.tid, lane = tid & 63, r32 = lane & 31, hi = lane >> 5, wid = cx.wv;
  const int bh = u >> 5, cp = u & 31, b = bh / 6, h = bh % 6;
  const size_t r0 = (size_t)b * T_ + cp * 256;
  const bf16_t* HB = (const bf16_t*)(p.ws + OFF_HB);
  const bf16_t* Kp = HB + ((size_t)(6 + h) * M_ + r0) * 64; const bf16_t* Vp = HB + ((size_t)(12 + h) * M_ + r0) * 64;
  const unsigned lds0 = (unsigned)(uintptr_t)lds;
#pragma unroll
  for (int i = 0; i < 4; ++i) { dma_v_tile(Vp + (size_t)i * 4096, lds0 + i * 8192, lane, wid); dma_v_tile(Kp + (size_t)i * 4096, lds0 + 32768 + i * 8192, lane, wid); }
  MX_WAIT_ALL();
  const int ch = wid >> 2, eb = (wid >> 1) & 1, db = wid & 1;
  f32x16 acc = f32x16{};
#pragma unroll
  for (int kt = 0; kt < 2; ++kt) { const lds_cptr vv = (lds_cptr)(uintptr_t)(lds0 + (ch * 2 + kt) * 8192) + vlane_off(lane), vk = vv + 32768;
#pragma unroll
    for (int ks = 0; ks < 4; ++ks) acc = MX_MFMA(vfrag(vv, 4 * eb + ks), vfrag(vk, 4 * db + ks), acc); }
  const float sc = exp2f(127.f * loggamma2(h));
  float* ST = (float*)(p.ws + OFF_RS) + ((size_t)bh * 64 + cp * 2 + ch) * 4096;
#pragma unroll
  for (int r = 0; r < 16; ++r) ST[(32 * eb + att::crow(r, hi)) * 64 + 32 * db + r32] = acc[r] * sc;
  MX_WAIT_ALL();
}
__device__ __forceinline__ void ret_scan(const Cx& cx, const P& p) {
  const float* __restrict__ ST = (const float*)(p.ws + OFF_RS); bf16_t* __restrict__ RT = (bf16_t*)(p.ws + OFF_RT);
  for (int i = cx.bid * NTHR + cx.tid; i < 12 * 4096; i += cx.G * NTHR) {
    const int bh = i >> 12, ed = i & 4095, h = bh % 6; const float lg = loggamma2(h), cd = exp2f(128.f * lg), g1 = exp2f(lg);
    const size_t o0 = (size_t)bh * 64 * 4096 + ed;
    float R = 0.f;
#pragma unroll
    for (int c0 = 0; c0 < 64; c0 += 16) {
      float kv[16];
#pragma unroll
      for (int k = 0; k < 16; ++k) kv[k] = ST[o0 + (size_t)(c0 + k) * 4096];
#pragma unroll
      for (int k = 0; k < 16; ++k) { RT[o0 + (size_t)(c0 + k) * 4096] = f2bf(R * g1); R = cd * R + kv[k]; }
    }
  }
}
__device__ __forceinline__ void ret_out_unit(const Cx& cx, const P& p, int u, char* lds) {
  const int tid = cx.tid, lane = tid & 63, r32 = lane & 31, hi = lane >> 5, wid = cx.wv;
  const int bh = u >> 5, cp = u & 31, b = bh / 6, h = bh % 6;
  const size_t r0 = (size_t)b * T_ + cp * 256;
  const bf16_t* HB = (const bf16_t*)(p.ws + OFF_HB);
  const bf16_t* Qp = HB + ((size_t)(0 + h) * M_ + r0) * 64; const bf16_t* Kp = HB + ((size_t)(6 + h) * M_ + r0) * 64;
  const bf16_t* Vp = HB + ((size_t)(12 + h) * M_ + r0) * 64; const bf16_t* Gp = HB + ((size_t)(18 + h) * M_ + r0) * 64;
  const unsigned lds0 = (unsigned)(uintptr_t)lds;
#pragma unroll
  for (int i = 0; i < 4; ++i) { dma_k_tile(Kp + (size_t)i * 4096, lds0 + i * 8192, lane, wid); dma_v_tile(Vp + (size_t)i * 4096, lds0 + 32768 + i * 8192, lane, wid); }
  const int ch = wid >> 2, rt = wid & 3, rw = ch * 128 + rt * 32;
  bf16x8 qr[4], rtf[2][4];
  const bf16_t* RT = (const bf16_t*)(p.ws + OFF_RT) + ((size_t)bh * 64 + cp * 2 + ch) * 4096;
#pragma unroll
  for (int d0 = 0; d0 < 4; ++d0) qr[d0] = *reinterpret_cast<const bf16x8*>(Qp + (size_t)(rw + r32) * 64 + d0 * 16 + hi * 8);
#pragma unroll
  for (int eb = 0; eb < 2; ++eb)
#pragma unroll
    for (int ks = 0; ks < 4; ++ks) rtf[eb][ks] = *reinterpret_cast<const bf16x8*>(RT + (size_t)(32 * eb + r32) * 64 + 16 * ks + 8 * hi);
  u32x4 gwv[4];
#pragma unroll
  for (int i = 0; i < 4; ++i) gwv[i] = *(const u32x4*)(Gp + (size_t)(rw + i * 8 + (lane >> 3)) * 64 + (lane & 7) * 8);
  MX_WAIT_ALL();
  f32x16 o[2]; o[0] = f32x16{}; o[1] = f32x16{};
  const f32x16 zero16 = f32x16{};
  const int n = rt * 32 + r32;
  for (int kt = 0; kt <= (rt >> 1); ++kt) {
    const int tile = ch * 2 + kt;
    const lds_cptr kp = (lds_cptr)(uintptr_t)(lds0 + tile * 8192) + hi * 1024 + r32 * 16;
    f32x16 p0 = MX_MFMA(kfrag(kp, 0, 0), qr[0], zero16), p1 = MX_MFMA(kfrag(kp, 0, 1), qr[0], zero16);
#pragma unroll
    for (int d0 = 1; d0 < 4; ++d0) { p0 = MX_MFMA(kfrag(kp, d0, 0), qr[d0], p0); p1 = MX_MFMA(kfrag(kp, d0, 1), qr[d0], p1); }
    if (kt == (rt >> 1)) {
#pragma unroll
      for (int r = 0; r < 16; ++r) { const int m = 64 * kt + att::crow(r, hi); if (m > n) p0[r] = 0.f; if (m + 32 > n) p1[r] = 0.f; }
    }
    u32x4 pw0, pw1, pw2, pw3;
    pw0 = (u32x4){att::cvtpk(p0[0], p0[1]), att::cvtpk(p0[2], p0[3]), att::cvtpk(p0[4], p0[5]), att::cvtpk(p0[6], p0[7])};
    pw1 = (u32x4){att::cvtpk(p0[8], p0[9]), att::cvtpk(p0[10], p0[11]), att::cvtpk(p0[12], p0[13]), att::cvtpk(p0[14], p0[15])};
    pw2 = (u32x4){att::cvtpk(p1[0], p1[1]), att::cvtpk(p1[2], p1[3]), att::cvtpk(p1[4], p1[5]), att::cvtpk(p1[6], p1[7])};
    pw3 = (u32x4){att::cvtpk(p1[8], p1[9]), att::cvtpk(p1[10], p1[11]), att::cvtpk(p1[12], p1[13]), att::cvtpk(p1[14], p1[15])};
    const lds_cptr vp = (lds_cptr)(uintptr_t)(lds0 + 32768 + tile * 8192) + vlane_off(lane);
#pragma unroll
    for (int d0 = 0; d0 < 2; ++d0) {
      o[d0] = MX_MFMA(__builtin_bit_cast(bf16x8, pw0), vfrag(vp, 4 * d0 + 0), o[d0]); o[d0] = MX_MFMA(__builtin_bit_cast(bf16x8, pw1), vfrag(vp, 4 * d0 + 1), o[d0]);
      o[d0] = MX_MFMA(__builtin_bit_cast(bf16x8, pw2), vfrag(vp, 4 * d0 + 2), o[d0]); o[d0] = MX_MFMA(__builtin_bit_cast(bf16x8, pw3), vfrag(vp, 4 * d0 + 3), o[d0]); }
  }
#pragma unroll
  for (int eb = 0; eb < 2; ++eb)
#pragma unroll
    for (int ks = 0; ks < 4; ++ks) o[eb] = MX_MFMA(qr[ks], rtf[eb][ks], o[eb]);
  float* stg = (float*)(lds + 65536) + wid * 2048;
#pragma unroll
  for (int r = 0; r < 16; ++r) { const int orow = att::crow(r, hi); stg[orow * 64 + r32] = o[0][r]; stg[orow * 64 + 32 + r32] = o[1][r]; }
  asm volatile("s_waitcnt lgkmcnt(0)" ::: "memory");
  bf16_t* mix = (bf16_t*)(p.ws + OFF_MIX) + (r0 + rw) * D_ + h * 64;
#pragma unroll
  for (int i = 0; i < 4; ++i) { const int row = i * 8 + (lane >> 3), c8 = lane & 7;
    const f32x4 a0 = *(const f32x4*)(stg + row * 64 + c8 * 8), a1 = *(const f32x4*)(stg + row * 64 + c8 * 8 + 4);
    float ss = (a0[0] * a0[0] + a0[1] * a0[1]) + (a0[2] * a0[2] + a0[3] * a0[3]) + (a1[0] * a1[0] + a1[1] * a1[1]) + (a1[2] * a1[2] + a1[3] * a1[3]);
    ss += __shfl_xor(ss, 1); ss += __shfl_xor(ss, 2); ss += __shfl_xor(ss, 4);
    const float rs = rsqrtf(ss * (1.f / 64.f) + EPS);
    const u32x4 gw = gwv[i];
    float gv[8] = {__uint_as_float(gw.x << 16), __uint_as_float(gw.x & 0xffff0000u), __uint_as_float(gw.y << 16), __uint_as_float(gw.y & 0xffff0000u),
                   __uint_as_float(gw.z << 16), __uint_as_float(gw.z & 0xffff0000u), __uint_as_float(gw.w << 16), __uint_as_float(gw.w & 0xffff0000u)};
    float ov[8] = {a0[0], a0[1], a0[2], a0[3], a1[0], a1[1], a1[2], a1[3]};
#pragma unroll
    for (int k = 0; k < 8; ++k) ov[k] = ov[k] * rs * (gv[k] * sigmoidf(gv[k]));
    u32x4 w; w.x = pk2(ov[0], ov[1]); w.y = pk2(ov[2], ov[3]); w.z = pk2(ov[4], ov[5]); w.w = pk2(ov[6], ov[7]);
    *(u32x4*)(mix + (size_t)row * D_ + c8 * 8) = w; }
  MX_WAIT_ALL();
}
__device__ __forceinline__ void gmlp_unit(const Cx& cx, const P& p, int layer, int u, char* lds) {
  const int tid = cx.tid, lane = tid & 63, r32 = lane & 31, hi = lane >> 5, wid = cx.wv;
  const int g = u & 3, bc = u >> 2; const size_t r0 = (size_t)bc * 128;
  const bf16_t* HB = (const bf16_t*)(p.ws + OFF_HB);
  const bf16_t* Up = HB + ((size_t)(42 + g) * M_ + r0) * 64; const bf16_t* Vp = HB + ((size_t)(46 + g) * M_ + r0) * 64;
  const unsigned lds0 = (unsigned)(uintptr_t)lds;
  dma_v_tile(Vp, lds0, lane, wid); dma_v_tile(Vp + 4096, lds0 + 8192, lane, wid);
  const int rt = wid & 3, dh = wid >> 2;
  const bf16_t* Wr = (const bf16_t*)(p.ws + OFF_WSB) + ((size_t)(layer * 4 + g) * 128 + rt * 32 + r32) * 128;
  u32x4 uwv[2]; float bsv[2];
#pragma unroll
  for (int i = 0; i < 2; ++i) { const int t = rt * 32 + i * 16 + (lane >> 2); uwv[i] = *(const u32x4*)(Up + (size_t)t * 64 + dh * 32 + (lane & 3) * 8); bsv[i] = p.gm_b[(layer * 4 + g) * 128 + t]; }
  MX_WAIT_ALL();
  f32x16 acc = f32x16{};
  for (int ks = 0; ks < 2 * rt + 2; ++ks) {
    const uint2 alo = *(const uint2*)(Wr + 16 * ks + 4 * hi), ahi = *(const uint2*)(Wr + 16 * ks + 8 + 4 * hi);
    const u32x4 aw = (u32x4){alo.x, alo.y, ahi.x, ahi.y};
    const lds_cptr vp = (lds_cptr)(uintptr_t)(lds0 + (ks >> 2) * 8192) + vlane_off(lane);
    acc = MX_MFMA(__builtin_bit_cast(bf16x8, aw), vfrag(vp, 4 * dh + (ks & 3)), acc);
  }
  float* stg = (float*)(lds + 16384) + wid * 1024;
#pragma unroll
  for (int r = 0; r < 16; ++r) stg[att::crow(r, hi) * 32 + r32] = acc[r];
  asm volatile("s_waitcnt lgkmcnt(0)" ::: "memory");
  bf16_t* mix = (bf16_t*)(p.ws + OFF_MIX) + (r0 + rt * 32) * D_ + 768 + g * 64 + dh * 32;
#pragma unroll
  for (int i = 0; i < 2; ++i) { const int row = i * 16 + (lane >> 2), c8 = lane & 3, t = rt * 32 + row;
    const f32x4 a0 = *(const f32x4*)(stg + row * 32 + c8 * 8), a1 = *(const f32x4*)(stg + row * 32 + c8 * 8 + 4);
    const float bias = bsv[i];
    const u32x4 uw = uwv[i];
    u32x4 w; w.x = pk2(__uint_as_float(uw.x << 16) * (a0[0] + bias), __uint_as_float(uw.x & 0xffff0000u) * (a0[1] + bias));
    w.y = pk2(__uint_as_float(uw.y << 16) * (a0[2] + bias), __uint_as_float(uw.y & 0xffff0000u) * (a0[3] + bias));
    w.z = pk2(__uint_as_float(uw.z << 16) * (a1[0] + bias), __uint_as_float(uw.z & 0xffff0000u) * (a1[1] + bias));
    w.w = pk2(__uint_as_float(uw.w << 16) * (a1[2] + bias), __uint_as_float(uw.w & 0xffff0000u) * (a1[3] + bias));
    *(u32x4*)(mix + (size_t)row * D_ + c8 * 8) = w; }
  MX_WAIT_ALL();
}
__device__ __forceinline__ void cmp_unit(const Cx& cx, const P& p, int layer, int u, char* lds) {
  const int tid = cx.tid, lane = tid & 63, r32 = lane & 31, hi = lane >> 5, wid = cx.wv;
  const int nt = u & 15, bgj = u >> 4, bg = bgj >> 1, j = bgj & 1, b = bg >> 1, g = bg & 1;
  const int nrow = min(nt * 32 + r32, 510);
  const bf16_t* xf = (const bf16_t*)(p.ws + OFF_HB) + ((size_t)(30 + j * 2 + g) * M_ + (size_t)b * T_) * 64 + (size_t)nrow * 1024;
  const bf16_t* W1T = (const bf16_t*)(p.ws + OFF_W1T) + (size_t)(layer * 2 + j) * 64 * 2048;
  f32x16 acc[2]; acc[0] = f32x16{}; acc[1] = f32x16{};
#pragma unroll 4
  for (int ks = 0; ks < 16; ++ks) { const int i0 = 256 * wid + 16 * ks + 8 * hi;
    const bf16x8 bx = *reinterpret_cast<const bf16x8*>(xf + i0);
    const bf16x8 a0 = *reinterpret_cast<const bf16x8*>(W1T + (size_t)r32 * 2048 + i0), a1 = *reinterpret_cast<const bf16x8*>(W1T + (size_t)(32 + r32) * 2048 + i0);
    acc[0] = MX_MFMA(a0, bx, acc[0]); acc[1] = MX_MFMA(a1, bx, acc[1]); }
  float* red = (float*)lds;
#pragma unroll
  for (int fb = 0; fb < 2; ++fb)
#pragma unroll
    for (int r = 0; r < 16; ++r) red[((wid * 2 + fb) * 16 + r) * 64 + lane] = acc[fb][r];
  MX_WAIT_ALL();
  if (wid == 0) {
    const float* c1 = (const float*)(p.ws + OFF_C1) + (layer * 2 + j) * 64;
    bf16x8 hb[2][2];
#pragma unroll
    for (int fb = 0; fb < 2; ++fb) { float hv[16];
#pragma unroll
      for (int r = 0; r < 16; ++r) { float a = c1[32 * fb + att::crow(r, hi)];
#pragma unroll
        for (int w = 0; w < 8; ++w) a += red[((w * 2 + fb) * 16 + r) * 64 + lane];
        hv[r] = gelu_tanh(a); }
#pragma unroll
      for (int s2 = 0; s2 < 2; ++s2) { const u32x4 w = (u32x4){att::cvtpk(hv[8 * s2], hv[8 * s2 + 1]), att::cvtpk(hv[8 * s2 + 2], hv[8 * s2 + 3]), att::cvtpk(hv[8 * s2 + 4], hv[8 * s2 + 5]), att::cvtpk(hv[8 * s2 + 6], hv[8 * s2 + 7])};
        hb[fb][s2] = __builtin_bit_cast(bf16x8, w); } }
    const float* w2 = p.cmp_w2 + (size_t)(layer * 2 + j) * 4096;
    f32x16 oc[2]; oc[0] = f32x16{}; oc[1] = f32x16{};
#pragma unroll
    for (int eb = 0; eb < 2; ++eb)
#pragma unroll
      for (int fb = 0; fb < 2; ++fb)
#pragma unroll
        for (int s2 = 0; s2 < 2; ++s2) { float wv[8];
#pragma unroll
          for (int jj = 0; jj < 8; ++jj) wv[jj] = w2[(32 * fb + 16 * s2 + 8 * (jj >> 2) + 4 * hi + (jj & 3)) * 64 + 32 * eb + r32];
          const u32x4 aw = (u32x4){pk2(wv[0], wv[1]), pk2(wv[2], wv[3]), pk2(wv[4], wv[5]), pk2(wv[6], wv[7])};
          oc[eb] = MX_MFMA(__builtin_bit_cast(bf16x8, aw), hb[fb][s2], oc[eb]); }
    if (j == 0) { float ss = 0.f;
#pragma unroll
      for (int eb = 0; eb < 2; ++eb)
#pragma unroll
        for (int r = 0; r < 16; ++r) ss += oc[eb][r] * oc[eb][r];
      ss += __shfl_xor(ss, 32);
      const float rs = rsqrtf(ss * (1.f / 64.f) + EPS);
#pragma unroll
      for (int eb = 0; eb < 2; ++eb)
#pragma unroll
        for (int r = 0; r < 16; ++r) oc[eb][r] *= rs * p.k_gain[(layer * 3 + 0) * 64 + 32 * eb + att::crow(r, hi)]; }
    bf16_t* dst = (bf16_t*)(p.ws + (j == 0 ? OFF_KC : OFF_VC)) + ((size_t)bg * 512 + nt * 32 + r32) * 64;
    const bool real = (nt * 32 + r32) < 511;
    if (real) {
#pragma unroll
      for (int eb = 0; eb < 2; ++eb)
#pragma unroll
        for (int r = 0; r < 16; ++r) dst[32 * eb + att::crow(r, hi)] = f2bf(oc[eb][r]); }
  }
  MX_WAIT_ALL();
}
#undef MX_MFMA
}

__device__ __forceinline__ void ph_mix1(const Cx& cx, const P& p, int layer, char* lds, int rank, int nranks) {
  for (int item = rank; item < 128 + 384; item += nranks) {
    Cx c2 = cx; c2.tid = cx.wv * 64 + lane_id(); asm volatile("" : "+v"(c2.tid));
    if (item < 128) mx::cmp_unit(c2, p, layer, item, lds); else mx::ret_kv_unit(c2, p, item - 128, lds);
  }
}
__device__ __forceinline__ void ph_mix2(const Cx& cx, const P& p, int layer, char* lds) {
  for (int u = cx.bid; u < 256; u += cx.G) { Cx c2 = cx; c2.tid = cx.wv * 64 + lane_id(); asm volatile("" : "+v"(c2.tid)); topk_unit(c2, p, u, lds); }
  { Cx c3 = cx; c3.bid = cx.G - 1 - cx.bid; mx::ret_scan(c3, p); }
  if (layer == 0) convert_weights(p, (LAS unsigned char*)lds, cx.wv, lane_id(), cx.bid * 8 + cx.wv, cx.G * 8, 6400, 8576);
}
__device__ __forceinline__ void ph_mix3(const Cx& cx, const P& p, int layer, char* lds) {
  const int nconv = (layer == 0) ? 148 : 0;
  unsigned* ctr = (unsigned*)(p.ws + OFF_CTR) + layer * 64;
  int* slot = (int*)(lds + 131072);
  for (;;) {
    __syncthreads();
    if (cx.wv == 0 && lane_id() == 0) *slot = (int)atomicAdd(ctr, 1u);
    __syncthreads();
    const int item = __builtin_amdgcn_readfirstlane(*slot);
    if (item >= 384 + 384 + 512 + nconv) break;
    Cx c2 = cx; c2.tid = cx.wv * 64 + lane_id(); asm volatile("" : "+v"(c2.tid));
    if (item < 384) nsa_unit(c2, p, item, lds); else if (item < 768) mx::ret_out_unit(c2, p, item - 384, lds);
    else if (item < 1280) mx::gmlp_unit(c2, p, layer, item - 768, lds);
    else { const int c0 = 1664 + (item - 1280) * 32; convert_weights(p, (LAS unsigned char*)lds, cx.wv, lane_id(), cx.wv, 8, c0, min(c0 + 32, 6400)); }
  }
}
typedef unsigned gu32_t;
#define XB_TMO      128
#define XB_XCNT(j)  (256  + 64 * (j))
#define XB_XSUB(j)  (1280 + 64 * (j))
#define XB_XGEN(j)  (2304 + 64 * (j))
#define XB_TOP      3328
#define XB_TOPGEN   3392
#define XCD_BAR_WORDS 3456
#define XB_SPIN_CAP (1u << 18)

__device__ __forceinline__ unsigned xb_ld(unsigned* p)              { return __hip_atomic_load(p, __ATOMIC_RELAXED, __HIP_MEMORY_SCOPE_AGENT); }
__device__ __forceinline__ unsigned xb_add(unsigned* p, unsigned v) { return __hip_atomic_fetch_add(p, v, __ATOMIC_RELAXED, __HIP_MEMORY_SCOPE_AGENT); }
__device__ __forceinline__ unsigned xb_xcc_id() { return (unsigned)__builtin_amdgcn_s_getreg((3 << 11) | 20) & 0xFu; }
#define XB_SPIN(cond, bar) do { unsigned _sp = 0; while (cond) { __builtin_amdgcn_s_sleep(1); \
    if ((++_sp & 255u) == 0u) { if (xb_ld(&(bar)[XB_TMO])) break; if (_sp > XB_SPIN_CAP) { atomicAdd(&(bar)[XB_TMO], 1u); break; } } } } while (0)

struct XcdBarrier {
    unsigned* bar; unsigned x;
    volatile LAS unsigned* st;
    int wv;
};

__device__ __forceinline__ XcdBarrier xcd_barrier_post(unsigned* bar, volatile LAS unsigned* st, int wv) {
    XcdBarrier b; b.bar = bar; b.x = xb_xcc_id(); b.st = st; b.wv = wv;
    if (wv == 0 && lane_id() == 0) (void)xb_add(&bar[XB_XCNT(b.x)], 1u);
    return b;
}
__device__ __forceinline__ void xcd_barrier_complete(unsigned* bar, unsigned x, unsigned& nloc, unsigned& nx) {
    const unsigned G = gridDim.x * gridDim.y * gridDim.z;
    unsigned sum, cnt, mine, sp = 0u;
    for (;;) {
        sum = 0u; cnt = 0u; mine = 0u;
#pragma unroll
        for (unsigned j = 0; j < 16; ++j) { const unsigned c = xb_ld(&bar[XB_XCNT(j)]); sum += c; cnt += (c > 0u) ? 1u : 0u; mine = (j == x) ? c : mine; }
        if (sum == G) break;
        __builtin_amdgcn_s_sleep(1);
        if ((++sp & 255u) == 0u) { if (xb_ld(&bar[XB_TMO])) break; if (sp > XB_SPIN_CAP) { atomicAdd(&bar[XB_TMO], 1u); break; } }
    }
    nloc = mine > 0u ? mine : 1u; nx = cnt > 0u ? cnt : 1u;
}

__device__ __forceinline__ void xcd_barrier(const XcdBarrier& b) {
    asm volatile("s_waitcnt vmcnt(0)" ::: "memory");
    __syncthreads();
    if (b.wv == 0 && lane_id() == 0) {
        unsigned* bar = b.bar;
        __builtin_amdgcn_s_waitcnt(0);
        unsigned nloc = b.st[0], nx = b.st[1];
        if (nloc == 0u) { xcd_barrier_complete(bar, b.x, nloc, nx); b.st[0] = nloc; b.st[1] = nx; }
        const unsigned old = xb_add(&bar[XB_XSUB(b.x)], 1u);
        const unsigned gen = old / nloc;
        if (old + 1u == (gen + 1u) * nloc) {
            __builtin_amdgcn_fence(__ATOMIC_RELEASE, "agent");
            asm volatile("s_waitcnt vmcnt(0)" ::: "memory");
            const unsigned og = xb_add(&bar[XB_TOP], 1u);
            const unsigned tg = og / nx;
            if (og + 1u == (tg + 1u) * nx) xb_add(&bar[XB_TOPGEN], 1u);
            else XB_SPIN(xb_ld(&bar[XB_TOPGEN]) == tg, bar);
            __builtin_amdgcn_fence(__ATOMIC_ACQUIRE, "agent");
            xb_add(&bar[XB_XGEN(b.x)], 1u);
            asm volatile("s_waitcnt vmcnt(0)" ::: "memory");
        } else {
            XB_SPIN(xb_ld(&bar[XB_XGEN(b.x)]) == gen, bar);
            __builtin_amdgcn_fence(__ATOMIC_ACQUIRE, "agent");
            asm volatile("s_waitcnt vmcnt(0)" ::: "memory");
        }
    }
    __syncthreads();
}

__global__ void __launch_bounds__(NTHR, 2) k_mega(P pk) {
  extern __shared__ __attribute__((aligned(16))) unsigned char lds_raw[];
  LAS unsigned char* lds = (LAS unsigned char*)lds_raw;
  float* sm = (float*)lds_raw;
  const int wave_s = __builtin_amdgcn_readfirstlane((int)threadIdx.x >> 6);
  { volatile LAS unsigned* bst = (volatile LAS unsigned*)(lds + 131072 + 64);
    if (threadIdx.x < 2) bst[threadIdx.x] = 0u;
    __syncthreads();
    (void)xcd_barrier_post((unsigned*)(pk.ws + OFF_BAR), bst, wave_s); }
#define GSYNC() do { kargp_t kb_ = (kargp_t)__builtin_amdgcn_kernarg_segment_ptr(); asm volatile("" : "+s"(kb_)); XcdBarrier xb_; xb_.bar = (unsigned*)(kb_->ws + OFF_BAR); xb_.x = xb_xcc_id(); \
    xb_.st = (volatile LAS unsigned*)(lds + 131072 + 64); xb_.wv = wave_s; xcd_barrier(xb_); } while (0)
#define LOADP(p, k) do { p.x = k->x; p.attn_norm = k->attn_norm; p.w_in = k->w_in; p.w_out = k->w_out; p.q_gain = k->q_gain; p.k_gain = k->k_gain; p.cmp_pe = k->cmp_pe; p.cmp_w1 = k->cmp_w1; p.cmp_w2 = k->cmp_w2; \
    p.gm_ws = k->gm_ws; p.gm_b = k->gm_b; p.ffn_norm = k->ffn_norm; p.w_gu = k->w_gu; p.w_down = k->w_down; p.rel_bias = k->rel_bias; p.out = k->out; p.ws = k->ws; } while (0)
  typedef const __attribute__((address_space(4))) P* kargp_t;
#define PB Cx cx; P p; { int t_ = wave_s * 64 + lane_id(), b_ = blockIdx.x; kargp_t k_ = (kargp_t)__builtin_amdgcn_kernarg_segment_ptr(); asm volatile("" : "+v"(t_), "+s"(b_), "+s"(k_)); LOADP(p, k_); cx.tid = t_; cx.bid = b_; cx.G = gridDim.x; cx.wv = wave_s; }
  { PB; ph_prologue(cx, p, lds); }
  GSYNC();
#pragma unroll 1
  for (int layer = 0; layer < 2; ++layer) {
    { PB; pg8::Gemm g{(const bf16_t*)(p.ws + OFF_XB), (const bf16_t*)(p.ws + OFF_WIN) + (size_t)layer * NPROJ * D_, M_, 3072, D_}; pg8::StaticOrder S; S.init(M_, 3072, cx.G, cx.bid);
      EpiProj E{(const float*)(p.ws + OFF_SSQ), (bf16_t*)(p.ws + OFF_HB), (float*)(p.ws + OFF_GATES), (const float2*)(p.ws + OFF_ROPE), p.q_gain + layer * 64, p.k_gain + layer * 192};
      pg8::gemm_phase<EpiProj, pg8::StaticOrder, PG8_ALIGN, PG8_SP2>(lds, g, S, E, cx.tid); }
    GSYNC();
    { PB; if (cx.bid < 64) {
        pg8::Gemm g2{(const bf16_t*)(p.ws + OFF_XB), (const bf16_t*)(p.ws + OFF_WIN) + (size_t)layer * NPROJ * D_, M_, NPROJ, D_}; pg8::OneUnit S2{cx.bid, 12, true};
        EpiProj E{(const float*)(p.ws + OFF_SSQ), (bf16_t*)(p.ws + OFF_HB), (float*)(p.ws + OFF_GATES), (const float2*)(p.ws + OFF_ROPE), p.q_gain + layer * 64, p.k_gain + layer * 192};
        pg8::gemm_phase<EpiProj, pg8::OneUnit, false, PG8_SP2>(lds, g2, S2, E, cx.tid);
      } else ph_mix1(cx, p, layer, (char*)lds_raw, cx.bid - 64, cx.G - 64); }
    GSYNC();
    { PB; ph_mix2(cx, p, layer, (char*)lds_raw); } GSYNC();
    { PB; ph_mix3(cx, p, layer, (char*)lds_raw); } GSYNC();
    { PB; pg8::Gemm g{(const bf16_t*)(p.ws + OFF_MIX), (const bf16_t*)(p.ws + OFF_WO) + (size_t)layer * D_ * D_, M_, D_, D_}; pg8::StaticOrder S; S.init(M_, D_, cx.G, cx.bid);
      EpiRes E{(layer == 0) ? p.x : nullptr, nullptr, (bf16_t*)(p.ws + OFF_XB), (float*)(p.ws + OFF_SSQ)};
      pg8::gemm_phase<EpiRes, pg8::StaticOrder, PG8_ALIGN, PG8_SP2>(lds, g, S, E, cx.tid); }
    GSYNC();
    { PB; pg8::Gemm g{(const bf16_t*)(p.ws + OFF_XB), (const bf16_t*)(p.ws + OFF_WGU) + (size_t)layer * 2 * DFF * D_, M_, 2 * DFF, D_}; pg8::StaticOrder S; S.init(M_, 2 * DFF, cx.G, cx.bid);
      EpiGU E{(const float*)(p.ws + OFF_SSQ), (bf16_t*)(p.ws + OFF_ACT)};
      pg8::gemm_phase<EpiGU, pg8::StaticOrder, PG8_ALIGN, PG8_SP2>(lds, g, S, E, cx.tid);
      { const int c0 = (cx.G > 128) ? 128 : 0; if (layer == 0 && cx.bid >= c0) convert_weights(p, lds, cx.wv, cx.tid & 63, (cx.bid - c0) * 8 + cx.wv, (cx.G - c0) * 8, 8576, 12800); } }
    GSYNC();
    { PB; pg8::Gemm g{(const bf16_t*)(p.ws + OFF_ACT), (const bf16_t*)(p.ws + OFF_WD) + (size_t)layer * D_ * DFF, M_, D_, DFF}; pg8::StaticOrder S; S.init(M_, D_, cx.G, cx.bid);
      EpiRes E{nullptr, (layer == 1) ? p.out : nullptr, (bf16_t*)(p.ws + OFF_XB), (float*)(p.ws + OFF_SSQ)};
      pg8::gemm_phase<EpiRes, pg8::StaticOrder, PG8_ALIGN, PG8_SP2>(lds, g, S, E, cx.tid); }
    GSYNC();
  }
}

extern "C" void kernel_launch(void* const* d_in, const int* in_sizes, int n_in, void* d_out, int out_size, void* d_ws, size_t ws_size, hipStream_t stream) {
  P p{};
  p.x = (const float*)d_in[0]; p.attn_norm = (const float*)d_in[1]; p.w_in = (const float*)d_in[2]; p.w_out = (const float*)d_in[3];
  p.q_gain = (const float*)d_in[4]; p.k_gain = (const float*)d_in[5]; p.cmp_pe = (const float*)d_in[6]; p.cmp_w1 = (const float*)d_in[7];
  p.cmp_w2 = (const float*)d_in[8]; p.gm_ws = (const float*)d_in[9]; p.gm_b = (const float*)d_in[10]; p.ffn_norm = (const float*)d_in[11];
  p.w_gu = (const float*)d_in[12]; p.w_down = (const float*)d_in[13]; p.rel_bias = (const float*)d_in[14];
  p.out = (float*)d_out; p.ws = (unsigned char*)d_ws;
  static int grid = 0;
  if (!grid) {
    (void)hipFuncSetAttribute((const void*)k_mega, hipFuncAttributeMaxDynamicSharedMemorySize, LDS_BYTES);
    int dev = 0, cus = 0, per_cu = 0;
    (void)hipGetDevice(&dev);
    (void)hipDeviceGetAttribute(&cus, hipDeviceAttributeMultiprocessorCount, dev);
    (void)hipOccupancyMaxActiveBlocksPerMultiprocessor(&per_cu, (const void*)k_mega, NTHR, LDS_BYTES);
    if (per_cu < 1) per_cu = 1;
    grid = cus;
  }
  (void)hipMemsetAsync((char*)d_ws + OFF_BAR, 0, 16384, stream);
  void* args[] = {&p};
  hipError_t e = hipLaunchCooperativeKernel((const void*)k_mega, dim3(grid), dim3(NTHR), args, LDS_BYTES, stream);
  if (e != hipSuccess) fprintf(stderr, "cooperative launch failed: %s (grid %d)\n", hipGetErrorString(e), grid);
}
```

```cpp
#include <hip/hip_runtime.h>
#include <hip/hip_cooperative_groups.h>
#include <stdint.h>
#include <stdio.h>
namespace cg = cooperative_groups;
namespace pg8 {
#define PG8_LAS __attribute__((address_space(3)))
typedef unsigned short bf16_t;
typedef short bf16x8 __attribute__((ext_vector_type(8)));
typedef float f32x4 __attribute__((ext_vector_type(4)));
typedef unsigned u32x4 __attribute__((ext_vector_type(4)));
constexpr int BM = 256, BK = 64, HALF = 128, HTB = HALF * BK * 2  , STAGE_BYTES = 8 * HTB, NXCD = 8, WGM = 8;

__host__ __device__ __forceinline__ int lds_byte(int r, int c) { const int st = (r >> 4) * 2 + (c >> 5), rr = r & 15, cc = c & 31, ob = rr * 64 + cc * 2; return st * 1024 + (ob ^ (((ob >> 9) & 1) << 5)); }
__host__ __device__ __forceinline__ void stage_rc(int b, int& R, int& C) { const int st = b / 1024, sb = b % 1024, swz = sb ^ (((sb >> 9) & 1) << 5); R = (st >> 1) * 16 + swz / 64; C = (st & 1) * 32 + (swz % 64) / 2; }
__host__ __device__ __forceinline__ int perm32(int rho) { const int n = rho >> 4, i = rho & 15; return 8 * (i >> 2) + 4 * n + (i & 3); }

struct Unit { int pm, pn; };
struct Gemm { const bf16_t* A; const bf16_t* Bt; int M, N, K; };

struct StaticOrder {
    int nM, nN, nwg, G, c;
    __host__ __device__ void init(int M, int N, int G_, int c_) { nM = M / BM; nN = N / BM; nwg = nM * nN; G = G_; c = c_; }
    __host__ __device__ bool next(int i, Unit& u) const {
        const long L = (long)i * G + c; if (L >= nwg) return false;
        int wgid = (int)L; { const int q = nwg / NXCD, r = nwg % NXCD, xcd = wgid % NXCD, off = wgid / NXCD; wgid = (xcd < r ? xcd * (q + 1) : r * (q + 1) + (xcd - r) * q) + off; }
        const int nig = WGM * nN, gid = wgid / nig, fm = gid * WGM, gsz = (nM - fm) < WGM ? (nM - fm) : WGM;
        u.pm = fm + ((wgid % nig) % gsz); u.pn = (wgid % nig) / gsz; return true;
    }
    __device__ __forceinline__ void a_ready(const Unit&) const {}
    __device__ __forceinline__ void done(const Unit&) const {}
};

struct OneUnit {
    int pm, pn; bool have;
    __host__ __device__ bool next(int i, Unit& u) const { if (i > 0 || !have) return false; u.pm = pm; u.pn = pn; return true; }
    __device__ __forceinline__ void a_ready(const Unit&) const {}
    __device__ __forceinline__ void done(const Unit&) const {}
};
__device__ __forceinline__ unsigned cvt_pk_bf16(float lo, float hi) { unsigned r; asm volatile("v_cvt_pk_bf16_f32 %0, %1, %2" : "=v"(r) : "v"(lo), "v"(hi)); return r; }
typedef float f32x2 __attribute__((ext_vector_type(2)));
template <class Epi, class Sched, bool ALIGN_EPI = false, bool SP2 = false>
__device__ __forceinline__ void gemm_phase(PG8_LAS unsigned char* lds, const Gemm g, const Sched& S, const Epi& E, const int tid) {
    const int wid = __builtin_amdgcn_readfirstlane(tid >> 6), lane = tid & 63, wr = wid >> 2, wc = wid & 3, fr = lane & 15, fq = lane >> 4;
    const int K = g.K, nt = K / BK;
    unsigned voffA[2], voffB[2];
#pragma unroll
    for (int i = 0; i < 2; ++i) { int R, C; stage_rc(tid * 16 + i * 8192, R, C); const int Rb = Epi::PERM ? ((R & ~31) + perm32(R & 31)) : R;
        voffA[i] = (unsigned)(R * K + C) * 2u; voffB[i] = (unsigned)(Rb * K + C) * 2u; }
    const size_t kstep = (size_t)(BK * 2);
    const size_t hstep = (size_t)HALF * K * 2;
    const size_t tstep = 2 * hstep;
    const unsigned ldsw = (unsigned)wid * 1024u;
    const int aoff = lds_byte(wr * 64 + fr, fq * 8), boff = lds_byte(wc * 32 + fr, fq * 8);
#define PG8_SA(b, h) (((b) * 2 + (h)) * HTB)
#define PG8_SB(b, h) ((4 + (b) * 2 + (h)) * HTB)
#define PG8_STAGE(bufoff, gbase, voff) do { _Pragma("unroll") for (int _i = 0; _i < 2; ++_i) \
        __builtin_amdgcn_global_load_lds((const unsigned*)((const char*)(gbase) + (voff)[_i]), (PG8_LAS unsigned*)(lds + (bufoff) + ldsw + _i * 8192), 16, 0, 0); } while (0)
#define PG8_LDA(dst, b, h) do { _Pragma("unroll") for (int m = 0; m < 4; ++m) _Pragma("unroll") for (int k = 0; k < 2; ++k) dst[m][k] = *(const PG8_LAS bf16x8*)(lds + PG8_SA(b, h) + aoff + m * 2048 + k * 1024); } while (0)
#define PG8_LDB(dst, b, h) do { _Pragma("unroll") for (int n = 0; n < 2; ++n) _Pragma("unroll") for (int k = 0; k < 2; ++k) dst[n][k] = *(const PG8_LAS bf16x8*)(lds + PG8_SB(b, h) + boff + n * 2048 + k * 1024); } while (0)
#define PG8_MMA(ai, bj, At, Bt) do { __builtin_amdgcn_s_setprio(1); _Pragma("unroll") for (int m = 0; m < 4; ++m) _Pragma("unroll") for (int n = 0; n < 2; ++n) _Pragma("unroll") for (int k = 0; k < 2; ++k) \
        acc[ai][bj][m][n] = __builtin_amdgcn_mfma_f32_16x16x32_bf16(Bt[n][k], At[m][k], acc[ai][bj][m][n], 0, 0, 0); __builtin_amdgcn_s_setprio(0); } while (0)
#define PG8_WAIT_V(n) asm volatile("s_waitcnt vmcnt(" #n ")" ::: "memory")
#define PG8_WAIT_L(n) asm volatile("s_waitcnt lgkmcnt(" #n ")" ::: "memory")
#define PG8_BAR __builtin_amdgcn_s_barrier()
#define PG8_SCHED __builtin_amdgcn_sched_barrier(0)
    Unit cur, nxt; int ui = 0;
    if (!S.next(0, cur)) return;
    f32x4 acc[2][2][4][2];
#pragma unroll
    for (int a = 0; a < 2; ++a)
#pragma unroll
        for (int b = 0; b < 2; ++b)
#pragma unroll
            for (int m = 0; m < 4; ++m)
#pragma unroll
                for (int n = 0; n < 2; ++n) acc[a][b][m][n] = (f32x4){0.f, 0.f, 0.f, 0.f};
    bf16x8 At[4][2], B0[2][2], B1[2][2];
    const char* cA = (const char*)g.A + (size_t)cur.pm * tstep; const char* cB = (const char*)g.Bt + (size_t)cur.pn * tstep;
    S.a_ready(cur);
    if constexpr (SP2) {
        PG8_STAGE(PG8_SB(0, 0), cB, voffB); PG8_STAGE(PG8_SB(0, 1), cB + hstep, voffB); PG8_STAGE(PG8_SA(0, 0), cA, voffA); PG8_STAGE(PG8_SA(0, 1), cA + hstep, voffA);
        if (wr == 1) PG8_BAR;
        PG8_WAIT_V(2); PG8_BAR;
        PG8_STAGE(PG8_SB(1, 0), cB + kstep, voffB); PG8_STAGE(PG8_SA(1, 0), cA + kstep, voffA); PG8_STAGE(PG8_SB(1, 1), cB + hstep + kstep, voffB);
        PG8_WAIT_V(6); PG8_BAR;
    } else {
        PG8_STAGE(PG8_SB(0, 0), cB, voffB); PG8_STAGE(PG8_SA(0, 0), cA, voffA); PG8_STAGE(PG8_SB(0, 1), cB + hstep, voffB); PG8_STAGE(PG8_SA(0, 1), cA + hstep, voffA);
        if (wr == 1) PG8_BAR;
        PG8_WAIT_V(4); PG8_BAR;
        PG8_STAGE(PG8_SB(1, 0), cB + kstep, voffB); PG8_STAGE(PG8_SA(1, 0), cA + kstep, voffA); PG8_STAGE(PG8_SB(1, 1), cB + hstep + kstep, voffB);
        PG8_WAIT_V(6); PG8_BAR;
    }
    for (;;) {
        const bool has_next = S.next(ui + 1, nxt);
        const char* nA = has_next ? (const char*)g.A + (size_t)nxt.pm * tstep : cA; const char* nB = has_next ? (const char*)g.Bt + (size_t)nxt.pn * tstep : cB;
        for (int t = 0; t < nt; t += 2) {
            const bool last = (t == nt - 2);
            const char* a1 = cA + (size_t)(t + 1) * kstep;
            const char* a2 = last ? nA : cA + (size_t)(t + 2) * kstep; const char* b2 = last ? nB : cB + (size_t)(t + 2) * kstep;
            const char* a3 = a2 + kstep; const char* b3 = b2 + kstep;
            if (last && has_next) S.a_ready(nxt);
            if constexpr (SP2) {
            PG8_LDB(B0, 0, 0); PG8_LDB(B1, 0, 1); PG8_SCHED; PG8_LDA(At, 0, 0); PG8_STAGE(PG8_SA(1, 1), a1 + hstep, voffA);
            PG8_WAIT_V(8); PG8_WAIT_L(0); PG8_BAR; PG8_MMA(0, 0, At, B0); PG8_MMA(0, 1, At, B1); PG8_BAR; PG8_SCHED;
            PG8_LDA(At, 0, 1); PG8_STAGE(PG8_SB(0, 0), b2, voffB); PG8_STAGE(PG8_SB(0, 1), b2 + hstep, voffB); PG8_STAGE(PG8_SA(0, 0), a2, voffA);
            PG8_WAIT_V(8); PG8_WAIT_L(0); PG8_BAR; PG8_MMA(1, 0, At, B0); PG8_MMA(1, 1, At, B1); PG8_BAR; PG8_SCHED;
            PG8_LDB(B0, 1, 0); PG8_LDB(B1, 1, 1); PG8_SCHED; PG8_LDA(At, 1, 0); PG8_STAGE(PG8_SA(0, 1), a2 + hstep, voffA);
            PG8_WAIT_V(8); PG8_WAIT_L(0); PG8_BAR; PG8_MMA(0, 0, At, B0); PG8_MMA(0, 1, At, B1); PG8_BAR; PG8_SCHED;
            PG8_LDA(At, 1, 1); PG8_STAGE(PG8_SB(1, 0), b3, voffB); PG8_STAGE(PG8_SB(1, 1), b3 + hstep, voffB); PG8_STAGE(PG8_SA(1, 0), a3, voffA);
            PG8_WAIT_V(8); PG8_WAIT_L(0); PG8_BAR; PG8_MMA(1, 0, At, B0); PG8_MMA(1, 1, At, B1); PG8_BAR; PG8_SCHED;
            } else {
            PG8_LDB(B0, 0, 0); PG8_SCHED; PG8_LDA(At, 0, 0); PG8_STAGE(PG8_SA(1, 1), a1 + hstep, voffA);
            PG8_WAIT_L(8); PG8_BAR; PG8_WAIT_L(0); PG8_MMA(0, 0, At, B0); PG8_BAR; PG8_SCHED;
            PG8_LDB(B1, 0, 1); PG8_STAGE(PG8_SB(0, 0), b2, voffB);
            PG8_BAR; PG8_WAIT_L(0); PG8_MMA(0, 1, At, B1); PG8_BAR;
            PG8_LDA(At, 0, 1); PG8_STAGE(PG8_SA(0, 0), a2, voffA);
            PG8_BAR; PG8_WAIT_L(0); PG8_MMA(1, 0, At, B0); PG8_BAR; PG8_SCHED;
            PG8_STAGE(PG8_SB(0, 1), b2 + hstep, voffB);
            PG8_WAIT_V(6); PG8_BAR; PG8_MMA(1, 1, At, B1); PG8_BAR;
            PG8_LDB(B0, 1, 0); PG8_SCHED; PG8_LDA(At, 1, 0); PG8_STAGE(PG8_SA(0, 1), a2 + hstep, voffA);
            PG8_WAIT_L(8); PG8_BAR; PG8_WAIT_L(0); PG8_MMA(0, 0, At, B0); PG8_BAR; PG8_SCHED;
            PG8_LDB(B1, 1, 1); PG8_STAGE(PG8_SB(1, 0), b3, voffB);
            PG8_BAR; PG8_WAIT_L(0); PG8_MMA(0, 1, At, B1); PG8_BAR;
            PG8_LDA(At, 1, 1); PG8_STAGE(PG8_SA(1, 0), a3, voffA);
            PG8_BAR; PG8_WAIT_L(0); PG8_MMA(1, 0, At, B0); PG8_BAR; PG8_SCHED;
            PG8_STAGE(PG8_SB(1, 1), b3 + hstep, voffB);
            PG8_WAIT_V(6); PG8_BAR; PG8_MMA(1, 1, At, B1); PG8_BAR;
            }
        }
        if constexpr (ALIGN_EPI) { if (wr == 0) PG8_BAR; }
        if constexpr (!Epi::AFTER_DRAIN) { E(acc, cur, wr, wc, fr, fq); S.done(cur); }
        if (!has_next) break;
#pragma unroll
        for (int a = 0; a < 2; ++a)
#pragma unroll
            for (int b = 0; b < 2; ++b)
#pragma unroll
                for (int m = 0; m < 4; ++m)
#pragma unroll
                    for (int n = 0; n < 2; ++n) acc[a][b][m][n] = (f32x4){0.f, 0.f, 0.f, 0.f};
        cur = nxt; cA = nA; cB = nB; ++ui;
        if constexpr (ALIGN_EPI) { if (wr == 1) PG8_BAR; }
    }
    PG8_WAIT_V(0);
    if constexpr (!ALIGN_EPI) { if (wr == 0) PG8_BAR; }
    PG8_BAR;
    if constexpr (Epi::AFTER_DRAIN) { E.fused(acc, cur, wr, wc, fr, fq, lds, wid, lane); S.done(cur); }
#undef PG8_SA
#undef PG8_SB
#undef PG8_STAGE
#undef PG8_LDA
#undef PG8_LDB
#undef PG8_MMA
#undef PG8_WAIT_V
#undef PG8_WAIT_L
#undef PG8_BAR
#undef PG8_SCHED
}
}

#ifndef PG8_SP2
#define PG8_SP2 true
#endif
#ifndef PG8_ALIGN
#define PG8_ALIGN true
#endif

typedef unsigned short bf16_t;
typedef float f32x4 __attribute__((ext_vector_type(4)));
typedef unsigned u32x4 __attribute__((ext_vector_type(4)));
#define LAS __attribute__((address_space(3)))

#define T_ 8192
#define M_ 16384
#define D_ 1024
#define INW 3218
#define NPROJ 3328
#define DFF 2816
#define EPS 1e-6f
#define NTHR 512

struct Cx { int tid, bid, G, wv; };
__device__ __forceinline__ int lane_id() { int l; asm volatile("v_mbcnt_lo_u32_b32 %0, -1, 0\n\tv_mbcnt_hi_u32_b32 %0, -1, %0" : "=v"(l)); return l; }
__device__ __forceinline__ void hand_publish(unsigned* cnt) { asm volatile("s_waitcnt vmcnt(0)" ::: "memory"); __hip_atomic_fetch_add(cnt, 1u, __ATOMIC_RELAXED, __HIP_MEMORY_SCOPE_AGENT); }
__device__ __forceinline__ void hand_wait(unsigned* cnt, unsigned need) { unsigned sp = 0; while (__hip_atomic_load(cnt, __ATOMIC_RELAXED, __HIP_MEMORY_SCOPE_AGENT) < need) { __builtin_amdgcn_s_sleep(4); if (++sp > (1u << 22)) break; }
  asm volatile("" ::: "memory"); }
struct P {
  const float *x, *attn_norm, *w_in, *w_out, *q_gain, *k_gain, *cmp_pe, *cmp_w1, *cmp_w2, *gm_ws, *gm_b, *ffn_norm, *w_gu, *w_down, *rel_bias;
  float* out; unsigned char* ws;
};

constexpr size_t MiB = 1u << 20;
constexpr size_t OFF_HB = 0;
constexpr size_t OFF_ACT = 0;
constexpr size_t OFF_MIX = 100 * MiB;
constexpr size_t OFF_GATES = 132 * MiB;
constexpr size_t OFF_KC = 134 * MiB;
constexpr size_t OFF_VC = 134 * MiB + 512 * 1024;
constexpr size_t OFF_RS = 135 * MiB;
constexpr size_t OFF_ROPE = 148 * MiB;
constexpr size_t OFF_WIN = 152 * MiB;
constexpr size_t OFF_WO = 165 * MiB;
constexpr size_t OFF_WGU = 169 * MiB;
constexpr size_t OFF_WD = 191 * MiB;
constexpr size_t OFF_XB = 204 * MiB;
constexpr size_t OFF_SSQ = 236 * MiB;
constexpr size_t OFF_SELQ = 237 * MiB;
constexpr size_t OFF_CTR = 238 * MiB;
constexpr size_t OFF_BAR = 238 * MiB + 65536;
constexpr size_t OFF_RT = 239 * MiB;
constexpr size_t OFF_W1T = 245 * MiB;
constexpr size_t OFF_C1 = 246 * MiB;
constexpr size_t OFF_WSB = 246 * MiB + 65536;
constexpr size_t OFF_W2F = 247 * MiB + 65536;
constexpr size_t OFF_BTAB = 247 * MiB;

constexpr int LDS_BYTES = 147456;

__device__ __forceinline__ float bf2f(bf16_t v) { return __uint_as_float(((unsigned)v) << 16); }
__device__ __forceinline__ bf16_t f2bf(float f) { unsigned u = __float_as_uint(f); u += 0x7fffu + ((u >> 16) & 1u); return (bf16_t)(u >> 16); }
__device__ __forceinline__ unsigned pk2(float lo, float hi) { unsigned r; asm("v_cvt_pk_bf16_f32 %0, %1, %2" : "=v"(r) : "v"(lo), "v"(hi)); return r; }
__device__ __forceinline__ float gelu_tanh(float x) { const float y = -2.3022082f * (x + 0.044715f * x * x * x); return x * __builtin_amdgcn_rcpf(1.f + __builtin_amdgcn_exp2f(y)); }
__device__ __forceinline__ float sigmoidf(float x) { return __builtin_amdgcn_rcpf(1.f + __builtin_amdgcn_exp2f(-1.4426950408889634f * x)); }
#define rsqrtf(x) __builtin_amdgcn_rsqf(x)
__device__ __forceinline__ float wave_sum(float v) {
#pragma unroll
  for (int o = 1; o < 64; o <<= 1) v += __shfl_xor(v, o);
  return v;
}
__device__ __forceinline__ float wave_max(float v) {
#pragma unroll
  for (int o = 1; o < 64; o <<= 1) v = fmaxf(v, __shfl_xor(v, o));
  return v;
}
__device__ __forceinline__ int t5_bucket(int n) {
  if (n < 16) return n;
  int b = 16;
  b += (n >= 19); b += (n >= 21); b += (n >= 24); b += (n >= 27); b += (n >= 31); b += (n >= 35); b += (n >= 40); b += (n >= 46);
  b += (n >= 52); b += (n >= 59); b += (n >= 67); b += (n >= 77); b += (n >= 87); b += (n >= 99); b += (n >= 113);
  return b;
}
#define WSYNC() do { __builtin_amdgcn_fence(__ATOMIC_RELEASE, "wavefront"); __builtin_amdgcn_wave_barrier(); __builtin_amdgcn_fence(__ATOMIC_ACQUIRE, "wavefront"); } while (0)

__device__ __forceinline__ int proj_col0(int g) { return (g < 42) ? 64 * g : 2706 + 64 * (g - 42); }
__device__ __forceinline__ float row_rstd(const float* ssq, int row, int fq) {
  const f32x4 s = *(const f32x4*)(ssq + (size_t)row * 16 + 4 * fq);
  float t = (s[0] + s[1]) + (s[2] + s[3]);
  t += __shfl_xor(t, 16); t += __shfl_xor(t, 32);
  return rsqrtf(t * (1.f / D_) + EPS);
}
struct EpiProj {
  static constexpr bool PERM = true, AFTER_DRAIN = false;
  const float* ssq; bf16_t* HB; float* gates; const float2* rope; const float* q_gain; const float* k_gain;
  __device__ __forceinline__ void operator()(const f32x4 (&acc)[2][2][4][2], const pg8::Unit& u, int wr, int wc, int fr, int fq) const {
    const int gidx = u.pn * 4 + wc;
    if (gidx > 50) return;
    int type; float sc = 1.f; const float* gn = nullptr;
    float dec_l2 = 0.f;
    if (gidx < 12) { type = 0; sc = (gidx >= 6) ? 0.125f : 1.f; const float lg2 = log2f(1.f - exp2f(-5.f - (float)(gidx % 6))); dec_l2 = (gidx >= 6) ? -lg2 : lg2; }
    else if (gidx < 24) type = 1;
    else if (gidx < 30) { type = 2; gn = q_gain; sc = 0.125f * 1.4426950408889634f; }
    else if (gidx == 34 || gidx == 35) { type = 2; gn = k_gain + 64; }
    else if (gidx == 38 || gidx == 39) { type = 2; gn = k_gain + 128; }
    else if (gidx < 42) type = 1;
    else if (gidx < 46) type = 3;
    else if (gidx < 50) type = 4;
    else type = 5;
    float gv[2][8];
#pragma unroll
    for (int bj = 0; bj < 2; ++bj)
#pragma unroll
      for (int i = 0; i < 8; ++i) gv[bj][i] = (type == 2) ? gn[32 * bj + 8 * fq + i] * sc : 1.f;
#pragma unroll
    for (int ai = 0; ai < 2; ++ai)
#pragma unroll
      for (int m = 0; m < 4; ++m) {
        const int row = u.pm * 256 + ai * 128 + wr * 64 + m * 16 + fr;
        const float rstd = row_rstd(ssq, row, fq);
        float v[2][8];
#pragma unroll
        for (int bj = 0; bj < 2; ++bj)
#pragma unroll
          for (int n = 0; n < 2; ++n)
#pragma unroll
            for (int e = 0; e < 4; ++e) v[bj][4 * n + e] = acc[ai][bj][m][n][e] * rstd;
        if (type == 0) {
          const float2* tb = rope + (size_t)(row & (T_ - 1)) * 32 + 8 * fq;
          const float scr = sc * exp2f((float)(row & 127) * dec_l2);
#pragma unroll
          for (int i = 0; i < 8; ++i) { const float2 cs = tb[i]; const float x1 = v[0][i], x2 = v[1][i]; v[0][i] = (x1 * cs.x - x2 * cs.y) * scr; v[1][i] = (x2 * cs.x + x1 * cs.y) * scr; }
        }
        if (type == 3 || type == 4) {
#pragma unroll
          for (int bj = 0; bj < 2; ++bj)
#pragma unroll
            for (int i = 0; i < 8; ++i) v[bj][i] = gelu_tanh(v[bj][i]);
        }
        if (type == 2 || type == 4) {
          float ss = 0.f;
#pragma unroll
          for (int bj = 0; bj < 2; ++bj)
#pragma unroll
            for (int i = 0; i < 8; ++i) ss += v[bj][i] * v[bj][i];
          ss += __shfl_xor(ss, 16); ss += __shfl_xor(ss, 32);
          const float rs = rsqrtf(ss * (1.f / 64.f) + EPS);
#pragma unroll
          for (int bj = 0; bj < 2; ++bj)
#pragma unroll
            for (int i = 0; i < 8; ++i) v[bj][i] = v[bj][i] * rs * gv[bj][i];
        }
        if (type == 5) {
          float* gp = gates + (size_t)row * 24 + 8 * fq;
#pragma unroll
          for (int i = 0; i < 8; ++i) if (8 * fq + i < 18) gp[i] = sigmoidf(v[0][i]);
        } else {
          bf16_t* dst = HB + ((size_t)gidx * M_ + row) * 64 + 8 * fq;
#pragma unroll
          for (int bj = 0; bj < 2; ++bj) { u32x4 w; w.x = pk2(v[bj][0], v[bj][1]); w.y = pk2(v[bj][2], v[bj][3]); w.z = pk2(v[bj][4], v[bj][5]); w.w = pk2(v[bj][6], v[bj][7]); *(u32x4*)(dst + 32 * bj) = w; }
        }
      }
  }
};
struct EpiRes {
  static constexpr bool PERM = true, AFTER_DRAIN = false;
  const float* xin32; float* xout32; bf16_t* xb; float* ssq;
  __device__ __forceinline__ void operator()(const f32x4 (&acc)[2][2][4][2], const pg8::Unit& u, int wr, int wc, int fr, int fq) const {
#pragma unroll
    for (int ai = 0; ai < 2; ++ai)
#pragma unroll
      for (int m = 0; m < 4; ++m) {
        const int row = u.pm * 256 + ai * 128 + wr * 64 + m * 16 + fr;
        float ss = 0.f;
#pragma unroll
        for (int bj = 0; bj < 2; ++bj) {
          const size_t o = (size_t)row * D_ + u.pn * 256 + bj * 128 + wc * 32 + 8 * fq;
          f32x4 x0, x1;
          if (xin32) { x0 = *(const f32x4*)(xin32 + o); x1 = *(const f32x4*)(xin32 + o + 4); }
          else { const u32x4 w = *(const u32x4*)(xb + o); x0 = (f32x4){__uint_as_float(w.x << 16), __uint_as_float(w.x & 0xffff0000u), __uint_as_float(w.y << 16), __uint_as_float(w.y & 0xffff0000u)};
                 x1 = (f32x4){__uint_as_float(w.z << 16), __uint_as_float(w.z & 0xffff0000u), __uint_as_float(w.w << 16), __uint_as_float(w.w & 0xffff0000u)}; }
          const f32x4 y0 = x0 + acc[ai][bj][m][0], y1 = x1 + acc[ai][bj][m][1];
          if (xout32) { *(f32x4*)(xout32 + o) = y0; *(f32x4*)(xout32 + o + 4) = y1; }
          else { u32x4 w; w.x = pk2(y0[0], y0[1]); w.y = pk2(y0[2], y0[3]); w.z = pk2(y1[0], y1[1]); w.w = pk2(y1[2], y1[3]); *(u32x4*)(xb + o) = w;
            ss += (y0[0] * y0[0] + y0[1] * y0[1]) + (y0[2] * y0[2] + y0[3] * y0[3]) + (y1[0] * y1[0] + y1[1] * y1[1]) + (y1[2] * y1[2] + y1[3] * y1[3]); }
        }
        if (!xout32) { ss += __shfl_xor(ss, 16); ss += __shfl_xor(ss, 32);
          if (fq == 0) ssq[(size_t)row * 16 + u.pn * 4 + wc] = ss; }
      }
  }
};
struct EpiGU {
  static constexpr bool PERM = true, AFTER_DRAIN = false;
  const float* ssq; bf16_t* act;
  __device__ __forceinline__ void operator()(const f32x4 (&acc)[2][2][4][2], const pg8::Unit& u, int wr, int wc, int fr, int fq) const {
#pragma unroll
    for (int ai = 0; ai < 2; ++ai)
#pragma unroll
      for (int m = 0; m < 4; ++m) {
        const int row = u.pm * 256 + ai * 128 + wr * 64 + m * 16 + fr;
        const float rstd = row_rstd(ssq, row, fq);
        float a[8];
#pragma unroll
        for (int n = 0; n < 2; ++n)
#pragma unroll
          for (int e = 0; e < 4; ++e) { const float g = acc[ai][0][m][n][e] * rstd, up = acc[ai][1][m][n][e] * rstd; a[4 * n + e] = g * sigmoidf(g) * up; }
        u32x4 w; w.x = pk2(a[0], a[1]); w.y = pk2(a[2], a[3]); w.z = pk2(a[4], a[5]); w.w = pk2(a[6], a[7]);
        *(u32x4*)(act + (size_t)row * DFF + u.pn * 128 + wc * 32 + 8 * fq) = w;
      }
  }
};

__device__ __forceinline__ void transpose_item(const float* W, int K, int ldw, const float* gain, bf16_t* WT, int v0, int src0, int nvalid, int k0, LAS float* scr, int lane) {
  const int col = lane & 31;
  float wv[32];
#pragma unroll
  for (int i = 0; i < 32; ++i) { const int kk = 2 * i + (lane >> 5); wv[i] = (col < nvalid) ? W[(size_t)(k0 + kk) * ldw + src0 + col] : 0.f; }
#pragma unroll
  for (int i = 0; i < 32; ++i) { const int kk = 2 * i + (lane >> 5); scr[kk * 33 + col] = gain ? wv[i] * gain[k0 + kk] : wv[i]; }
  asm volatile("s_waitcnt lgkmcnt(0)" ::: "memory");
  const int c = lane & 7;
#pragma unroll
  for (int j = 0; j < 4; ++j) { const int n = (lane >> 3) + 8 * j; const LAS float* s = scr + (8 * c) * 33 + n;
    u32x4 o; o.x = pk2(s[0 * 33], s[1 * 33]); o.y = pk2(s[2 * 33], s[3 * 33]); o.z = pk2(s[4 * 33], s[5 * 33]); o.w = pk2(s[6 * 33], s[7 * 33]);
    *(u32x4*)(WT + (size_t)(v0 + n) * K + k0 + 8 * c) = o; }
  asm volatile("s_waitcnt lgkmcnt(0)" ::: "memory");
}
__device__ __forceinline__ void convert_weights(const P& p, LAS unsigned char* lds, int wave, int lane, int gw, int NGW, int it0, int it1) {
  LAS float* scr = (LAS float*)(lds + wave * 16384);
  for (int it = it0 + gw; it < it1; it += NGW) {
    const int layer = it / 6400; int r = it % 6400;
    if (r < 1664) {
      const int vb = r >> 4, kb = r & 15, v0 = vb * 32, pn = v0 >> 8, bj = (v0 >> 7) & 1, wc = (v0 >> 5) & 3, g = pn * 4 + wc;
      int src0 = 0, nvalid = 32;
      if (g < 50) src0 = proj_col0(g) + 32 * bj; else if (g == 50 && bj == 0) { src0 = 2688; nvalid = 18; } else nvalid = 0;
      transpose_item(p.w_in + (size_t)layer * D_ * INW, D_, INW, p.attn_norm + layer * D_, (bf16_t*)(p.ws + OFF_WIN) + (size_t)layer * NPROJ * D_, v0, src0, nvalid, kb * 64, scr, lane);
      continue;
    }
    r -= 1664;
    if (r < 512) { const int vb = r >> 4, kb = r & 15;
      transpose_item(p.w_out + (size_t)layer * D_ * D_, D_, D_, nullptr, (bf16_t*)(p.ws + OFF_WO) + (size_t)layer * D_ * D_, vb * 32, vb * 32, 32, kb * 64, scr, lane); continue; }
    r -= 512;
    if (r < 2816) { const int vb = r >> 4, kb = r & 15, v0 = vb * 32, pn = v0 >> 8, bj = (v0 >> 7) & 1, c0 = v0 & 127;
      transpose_item(p.w_gu + (size_t)layer * D_ * 2 * DFF, D_, 2 * DFF, p.ffn_norm + layer * D_, (bf16_t*)(p.ws + OFF_WGU) + (size_t)layer * 2 * DFF * D_, v0, bj * DFF + 128 * pn + c0, 32, kb * 64, scr, lane); continue; }
    r -= 2816;
    { const int vb = r / 44, kb = r % 44;
      transpose_item(p.w_down + (size_t)layer * DFF * D_, DFF, D_, nullptr, (bf16_t*)(p.ws + OFF_WD) + (size_t)layer * D_ * DFF, vb * 32, vb * 32, 32, kb * 64, scr, lane); }
  }
}
__device__ __forceinline__ void ph_prologue(const Cx& cx, const P& p, LAS unsigned char* lds) {
  const int tid = cx.tid, lane = tid & 63, wave = tid >> 6;
  LAS float* scr = (LAS float*)(lds + wave * 16384);
  const int gw = cx.bid * 8 + wave, NGW = cx.G * 8;
  convert_weights(p, lds, wave, lane, gw, NGW, 0, 1664);
  bf16_t* XB = (bf16_t*)(p.ws + OFF_XB); float* ssq = (float*)(p.ws + OFF_SSQ);
  for (int r = gw; r < M_; r += 2 * NGW) {
    const int r2 = r + NGW;
    const f32x4* xa = (const f32x4*)(p.x + (size_t)r * D_); const f32x4* xb2 = (const f32x4*)(p.x + (size_t)((r2 < M_) ? r2 : r) * D_);
    f32x4 va[4], vb[4];
#pragma unroll
    for (int j = 0; j < 4; ++j) { va[j] = xa[lane + 64 * j]; vb[j] = xb2[lane + 64 * j]; }
    float sa = 0.f, sb = 0.f;
#pragma unroll
    for (int j = 0; j < 4; ++j) { sa += (va[j][0] * va[j][0] + va[j][1] * va[j][1]) + (va[j][2] * va[j][2] + va[j][3] * va[j][3]); sb += (vb[j][0] * vb[j][0] + vb[j][1] * vb[j][1]) + (vb[j][2] * vb[j][2] + vb[j][3] * vb[j][3]);
      *(uint2*)(XB + (size_t)r * D_ + (lane + 64 * j) * 4) = make_uint2(pk2(va[j][0], va[j][1]), pk2(va[j][2], va[j][3]));
      if (r2 < M_) *(uint2*)(XB + (size_t)r2 * D_ + (lane + 64 * j) * 4) = make_uint2(pk2(vb[j][0], vb[j][1]), pk2(vb[j][2], vb[j][3])); }
    sa = wave_sum(sa); sb = wave_sum(sb);
    if (lane < 16) { ssq[(size_t)r * 16 + lane] = (lane == 0) ? sa : 0.f; if (r2 < M_) ssq[(size_t)r2 * 16 + lane] = (lane == 0) ? sb : 0.f; }
  }
  if (cx.bid == 0) for (int i = tid; i < 1024; i += NTHR) ((unsigned*)(p.ws + OFF_CTR))[i] = 0u;
  for (int it = gw; it < 256; it += NGW) { const int mj = it >> 6, vb = (it >> 5) & 1, kb = it & 31;
    transpose_item(p.cmp_w1 + (size_t)mj * 2048 * 64, 2048, 64, nullptr, (bf16_t*)(p.ws + OFF_W1T) + (size_t)mj * 64 * 2048, vb * 32, vb * 32, 32, kb * 64, scr, lane); }
  for (int it = gw; it < 256; it += NGW) { const int mj = it >> 6, f = it & 63; const float* w1 = p.cmp_w1 + (size_t)mj * 2048 * 64 + f; const float* pe = p.cmp_pe + (size_t)mj * 2048;
    float a = 0.f; for (int i = lane; i < 2048; i += 64) a += pe[i] * w1[(size_t)i * 64];
    a = wave_sum(a); if (lane == 0) ((float*)(p.ws + OFF_C1))[it] = a; }
  for (int i = cx.bid * NTHR + tid; i < 6 * 768; i += cx.G * NTHR) { const int hd = i / 768, k = i % 768; float v = 0.f;
    if (k < 115) v = (k == 0) ? -1e30f : p.rel_bias[t5_bucket(k - 1) * 6 + hd] * 1.4426950408889634f;
    else if (k >= 128 && k < 642) { const int kk = k - 128; v = (kk == 0 || kk == 513) ? -1e30f : p.rel_bias[t5_bucket(kk - 1) * 6 + hd] * 1.4426950408889634f; }
    ((float*)(p.ws + OFF_BTAB))[i] = v; }
  for (int i = cx.bid * NTHR + tid; i < 4 * 4096; i += cx.G * NTHR) {
    const int mj = i >> 12, jj = i & 7, ln = (i >> 3) & 63, s2 = (i >> 9) & 1, fb = (i >> 10) & 1, eb = (i >> 11) & 1, r32_ = ln & 31, hi_ = ln >> 5;
    ((bf16_t*)(p.ws + OFF_W2F))[i] = f2bf(p.cmp_w2[(size_t)mj * 4096 + (32 * fb + 16 * s2 + 8 * (jj >> 2) + 4 * hi_ + (jj & 3)) * 64 + 32 * eb + r32_]); }
  for (int i = cx.bid * NTHR + tid; i < 2 * 4 * 128 * 128; i += cx.G * NTHR) { const int tt = (i >> 7) & 127, ss = i & 127; ((bf16_t*)(p.ws + OFF_WSB))[i] = (ss <= tt) ? f2bf(p.gm_ws[i]) : (bf16_t)0; }
  float2* tab = (float2*)(p.ws + OFF_ROPE);
  for (int i = cx.bid * NTHR + tid; i < T_ * 32; i += cx.G * NTHR) {
    const int t = i >> 5, k = i & 31;
    const float inv = powf(10000.0f, -(float)k / 32.0f);
    const float ang = (float)t * inv;
    tab[i] = make_float2(cosf(ang), sinf(ang));
  }
}
namespace att {
using bf16x8 = __attribute__((ext_vector_type(8))) short;
using s16x4 = __attribute__((ext_vector_type(4))) short;
using f32x16 = __attribute__((ext_vector_type(16))) float;
constexpr int NW = 8, QBLK = 32, QB = 256, KVBLK = 64;
constexpr int SLOTB = 8192, LDS_K = 0, LDS_V = 3 * SLOTB, LDS_WS = 6 * SLOTB, LDS_OST = LDS_WS + NW * 256, LDS_TAB = LDS_OST + NW * 8192, LDS_SELW = LDS_TAB + 2304, LDS_END = LDS_SELW + NW * 512;
static_assert(LDS_END <= 131072, "attention LDS");
constexpr float NEGBIG = -1e30f;
#define SBAR() __builtin_amdgcn_sched_barrier(0)
#define PIN(x) asm volatile("" : "+v"(x))
#define MFMA(a, b, c) __builtin_amdgcn_mfma_f32_32x32x16_bf16(a, b, c, 0, 0, 0)
#define WAIT_BAR(N) asm volatile("s_waitcnt vmcnt(" #N ") lgkmcnt(0)\n\ts_barrier" ::: "memory")
__device__ __forceinline__ int crow(int r, int hi) { return (r & 3) + 8 * (r >> 2) + 4 * hi; }
__device__ __forceinline__ unsigned cvtpk(float lo, float hi) { unsigned r; asm("v_cvt_pk_bf16_f32 %0, %1, %2" : "=v"(r) : "v"(lo), "v"(hi)); return r; }
__device__ __forceinline__ void glds16(const void* g, unsigned lds_base) {
  unsigned sv; asm volatile("s_mov_b32 %0, m0\n\ts_mov_b32 m0, %2\n\ts_nop 0\n\tglobal_load_lds_dwordx4 %1, off\n\ts_mov_b32 m0, %0" : "=&s"(sv) : "v"(g), "s"(lds_base) : "memory"); }
typedef __attribute__((address_space(3))) const char* lds_cptr;
typedef short v4i16_t __attribute__((ext_vector_type(4)));
__device__ __forceinline__ void kload2(bf16x8* kf, lds_cptr kp, int d0) { kf[2 * d0] = *(const __attribute__((address_space(3))) bf16x8*)(kp + d0 * 2048); kf[2 * d0 + 1] = *(const __attribute__((address_space(3))) bf16x8*)(kp + d0 * 2048 + 512); }
__device__ __forceinline__ s16x4 vtr(lds_cptr p) { return __builtin_bit_cast(s16x4, __builtin_amdgcn_ds_read_tr16_b64_v4i16((__attribute__((address_space(3))) v4i16_t*)p)); }
#define MX3(a, b, c) __builtin_fmaxf(__builtin_fmaxf((a), (b)), (c))
__device__ __forceinline__ float rowmax(const f32x16& p0, const f32x16& p1) {
  float a = MX3(p0[0], p0[1], p1[0]), b = MX3(p0[2], p0[3], p1[1]); a = MX3(a, p1[2], p1[3]);
#pragma unroll
  for (int r = 4; r < 16; r += 4) { a = MX3(a, p0[r], p0[r + 1]); b = MX3(b, p0[r + 2], p0[r + 3]); a = MX3(a, p1[r], p1[r + 1]); b = MX3(b, p1[r + 2], p1[r + 3]); }
  float m = __builtin_fmaxf(a, b); auto rr = __builtin_amdgcn_permlane32_swap(__float_as_uint(m), __float_as_uint(m), false, false);
  return __builtin_fmaxf(__uint_as_float(rr[0]), __uint_as_float(rr[1])); }
template <int S, int IMAX>
__device__ __forceinline__ void bias_hook(f32x16& p0, f32x16& p1, int dl, const __attribute__((address_space(3))) float* tab) {
#pragma unroll
  for (int r = 0; r < 16; ++r) { const int c = (r & 3) + 8 * (r >> 2); const int d0 = dl - S * c, d1 = d0 - 32 * S;
    p0[r] += tab[1 + min(max(d0, -1), IMAX)]; p1[r] += tab[1 + min(max(d1, -1), IMAX)]; } }

template <int MODE>
__device__ __forceinline__ void nsa_pass(const int tid, const bf16_t* Qrows, const bf16_t* __restrict__ Kt0, const bf16_t* __restrict__ Vt0, const int NT, const int dq, const float b31,
                                         const float* gate, char* lds, const bool first, const bool preK = false, const bf16_t* __restrict__ nextK = nullptr) {
  constexpr int S = (MODE == 2) ? 16 : 1, IMAX = (MODE == 1) ? 512 : 113; constexpr float REF = 8.f;
  const int lane = tid & 63, r32 = lane & 31, hi = lane >> 5; const int wid = __builtin_amdgcn_readfirstlane(tid >> 6);
  const bf16_t* Qw = Qrows + (size_t)(wid * QBLK) * 64;
  const unsigned lds0 = (unsigned)(uintptr_t)lds; float* wsf = (float*)(lds + LDS_WS) + wid * 64;
  const __attribute__((address_space(3))) float* tab = (const __attribute__((address_space(3))) float*)(uintptr_t)(lds0 + LDS_TAB);
  const __attribute__((address_space(3))) unsigned* selw = (const __attribute__((address_space(3))) unsigned*)(uintptr_t)(lds0 + LDS_SELW + wid * 512);
  const bf16_t* ksrc = Kt0 + (size_t)lane * 64 + wid * 8;
  const bf16_t* vsrc = Vt0 + (size_t)(16 * (wid & 3) + (lane >> 2)) * 64 + (wid >> 2) * 32 + (lane & 3) * 8;
  const unsigned kdst = lds0 + LDS_K + wid * 1024, vdst = lds0 + LDS_V + wid * 1024;
#define DMA_K(t, slot) glds16(ksrc + (size_t)(t) * KVBLK * 64, (unsigned)__builtin_amdgcn_readfirstlane(kdst + (slot)))
#define DMA_V(t, slot) glds16(vsrc + (size_t)(t) * KVBLK * 64, (unsigned)__builtin_amdgcn_readfirstlane(vdst + (slot)))
  const lds_cptr vp0 = (lds_cptr)(uintptr_t)lds0 + LDS_V + ((lane >> 4) & 1) * 32 + (lane & 3) * 8 + (4 * hi + ((lane & 15) >> 2)) * 64;
  const lds_cptr kp0 = (lds_cptr)(uintptr_t)lds0 + LDS_K + hi * 1024 + r32 * 16;
  if (!preK) { DMA_K(0, 0); DMA_V(0, 0); DMA_K(1, SLOTB); } else { DMA_V(0, 0); }
  bf16x8 qr[4];
#pragma unroll
  for (int d0 = 0; d0 < 4; ++d0) qr[d0] = *reinterpret_cast<const bf16x8*>(&Qw[(size_t)r32 * 64 + d0 * 16 + hi * 8]);
  float l_reg = 0.f; f32x16 o[2]; o[0] = f32x16{}; o[1] = f32x16{};
  f32x16 zero16 = f32x16{}; PIN(zero16);
  const int qrel = wid * QBLK + r32;
  const int dlq = dq + qrel - S * 4 * hi;
  f32x16 pA0, pA1, pB0, pB1; bf16x8 kf[8]; s16x4 vlo[8], vhi[8]; u32x4 pw0, pw1, pw2, pw3;
  int sl_prev = 0, sl_cur = 0, sl_next = SLOTB;
#define ROT() do { sl_prev = sl_cur; sl_cur = sl_next; sl_next = (sl_next == 2 * SLOTB) ? 0 : sl_next + SLOTB; } while (0)
#define EX(v) __builtin_amdgcn_exp2f((v) + nmh)
#define SELBIT(t) ((MODE == 0) ? (((selw[(t)] >> r32) & 1u) != 0u) : true)
  if (!preK) { DMA_K(2, 2 * SLOTB); WAIT_BAR(3); } else { WAIT_BAR(1); }
  _Pragma("unroll") for (int d0 = 0; d0 < 4; ++d0) kload2(kf, kp0, d0);
  pA0 = MFMA(kf[0], qr[0], zero16); pA1 = MFMA(kf[1], qr[0], zero16); pA0 = MFMA(kf[2], qr[1], pA0); pA1 = MFMA(kf[3], qr[1], pA1);
  pA0 = MFMA(kf[4], qr[2], pA0); pA1 = MFMA(kf[5], qr[2], pA1); pA0 = MFMA(kf[6], qr[3], pA0); pA1 = MFMA(kf[7], qr[3], pA1);
  { const bool band0 = (MODE != 0) || (NT < 8);
    if (band0) bias_hook<S, IMAX>(pA0, pA1, dlq, tab);
    const float bc = band0 ? 0.f : b31; const bool sb = SELBIT(0);
    const float nmh = sb ? bc - REF : NEGBIG;
#pragma unroll
    for (int r = 0; r < 16; ++r) { pA0[r] = EX(pA0[r]); pA1[r] = EX(pA1[r]); } }
  WAIT_BAR(0);
  DMA_K(3, 0); DMA_V(1, SLOTB); ROT();
  _Pragma("unroll") for (int d0 = 0; d0 < 4; ++d0) kload2(kf, kp0 + sl_cur, d0);
  WAIT_BAR(2);
#define PKW(P, i) cvtpk(P[i], P[i + 1])
#define PAF(k) __builtin_bit_cast(bf16x8, pw##k)
#define VFR(i) (bf16x8){vlo[i][0], vlo[i][1], vlo[i][2], vlo[i][3], vhi[i][0], vhi[i][1], vhi[i][2], vhi[i][3]}
#define VRD(i) do { vlo[i] = vtr(vp_ + (((i) >> 2) * 4096 + ((i) & 3) * 1024)); vhi[i] = vtr(vp_ + (((i) >> 2) * 4096 + ((i) & 3) * 1024 + 512)); } while (0)
#define KRD(G, d0) do { if (G) { kload2(kf, kp0 + sl_next, d0); SBAR(); } } while (0)
#define GAPA(MF, a0, a1, a2, a3, W0, W1, PW) do { MF; sacc += a0; sacc += a1; sacc += a2; sacc += a3; W0; W1; PIN(PW); PIN(sacc); SBAR(); } while (0)
#define GAPB(MF, X, i) do { MF; X[i] = EX(X[i]); X[i + 1] = EX(X[i + 1]); X[i + 2] = EX(X[i + 2]); X[i + 3] = EX(X[i + 3]); PIN(X); SBAR(); } while (0)
#define STEP(C0, C1, P0, P1, t, MASK, GK, GV, GL) do { SBAR(); \
    const lds_cptr vp_ = vp0 + sl_prev; \
    VRD(0); SBAR(); float sacc = P0[0] + P0[1]; \
                    GAPA(C0 = MFMA(kf[0], qr[0], zero16), P0[2], P0[3], P0[4], P0[5],     pw0[0] = PKW(P0, 0),  pw0[1] = PKW(P0, 2),  pw0); \
    VRD(4); SBAR(); GAPA(C1 = MFMA(kf[1], qr[0], zero16), P0[6], P0[7], P0[8], P0[9],     pw0[2] = PKW(P0, 4),  pw0[3] = PKW(P0, 6),  pw0); \
    VRD(1); SBAR(); GAPA(C0 = MFMA(kf[2], qr[1], C0),    P0[10], P0[11], P0[12], P0[13], pw1[0] = PKW(P0, 8),  pw1[1] = PKW(P0, 10), pw1); \
    VRD(5); SBAR(); GAPA(C1 = MFMA(kf[3], qr[1], C1),    P0[14], P0[15], P1[0], P1[1],   pw1[2] = PKW(P0, 12), pw1[3] = PKW(P0, 14), pw1); \
    VRD(2); SBAR(); GAPA(C0 = MFMA(kf[4], qr[2], C0),    P1[2], P1[3], P1[4], P1[5],     pw2[0] = PKW(P1, 0),  pw2[1] = PKW(P1, 2),  pw2); \
    VRD(6); SBAR(); GAPA(C1 = MFMA(kf[5], qr[2], C1),    P1[6], P1[7], P1[8], P1[9],     pw2[2] = PKW(P1, 4),  pw2[3] = PKW(P1, 6),  pw2); \
    VRD(3); SBAR(); GAPA(C0 = MFMA(kf[6], qr[3], C0),    P1[10], P1[11], P1[12], P1[13], pw3[0] = PKW(P1, 8),  pw3[1] = PKW(P1, 10), pw3); \
    VRD(7); SBAR(); GAPA(C1 = MFMA(kf[7], qr[3], C1),    P1[14], P1[15], 0.f, 0.f,       pw3[2] = PKW(P1, 12), pw3[3] = PKW(P1, 14), pw3); \
    l_reg += sacc; \
    if (GK) DMA_K((t) + 3, sl_cur); if (GV) DMA_V((t) + 1, sl_next); \
    if (MASK) bias_hook<S, IMAX>(C0, C1, dlq - S * 64 * (t), tab); \
    const float bc_ = (MASK) ? 0.f : b31; const bool sb_ = SELBIT(t); \
    const float nmh = sb_ ? bc_ - REF : NEGBIG; SBAR(); \
    GAPB(o[0] = MFMA(PAF(0), VFR(0), o[0]), C0, 0);              GAPB(o[1] = MFMA(PAF(0), VFR(4), o[1]), C0, 4); \
    KRD(GL, 0); GAPB(o[0] = MFMA(PAF(1), VFR(1), o[0]), C0, 8);  KRD(GL, 1); GAPB(o[1] = MFMA(PAF(1), VFR(5), o[1]), C0, 12); \
    KRD(GL, 2); GAPB(o[0] = MFMA(PAF(2), VFR(2), o[0]), C1, 0);  KRD(GL, 3); GAPB(o[1] = MFMA(PAF(2), VFR(6), o[1]), C1, 4); \
    GAPB(o[0] = MFMA(PAF(3), VFR(3), o[0]), C1, 8);              GAPB(o[1] = MFMA(PAF(3), VFR(7), o[1]), C1, 12); \
    } while (0)
  int t = 1;
  if (MODE == 0) {
    for (; t + 7 < NT; t += 2) {
      STEP(pB0, pB1, pA0, pA1, t, false, true, true, true);     WAIT_BAR(2); ROT();
      STEP(pA0, pA1, pB0, pB1, t + 1, false, true, true, true); WAIT_BAR(2); ROT();
    }
  }
#define ENDW(tt) do { if ((tt) + 3 < NT) { WAIT_BAR(2); } else if ((tt) + 2 < NT) { WAIT_BAR(1); } else { WAIT_BAR(0); } } while (0)
  for (; t + 1 < NT; t += 2) {
    STEP(pB0, pB1, pA0, pA1, t, true, (t + 3 < NT), (t + 1 < NT), (t + 1 < NT));         ENDW(t);     ROT();
    STEP(pA0, pA1, pB0, pB1, t + 1, true, (t + 4 < NT), (t + 2 < NT), (t + 2 < NT));     ENDW(t + 1); ROT();
  }
  if (nextK) { const bf16_t* nk = nextK + (size_t)lane * 64 + wid * 8;
    glds16(nk, (unsigned)__builtin_amdgcn_readfirstlane(kdst)); glds16(nk + 4096, (unsigned)__builtin_amdgcn_readfirstlane(kdst + SLOTB)); glds16(nk + 8192, (unsigned)__builtin_amdgcn_readfirstlane(kdst + 2 * SLOTB)); }
  STEP(pB0, pB1, pA0, pA1, NT - 1, true, false, false, false);
  { float sacc = pB0[0] + pB0[1];
#pragma unroll
    for (int r = 2; r < 16; ++r) sacc += pB0[r];
#pragma unroll
    for (int r = 0; r < 16; ++r) sacc += pB1[r];
    l_reg += sacc;
    pw0 = (u32x4){PKW(pB0, 0), PKW(pB0, 2), PKW(pB0, 4), PKW(pB0, 6)}; pw1 = (u32x4){PKW(pB0, 8), PKW(pB0, 10), PKW(pB0, 12), PKW(pB0, 14)};
    pw2 = (u32x4){PKW(pB1, 0), PKW(pB1, 2), PKW(pB1, 4), PKW(pB1, 6)}; pw3 = (u32x4){PKW(pB1, 8), PKW(pB1, 10), PKW(pB1, 12), PKW(pB1, 14)};
    const lds_cptr vp_ = vp0 + sl_cur; _Pragma("unroll") for (int i = 0; i < 8; ++i) VRD(i);
    o[0] = MFMA(PAF(0), VFR(0), o[0]); o[1] = MFMA(PAF(0), VFR(4), o[1]); o[0] = MFMA(PAF(1), VFR(1), o[0]); o[1] = MFMA(PAF(1), VFR(5), o[1]);
    o[0] = MFMA(PAF(2), VFR(2), o[0]); o[1] = MFMA(PAF(2), VFR(6), o[1]); o[0] = MFMA(PAF(3), VFR(3), o[0]); o[1] = MFMA(PAF(3), VFR(7), o[1]); }
  { auto rr = __builtin_amdgcn_permlane32_swap(__float_as_uint(l_reg), __float_as_uint(l_reg), false, false); l_reg = __uint_as_float(rr[0]) + __uint_as_float(rr[1]); }
  if (hi == 0) wsf[32 + r32] = (l_reg > 0.f) ? gate[(size_t)qrel * 24] / l_reg : 0.f;
  asm volatile("s_waitcnt lgkmcnt(0)" ::: "memory");
  float rli[16];
#pragma unroll
  for (int r = 0; r < 16; ++r) rli[r] = wsf[32 + crow(r, hi)];
  float* stg = (float*)(lds + LDS_OST) + wid * 2048;
  if (first) {
#pragma unroll
    for (int r = 0; r < 16; ++r) { const int orow = crow(r, hi);
#pragma unroll
      for (int d0 = 0; d0 < 2; ++d0) stg[orow * 64 + d0 * 32 + r32] = o[d0][r] * rli[r]; }
  } else {
#pragma unroll
    for (int r = 0; r < 16; ++r) { const int orow = crow(r, hi);
#pragma unroll
      for (int d0 = 0; d0 < 2; ++d0) stg[orow * 64 + d0 * 32 + r32] += o[d0][r] * rli[r]; }
  }
  asm volatile("s_waitcnt lgkmcnt(0)\n\ts_barrier" ::: "memory");
#undef DMA_K
#undef DMA_V
#undef ROT
#undef EX
#undef SELBIT
#undef PKW
#undef PAF
#undef VFR
#undef VRD
#undef KRD
#undef ENDW
#undef GAPA
#undef GAPB
#undef STEP
}
#undef SBAR
#undef PIN
#undef MFMA
#undef WAIT_BAR
#undef MX3
}

#define L2E 1.4426950408889634f
__device__ __forceinline__ void topk_unit(const Cx& cx, const P& p, int layer, int u, char* lds) {
  using att::bf16x8; using att::f32x16;
  const int tid = cx.tid, lane = tid & 63, r32 = lane & 31, hi = lane >> 5, wid = cx.wv, grp = wid & 3, half = wid >> 2;
  const int qb = 63 - (u >> 2), bg = u & 3, b = bg >> 1, g = bg & 1, q0 = qb * 128;
  const int ntile64 = ((((q0 + 127) >> 4) + 1) + 63) >> 6;
  if (tid == 0) hand_wait((unsigned*)(p.ws + OFF_CTR) + 512 + layer * 64 + bg * 16, 16u);
  __syncthreads();
  const bf16_t* KCb = (const bf16_t*)(p.ws + OFF_KC) + (size_t)bg * 512 * 64;
  const unsigned lds0 = (unsigned)(uintptr_t)lds;
  constexpr int L_IMP = 65536, L_LSUM = 131072 + 1024, L_TAB = 139264;
  for (int i = tid; i < ntile64 * 512; i += NTHR) { const int n = i >> 3, c = i & 7; const unsigned long long* q8 = (const unsigned long long*)(KCb + (size_t)n * 64 + c * 8);
    const unsigned long long a = __hip_atomic_load(q8, __ATOMIC_RELAXED, __HIP_MEMORY_SCOPE_AGENT), b2 = __hip_atomic_load(q8 + 1, __ATOMIC_RELAXED, __HIP_MEMORY_SCOPE_AGENT);
    *(u32x4*)(lds + (n >> 6) * 8192 + c * 1024 + (n & 63) * 16) = (u32x4){(unsigned)a, (unsigned)(a >> 32), (unsigned)b2, (unsigned)(b2 >> 32)}; }
  float* tabw = (float*)(lds + L_TAB);
  for (int i = tid; i < 3 * 115; i += NTHR) { const int h = i / 115, k = i % 115; tabw[i] = ((const float*)(p.ws + OFF_BTAB))[(g * 3 + h) * 768 + k]; }
  float* impw = (float*)(lds + L_IMP) + wid * 2048;
#pragma unroll
  for (int s2 = 0; s2 < 32; ++s2) impw[s2 * 64 + lane] = 0.f;
  __syncthreads();
  const __attribute__((address_space(3))) float* tab = (const __attribute__((address_space(3))) float*)(uintptr_t)(lds0 + L_TAB);
  const att::lds_cptr kp0 = (att::lds_cptr)(uintptr_t)lds0 + hi * 1024 + r32 * 16;
  const int tq0 = q0 + grp * 32, t = tq0 + r32, cur = tq0 >> 6;
  const int NT32 = ((tq0 >> 4) + 1 + 31) >> 5;
  const int Th = (NT32 + 1) >> 1, T0 = half ? Th : 0, T1 = half ? NT32 : Th;
  const int nfar = (tq0 - 144) >> 4;
  const int Tnear0 = (nfar >= 31) ? ((nfar - 31) >> 5) + 1 : 0;
  const bf16_t* HB = (const bf16_t*)(p.ws + OFF_HB);
  float b31[3];
#pragma unroll
  for (int h = 0; h < 3; ++h) b31[h] = p.rel_bias[31 * 6 + g * 3 + h] * L2E;
  const int dl0 = t - 31 - 64 * hi;
  f32x16 zero16 = f32x16{}; asm volatile("" : "+v"(zero16));
#define TK_SCORES(T, h, sv) do { const att::lds_cptr kp_ = kp0 + ((T) >> 1) * 8192 + ((T) & 1) * 512; \
    const bf16x8 k0_ = *(const __attribute__((address_space(3))) bf16x8*)(kp_), k1_ = *(const __attribute__((address_space(3))) bf16x8*)(kp_ + 2048), \
                 k2_ = *(const __attribute__((address_space(3))) bf16x8*)(kp_ + 4096), k3_ = *(const __attribute__((address_space(3))) bf16x8*)(kp_ + 6144); \
    sv = __builtin_amdgcn_mfma_f32_32x32x16_bf16(k0_, qr[0], zero16, 0, 0, 0); sv = __builtin_amdgcn_mfma_f32_32x32x16_bf16(k1_, qr[1], sv, 0, 0, 0); \
    sv = __builtin_amdgcn_mfma_f32_32x32x16_bf16(k2_, qr[2], sv, 0, 0, 0); sv = __builtin_amdgcn_mfma_f32_32x32x16_bf16(k3_, qr[3], sv, 0, 0, 0); \
    if ((T) >= Tnear0) { const int dl_ = dl0 - 512 * (T); _Pragma("unroll") for (int r = 0; r < 16; ++r) { const int c_ = (r & 3) + 8 * (r >> 2); sv[r] = __builtin_amdgcn_exp2f(sv[r] + tab[(h) * 115 + 1 + min(max(dl_ - 16 * c_, -1), 113)]); } } \
    else { _Pragma("unroll") for (int r = 0; r < 16; ++r) sv[r] = __builtin_amdgcn_exp2f(sv[r] + b31[h]); } } while (0)
  float U[3][32]; float l[3];
#pragma unroll
  for (int h = 0; h < 3; ++h) {
    const bf16_t* Qh = HB + ((size_t)(24 + g * 3 + h) * M_ + (size_t)b * T_ + tq0) * 64;
    bf16x8 qr[4];
#pragma unroll
    for (int d0 = 0; d0 < 4; ++d0) qr[d0] = *reinterpret_cast<const bf16x8*>(Qh + (size_t)r32 * 64 + d0 * 16 + hi * 8);
    float lh = 0.f, carry = 0.f;
    if (half == 1 && T0 < T1) { f32x16 sv; TK_SCORES(T0 - 1, h, sv); carry = __shfl_xor(sv[15], 32); }
#define TK_FINISH(tt_, sv_) do { float body[4], pt[4], a_ = 0.f; \
        _Pragma("unroll") for (int g4 = 0; g4 < 4; ++g4) { const float s3 = (sv_[4 * g4] + sv_[4 * g4 + 1]) + sv_[4 * g4 + 2]; body[g4] = 2.f * s3 + sv_[4 * g4 + 3]; a_ += s3 + sv_[4 * g4 + 3]; } \
        lh += a_; \
        _Pragma("unroll") for (int k = 0; k < 4; ++k) pt[k] = __shfl_xor(sv_[4 * k + 3], 32); \
        U[h][(tt_) * 4 + 0] = body[0] + (hi ? pt[0] : carry); U[h][(tt_) * 4 + 1] = body[1] + (hi ? pt[1] : pt[0]); \
        U[h][(tt_) * 4 + 2] = body[2] + (hi ? pt[2] : pt[1]); U[h][(tt_) * 4 + 3] = body[3] + (hi ? pt[3] : pt[2]); \
        carry = pt[3]; } while (0)
#pragma unroll
    for (int tp = 0; tp < 4; ++tp) {
      const int T = T0 + 2 * tp;
      if (T + 1 < T1 && T + 1 < Tnear0) {
        const att::lds_cptr ka_ = kp0 + (T >> 1) * 8192 + (T & 1) * 512, kb_ = kp0 + ((T + 1) >> 1) * 8192 + ((T + 1) & 1) * 512;
        f32x16 sa, sb;
        { const bf16x8 a0 = *(const __attribute__((address_space(3))) bf16x8*)(ka_), a1 = *(const __attribute__((address_space(3))) bf16x8*)(ka_ + 2048), a2 = *(const __attribute__((address_space(3))) bf16x8*)(ka_ + 4096), a3 = *(const __attribute__((address_space(3))) bf16x8*)(ka_ + 6144);
          const bf16x8 b0 = *(const __attribute__((address_space(3))) bf16x8*)(kb_), b1 = *(const __attribute__((address_space(3))) bf16x8*)(kb_ + 2048), b2 = *(const __attribute__((address_space(3))) bf16x8*)(kb_ + 4096), b3 = *(const __attribute__((address_space(3))) bf16x8*)(kb_ + 6144);
          sa = __builtin_amdgcn_mfma_f32_32x32x16_bf16(a0, qr[0], zero16, 0, 0, 0); sb = __builtin_amdgcn_mfma_f32_32x32x16_bf16(b0, qr[0], zero16, 0, 0, 0);
          sa = __builtin_amdgcn_mfma_f32_32x32x16_bf16(a1, qr[1], sa, 0, 0, 0);     sb = __builtin_amdgcn_mfma_f32_32x32x16_bf16(b1, qr[1], sb, 0, 0, 0);
          sa = __builtin_amdgcn_mfma_f32_32x32x16_bf16(a2, qr[2], sa, 0, 0, 0);     sb = __builtin_amdgcn_mfma_f32_32x32x16_bf16(b2, qr[2], sb, 0, 0, 0);
          sa = __builtin_amdgcn_mfma_f32_32x32x16_bf16(a3, qr[3], sa, 0, 0, 0);     sb = __builtin_amdgcn_mfma_f32_32x32x16_bf16(b3, qr[3], sb, 0, 0, 0); }
#pragma unroll
        for (int r = 0; r < 16; ++r) { sa[r] = __builtin_amdgcn_exp2f(sa[r] + b31[h]); sb[r] = __builtin_amdgcn_exp2f(sb[r] + b31[h]); }
        TK_FINISH(2 * tp, sa); TK_FINISH(2 * tp + 1, sb);
      } else {
        if (T < T1) { f32x16 sv; TK_SCORES(T, h, sv); TK_FINISH(2 * tp, sv); }
        else { U[h][tp * 8 + 0] = 0.f; U[h][tp * 8 + 1] = 0.f; U[h][tp * 8 + 2] = 0.f; U[h][tp * 8 + 3] = 0.f; }
        if (T + 1 < T1) { f32x16 sv; TK_SCORES(T + 1, h, sv); TK_FINISH(2 * tp + 1, sv); }
        else { U[h][tp * 8 + 4] = 0.f; U[h][tp * 8 + 5] = 0.f; U[h][tp * 8 + 6] = 0.f; U[h][tp * 8 + 7] = 0.f; }
      }
    }
#undef TK_FINISH
    l[h] = lh;
  }
  { float* ls = (float*)(lds + L_LSUM);
#pragma unroll
    for (int h = 0; h < 3; ++h) ls[((grp * 2 + half) * 3 + h) * 64 + lane] = l[h]; }
  __syncthreads();
  { const float* ls = (const float*)(lds + L_LSUM); float rl[3];
#pragma unroll
    for (int h = 0; h < 3; ++h) { float lt = ls[((grp * 2 + 0) * 3 + h) * 64 + lane] + ls[((grp * 2 + 1) * 3 + h) * 64 + lane]; lt += __shfl_xor(lt, 32); rl[h] = (lt > 0.f) ? 1.f / lt : 0.f; }
#pragma unroll
    for (int i = 0; i < 32; ++i) impw[i * 64 + lane] = (U[0][i] * rl[0] + U[1][i] * rl[1]) + U[2][i] * rl[2]; }
#undef TK_SCORES
  __syncthreads();
  {
    const int qq = 16 * half + (lane & 15), part = lane >> 4, srcw = part >> 1, shi = part & 1;
    const float* ip = (const float*)(lds + L_IMP) + (grp + 4 * srcw) * 2048 + qq + 32 * shi;
    const int tbase = srcw ? Th : 0;
    unsigned v[32];
#pragma unroll
    for (int i = 0; i < 32; ++i) { const int j = 8 * (tbase + (i >> 2)) + 2 * (i & 3) + shi; v[i] = (j >= 1 && j <= cur - 2) ? __float_as_uint(ip[i * 64]) : 0u; }
    unsigned tau = 0u;
    if (cur >= 16) {
      unsigned thr = 0x7fffffffu;
#pragma unroll 1
      for (int rnd = 0; rnd < 13; ++rnd) {
        unsigned m0 = 0u, m1 = 0u, m2 = 0u, m3 = 0u;
#pragma unroll
        for (int i = 0; i < 32; i += 4) { m0 = max(m0, (v[i] < thr) ? v[i] : 0u); m1 = max(m1, (v[i + 1] < thr) ? v[i + 1] : 0u); m2 = max(m2, (v[i + 2] < thr) ? v[i + 2] : 0u); m3 = max(m3, (v[i + 3] < thr) ? v[i + 3] : 0u); }
        unsigned m = max(max(m0, m1), max(m2, m3));
        m = max(m, (unsigned)__shfl_xor((int)m, 16)); m = max(m, (unsigned)__shfl_xor((int)m, 32));
        thr = m;
      }
      tau = thr;
    }
    unsigned w0 = 0u, w1 = 0u, w2 = 0u, w3 = 0u;
#pragma unroll
    for (int i = 0; i < 32; ++i) { const int j = 8 * (tbase + (i >> 2)) + 2 * (i & 3) + shi;
      const bool ok = (j >= 1 && j <= cur - 2) && (v[i] >= tau); const unsigned m = ok ? (1u << (j & 31)) : 0u; const int wq = j >> 5;
      w0 |= (wq == 0) ? m : 0u; w1 |= (wq == 1) ? m : 0u; w2 |= (wq == 2) ? m : 0u; w3 |= (wq == 3) ? m : 0u; }
    w0 |= (unsigned)__shfl_xor((int)w0, 16); w1 |= (unsigned)__shfl_xor((int)w1, 16); w2 |= (unsigned)__shfl_xor((int)w2, 16); w3 |= (unsigned)__shfl_xor((int)w3, 16);
    w0 |= (unsigned)__shfl_xor((int)w0, 32); w1 |= (unsigned)__shfl_xor((int)w1, 32); w2 |= (unsigned)__shfl_xor((int)w2, 32); w3 |= (unsigned)__shfl_xor((int)w3, 32);
#pragma unroll
    for (int f = 0; f < 3; ++f) { const int jf = (f == 0) ? 0 : (f == 1) ? cur - 1 : cur; if (jf >= 0) { const unsigned m = 1u << (jf & 31); const int wq = jf >> 5;
        w0 |= (wq == 0) ? m : 0u; w1 |= (wq == 1) ? m : 0u; w2 |= (wq == 2) ? m : 0u; w3 |= (wq == 3) ? m : 0u; } }
    if (part == 0) *(uint4*)((unsigned*)(p.ws + OFF_SELQ) + ((size_t)bg * T_ + tq0 + qq) * 4) = make_uint4(w0, w1, w2, w3);
  }
  __syncthreads();
}
__device__ __forceinline__ void nsa_unit(const Cx& cx, const P& p, int u, char* lds) {
  const int tid = cx.tid, lane = tid & 63, r32 = lane & 31, wid = tid >> 6;
  const int qb = 31 - u / 12, bgh = u % 12, b = bgh / 6, g = (bgh / 3) & 1, h = bgh % 3, head = g * 3 + h;
  const size_t rowb = (size_t)b * T_; const int q0 = qb * 256;
  const bf16_t* HB = (const bf16_t*)(p.ws + OFF_HB);
  const bf16_t* Qrows = HB + ((size_t)(24 + head) * M_ + rowb + q0) * 64;
  const float* gate0 = (const float*)(p.ws + OFF_GATES) + (rowb + q0) * 24 + head * 3;
  float* tabw = (float*)(lds + att::LDS_TAB);
  const float b31 = p.rel_bias[31 * 6 + head] * L2E;
  { const uint4 mq = *(const uint4*)((const unsigned*)(p.ws + OFF_SELQ) + ((size_t)(b * 2 + g) * T_ + q0 + wid * 32 + r32) * 4);
    unsigned* sw = (unsigned*)(lds + att::LDS_SELW) + wid * 128;
    const int nblk = 4 * qb + 4;
#pragma unroll
    for (int w4 = 0; w4 < 4; ++w4) { const unsigned w = (w4 == 0) ? mq.x : (w4 == 1) ? mq.y : (w4 == 2) ? mq.z : mq.w;
      if (32 * w4 < nblk) { for (int j = 0; j < 32; ++j) { const unsigned long long bal = __ballot((w >> j) & 1u); if (lane == 0) sw[32 * w4 + j] = (unsigned)bal; } } } }
  const float* btab = (const float*)(p.ws + OFF_BTAB) + head * 768;
  if (tid < 115) tabw[tid] = btab[tid];
  const int t0w = (qb >= 2) ? 4 * qb - 8 : 0;
  const bf16_t* Kwin = HB + ((size_t)(38 + g) * M_ + rowb + 64 * t0w) * 64; const bf16_t* Kcmp = (const bf16_t*)(p.ws + OFF_KC) + (size_t)(b * 2 + g) * 512 * 64;
  att::nsa_pass<0>(tid, Qrows, HB + ((size_t)(34 + g) * M_ + rowb) * 64, HB + ((size_t)(36 + g) * M_ + rowb) * 64, 4 * qb + 4, q0, b31, gate0 + 1, lds, true, false, Kwin);
  for (int i = tid; i < 514; i += NTHR) tabw[i] = btab[128 + i];
  { const int t0 = (qb >= 2) ? 4 * qb - 8 : 0;
    att::nsa_pass<1>(tid, Qrows, HB + ((size_t)(38 + g) * M_ + rowb + 64 * t0) * 64, HB + ((size_t)(40 + g) * M_ + rowb + 64 * t0) * 64, 4 * qb + 4 - t0, q0 - 64 * t0, b31, gate0 + 2, lds, false, true, Kcmp); }
  if (tid < 115) tabw[tid] = btab[tid];
  { const int nt = (qb < 16) ? 4 : (qb < 24) ? 6 : 8;
    att::nsa_pass<2>(tid, Qrows, (const bf16_t*)(p.ws + OFF_KC) + (size_t)(b * 2 + g) * 512 * 64, (const bf16_t*)(p.ws + OFF_VC) + (size_t)(b * 2 + g) * 512 * 64, nt, q0 - 31, b31, gate0, lds, false, true, nullptr); }
  { const float* stg = (const float*)(lds + att::LDS_OST) + wid * 2048;
    bf16_t* mixw = (bf16_t*)(p.ws + OFF_MIX) + (rowb + q0 + wid * 32) * D_ + 384 + head * 64;
#pragma unroll
    for (int i = 0; i < 4; ++i) { const int row = i * 8 + (lane >> 3), ch = lane & 7;
      const f32x4 a0 = *(const f32x4*)(stg + row * 64 + ch * 8), a1 = *(const f32x4*)(stg + row * 64 + ch * 8 + 4);
      u32x4 w; w.x = pk2(a0[0], a0[1]); w.y = pk2(a0[2], a0[3]); w.z = pk2(a1[0], a1[1]); w.w = pk2(a1[2], a1[3]);
      *(u32x4*)(mixw + (size_t)row * D_ + ch * 8) = w; }
    asm volatile("s_waitcnt lgkmcnt(0)\n\ts_barrier" ::: "memory"); }
}
namespace mx {
using att::bf16x8; using att::s16x4; using att::f32x16; using att::lds_cptr;
#define MX_MFMA(a, b, c) __builtin_amdgcn_mfma_f32_32x32x16_bf16(a, b, c, 0, 0, 0)
__device__ __forceinline__ void dma_k_tile(const bf16_t* src, unsigned ldsaddr, int lane, int wid) { att::glds16(src + (size_t)lane * 64 + wid * 8, (unsigned)__builtin_amdgcn_readfirstlane(ldsaddr + wid * 1024)); }
__device__ __forceinline__ void dma_v_tile(const bf16_t* src, unsigned ldsaddr, int lane, int wid) { att::glds16(src + (size_t)(16 * (wid & 3) + (lane >> 2)) * 64 + (wid >> 2) * 32 + (lane & 3) * 8, (unsigned)__builtin_amdgcn_readfirstlane(ldsaddr + wid * 1024)); }
__device__ __forceinline__ int vlane_off(int lane) { return ((lane >> 4) & 1) * 32 + (lane & 3) * 8 + (4 * (lane >> 5) + ((lane & 15) >> 2)) * 64; }
__device__ __forceinline__ bf16x8 vfrag(lds_cptr vp, int i) { const s16x4 lo = att::vtr(vp + (i >> 2) * 4096 + (i & 3) * 1024), hi = att::vtr(vp + (i >> 2) * 4096 + (i & 3) * 1024 + 512);
  return (bf16x8){lo[0], lo[1], lo[2], lo[3], hi[0], hi[1], hi[2], hi[3]}; }
__device__ __forceinline__ bf16x8 kfrag(lds_cptr kp, int d0, int n) { return *(const __attribute__((address_space(3))) bf16x8*)(kp + d0 * 2048 + n * 512); }
#define MX_WAIT_ALL() asm volatile("s_waitcnt vmcnt(0) lgkmcnt(0)\n\ts_barrier" ::: "memory")
__device__ __forceinline__ float loggamma2(int h) { return log2f(1.f - exp2f(-5.f - (float)h)); }

__device__ __forceinline__ void ret_kv_unit(const Cx& cx, const P& p, int layer, int u, char* lds) {
  const int tid = cx.tid, lane = tid & 63, r32 = lane & 31, hi = lane >> 5, wid = cx.wv;
  const int bh = u >> 5, cp = u & 31, b = bh / 6, h = bh % 6;
  const size_t r0 = (size_t)b * T_ + cp * 256;
  const bf16_t* HB = (const bf16_t*)(p.ws + OFF_HB);
  const bf16_t* Kp = HB + ((size_t)(6 + h) * M_ + r0) * 64; const bf16_t* Vp = HB + ((size_t)(12 + h) * M_ + r0) * 64;
  const unsigned lds0 = (unsigned)(uintptr_t)lds;
#pragma unroll
  for (int i = 0; i < 4; ++i) { dma_v_tile(Vp + (size_t)i * 4096, lds0 + i * 8192, lane, wid); dma_v_tile(Kp + (size_t)i * 4096, lds0 + 32768 + i * 8192, lane, wid); }
  MX_WAIT_ALL();
  const int ch = wid >> 2, eb = (wid >> 1) & 1, db = wid & 1;
  f32x16 acc = f32x16{};
#pragma unroll
  for (int kt = 0; kt < 2; ++kt) { const lds_cptr vv = (lds_cptr)(uintptr_t)(lds0 + (ch * 2 + kt) * 8192) + vlane_off(lane), vk = vv + 32768;
#pragma unroll
    for (int ks = 0; ks < 4; ++ks) acc = MX_MFMA(vfrag(vv, 4 * eb + ks), vfrag(vk, 4 * db + ks), acc); }
  const float sc = exp2f(127.f * loggamma2(h));
  float* ST = (float*)(p.ws + OFF_RS) + ((size_t)bh * 64 + cp * 2 + ch) * 4096;
#pragma unroll
  for (int r = 0; r < 16; ++r) __hip_atomic_store(ST + (32 * eb + att::crow(r, hi)) * 64 + 32 * db + r32, acc[r] * sc, __ATOMIC_RELAXED, __HIP_MEMORY_SCOPE_AGENT);
  MX_WAIT_ALL();
  if (tid == 0) hand_publish((unsigned*)(p.ws + OFF_CTR) + 768 + layer * 64);
}
__device__ __forceinline__ void ret_scan(const Cx& cx, const P& p) {
  const float* __restrict__ ST = (const float*)(p.ws + OFF_RS); bf16_t* __restrict__ RT = (bf16_t*)(p.ws + OFF_RT);
  for (int i = cx.bid * NTHR + cx.tid; i < 12 * 4096; i += cx.G * NTHR) {
    const int bh = i >> 12, ed = i & 4095, h = bh % 6; const float lg = loggamma2(h), cd = exp2f(128.f * lg), g1 = exp2f(lg);
    const size_t o0 = (size_t)bh * 64 * 4096 + ed;
    float R = 0.f;
#pragma unroll
    for (int c0 = 0; c0 < 64; c0 += 16) {
      float kv[16];
#pragma unroll
      for (int k = 0; k < 16; ++k) kv[k] = __hip_atomic_load(ST + o0 + (size_t)(c0 + k) * 4096, __ATOMIC_RELAXED, __HIP_MEMORY_SCOPE_AGENT);
#pragma unroll
      for (int k = 0; k < 16; ++k) { RT[o0 + (size_t)(c0 + k) * 4096] = f2bf(R * g1); R = cd * R + kv[k]; }
    }
  }
}
__device__ __forceinline__ void ret_out_unit(const Cx& cx, const P& p, int u, char* lds) {
  const int tid = cx.tid, lane = tid & 63, r32 = lane & 31, hi = lane >> 5, wid = cx.wv;
  const int bh = u >> 5, cp = u & 31, b = bh / 6, h = bh % 6;
  const size_t r0 = (size_t)b * T_ + cp * 256;
  const bf16_t* HB = (const bf16_t*)(p.ws + OFF_HB);
  const bf16_t* Qp = HB + ((size_t)(0 + h) * M_ + r0) * 64; const bf16_t* Kp = HB + ((size_t)(6 + h) * M_ + r0) * 64;
  const bf16_t* Vp = HB + ((size_t)(12 + h) * M_ + r0) * 64; const bf16_t* Gp = HB + ((size_t)(18 + h) * M_ + r0) * 64;
  const unsigned lds0 = (unsigned)(uintptr_t)lds;
#pragma unroll
  for (int i = 0; i < 4; ++i) { dma_k_tile(Kp + (size_t)i * 4096, lds0 + i * 8192, lane, wid); dma_v_tile(Vp + (size_t)i * 4096, lds0 + 32768 + i * 8192, lane, wid); }
  const int ch = wid >> 2, rt = wid & 3, rw = ch * 128 + rt * 32;
  bf16x8 qr[4], rtf[2][4];
  const bf16_t* RT = (const bf16_t*)(p.ws + OFF_RT) + ((size_t)bh * 64 + cp * 2 + ch) * 4096;
#pragma unroll
  for (int d0 = 0; d0 < 4; ++d0) qr[d0] = *reinterpret_cast<const bf16x8*>(Qp + (size_t)(rw + r32) * 64 + d0 * 16 + hi * 8);
#pragma unroll
  for (int eb = 0; eb < 2; ++eb)
#pragma unroll
    for (int ks = 0; ks < 4; ++ks) rtf[eb][ks] = *reinterpret_cast<const bf16x8*>(RT + (size_t)(32 * eb + r32) * 64 + 16 * ks + 8 * hi);
  u32x4 gwv[4];
#pragma unroll
  for (int i = 0; i < 4; ++i) gwv[i] = *(const u32x4*)(Gp + (size_t)(rw + i * 8 + (lane >> 3)) * 64 + (lane & 7) * 8);
  MX_WAIT_ALL();
  f32x16 o[2]; o[0] = f32x16{}; o[1] = f32x16{};
  const f32x16 zero16 = f32x16{};
  const int n = rt * 32 + r32;
  for (int kt = 0; kt <= (rt >> 1); ++kt) {
    const int tile = ch * 2 + kt;
    const lds_cptr kp = (lds_cptr)(uintptr_t)(lds0 + tile * 8192) + hi * 1024 + r32 * 16;
    f32x16 p0 = MX_MFMA(kfrag(kp, 0, 0), qr[0], zero16), p1 = MX_MFMA(kfrag(kp, 0, 1), qr[0], zero16);
#pragma unroll
    for (int d0 = 1; d0 < 4; ++d0) { p0 = MX_MFMA(kfrag(kp, d0, 0), qr[d0], p0); p1 = MX_MFMA(kfrag(kp, d0, 1), qr[d0], p1); }
    if (kt == (rt >> 1)) {
#pragma unroll
      for (int r = 0; r < 16; ++r) { const int m = 64 * kt + att::crow(r, hi); if (m > n) p0[r] = 0.f; if (m + 32 > n) p1[r] = 0.f; }
    }
    u32x4 pw0, pw1, pw2, pw3;
    pw0 = (u32x4){att::cvtpk(p0[0], p0[1]), att::cvtpk(p0[2], p0[3]), att::cvtpk(p0[4], p0[5]), att::cvtpk(p0[6], p0[7])};
    pw1 = (u32x4){att::cvtpk(p0[8], p0[9]), att::cvtpk(p0[10], p0[11]), att::cvtpk(p0[12], p0[13]), att::cvtpk(p0[14], p0[15])};
    pw2 = (u32x4){att::cvtpk(p1[0], p1[1]), att::cvtpk(p1[2], p1[3]), att::cvtpk(p1[4], p1[5]), att::cvtpk(p1[6], p1[7])};
    pw3 = (u32x4){att::cvtpk(p1[8], p1[9]), att::cvtpk(p1[10], p1[11]), att::cvtpk(p1[12], p1[13]), att::cvtpk(p1[14], p1[15])};
    const lds_cptr vp = (lds_cptr)(uintptr_t)(lds0 + 32768 + tile * 8192) + vlane_off(lane);
#pragma unroll
    for (int d0 = 0; d0 < 2; ++d0) {
      o[d0] = MX_MFMA(__builtin_bit_cast(bf16x8, pw0), vfrag(vp, 4 * d0 + 0), o[d0]); o[d0] = MX_MFMA(__builtin_bit_cast(bf16x8, pw1), vfrag(vp, 4 * d0 + 1), o[d0]);
      o[d0] = MX_MFMA(__builtin_bit_cast(bf16x8, pw2), vfrag(vp, 4 * d0 + 2), o[d0]); o[d0] = MX_MFMA(__builtin_bit_cast(bf16x8, pw3), vfrag(vp, 4 * d0 + 3), o[d0]); }
  }
#pragma unroll
  for (int eb = 0; eb < 2; ++eb)
#pragma unroll
    for (int ks = 0; ks < 4; ++ks) o[eb] = MX_MFMA(qr[ks], rtf[eb][ks], o[eb]);
  float* stg = (float*)(lds + 65536) + wid * 2048;
#pragma unroll
  for (int r = 0; r < 16; ++r) { const int orow = att::crow(r, hi); stg[orow * 64 + r32] = o[0][r]; stg[orow * 64 + 32 + r32] = o[1][r]; }
  asm volatile("s_waitcnt lgkmcnt(0)" ::: "memory");
  bf16_t* mix = (bf16_t*)(p.ws + OFF_MIX) + (r0 + rw) * D_ + h * 64;
#pragma unroll
  for (int i = 0; i < 4; ++i) { const int row = i * 8 + (lane >> 3), c8 = lane & 7;
    const f32x4 a0 = *(const f32x4*)(stg + row * 64 + c8 * 8), a1 = *(const f32x4*)(stg + row * 64 + c8 * 8 + 4);
    float ss = (a0[0] * a0[0] + a0[1] * a0[1]) + (a0[2] * a0[2] + a0[3] * a0[3]) + (a1[0] * a1[0] + a1[1] * a1[1]) + (a1[2] * a1[2] + a1[3] * a1[3]);
    ss += __shfl_xor(ss, 1); ss += __shfl_xor(ss, 2); ss += __shfl_xor(ss, 4);
    const float rs = rsqrtf(ss * (1.f / 64.f) + EPS);
    const u32x4 gw = gwv[i];
    float gv[8] = {__uint_as_float(gw.x << 16), __uint_as_float(gw.x & 0xffff0000u), __uint_as_float(gw.y << 16), __uint_as_float(gw.y & 0xffff0000u),
                   __uint_as_float(gw.z << 16), __uint_as_float(gw.z & 0xffff0000u), __uint_as_float(gw.w << 16), __uint_as_float(gw.w & 0xffff0000u)};
    float ov[8] = {a0[0], a0[1], a0[2], a0[3], a1[0], a1[1], a1[2], a1[3]};
#pragma unroll
    for (int k = 0; k < 8; ++k) ov[k] = ov[k] * rs * (gv[k] * sigmoidf(gv[k]));
    u32x4 w; w.x = pk2(ov[0], ov[1]); w.y = pk2(ov[2], ov[3]); w.z = pk2(ov[4], ov[5]); w.w = pk2(ov[6], ov[7]);
    *(u32x4*)(mix + (size_t)row * D_ + c8 * 8) = w; }
  MX_WAIT_ALL();
}
__device__ __forceinline__ void gmlp_unit(const Cx& cx, const P& p, int layer, int u, char* lds) {
  const int tid = cx.tid, lane = tid & 63, r32 = lane & 31, hi = lane >> 5, wid = cx.wv;
  const int g = u & 3, bc = u >> 2; const size_t r0 = (size_t)bc * 128;
  const bf16_t* HB = (const bf16_t*)(p.ws + OFF_HB);
  const bf16_t* Up = HB + ((size_t)(42 + g) * M_ + r0) * 64; const bf16_t* Vp = HB + ((size_t)(46 + g) * M_ + r0) * 64;
  const unsigned lds0 = (unsigned)(uintptr_t)lds;
  dma_v_tile(Vp, lds0, lane, wid); dma_v_tile(Vp + 4096, lds0 + 8192, lane, wid);
  const int rt = wid & 3, dh = wid >> 2;
  const bf16_t* Wr = (const bf16_t*)(p.ws + OFF_WSB) + ((size_t)(layer * 4 + g) * 128 + rt * 32 + r32) * 128;
  u32x4 uwv[2]; float bsv[2];
#pragma unroll
  for (int i = 0; i < 2; ++i) { const int t = rt * 32 + i * 16 + (lane >> 2); uwv[i] = *(const u32x4*)(Up + (size_t)t * 64 + dh * 32 + (lane & 3) * 8); bsv[i] = p.gm_b[(layer * 4 + g) * 128 + t]; }
  MX_WAIT_ALL();
  f32x16 acc = f32x16{};
  for (int ks = 0; ks < 2 * rt + 2; ++ks) {
    const uint2 alo = *(const uint2*)(Wr + 16 * ks + 4 * hi), ahi = *(const uint2*)(Wr + 16 * ks + 8 + 4 * hi);
    const u32x4 aw = (u32x4){alo.x, alo.y, ahi.x, ahi.y};
    const lds_cptr vp = (lds_cptr)(uintptr_t)(lds0 + (ks >> 2) * 8192) + vlane_off(lane);
    acc = MX_MFMA(__builtin_bit_cast(bf16x8, aw), vfrag(vp, 4 * dh + (ks & 3)), acc);
  }
  float* stg = (float*)(lds + 16384) + wid * 1024;
#pragma unroll
  for (int r = 0; r < 16; ++r) stg[att::crow(r, hi) * 32 + r32] = acc[r];
  asm volatile("s_waitcnt lgkmcnt(0)" ::: "memory");
  bf16_t* mix = (bf16_t*)(p.ws + OFF_MIX) + (r0 + rt * 32) * D_ + 768 + g * 64 + dh * 32;
#pragma unroll
  for (int i = 0; i < 2; ++i) { const int row = i * 16 + (lane >> 2), c8 = lane & 3, t = rt * 32 + row;
    const f32x4 a0 = *(const f32x4*)(stg + row * 32 + c8 * 8), a1 = *(const f32x4*)(stg + row * 32 + c8 * 8 + 4);
    const float bias = bsv[i];
    const u32x4 uw = uwv[i];
    u32x4 w; w.x = pk2(__uint_as_float(uw.x << 16) * (a0[0] + bias), __uint_as_float(uw.x & 0xffff0000u) * (a0[1] + bias));
    w.y = pk2(__uint_as_float(uw.y << 16) * (a0[2] + bias), __uint_as_float(uw.y & 0xffff0000u) * (a0[3] + bias));
    w.z = pk2(__uint_as_float(uw.z << 16) * (a1[0] + bias), __uint_as_float(uw.z & 0xffff0000u) * (a1[1] + bias));
    w.w = pk2(__uint_as_float(uw.w << 16) * (a1[2] + bias), __uint_as_float(uw.w & 0xffff0000u) * (a1[3] + bias));
    *(u32x4*)(mix + (size_t)row * D_ + c8 * 8) = w; }
  MX_WAIT_ALL();
}
__device__ __forceinline__ void cmp_unit(const Cx& cx, const P& p, int layer, int u, char* lds) {
  const int tid = cx.tid, lane = tid & 63, r32 = lane & 31, hi = lane >> 5, wid = cx.wv;
  const int nt = u & 15, bgj = u >> 4, bg = bgj >> 1, j = bgj & 1, b = bg >> 1, g = bg & 1;
  const int nrow = min(nt * 32 + r32, 510);
  const bf16_t* xf = (const bf16_t*)(p.ws + OFF_HB) + ((size_t)(30 + j * 2 + g) * M_ + (size_t)b * T_) * 64 + (size_t)nrow * 1024;
  const bf16_t* W1T = (const bf16_t*)(p.ws + OFF_W1T) + (size_t)(layer * 2 + j) * 64 * 2048;
  bf16x8 w2f[2][2][2];
  if (wid == 0) { const bf16_t* wf = (const bf16_t*)(p.ws + OFF_W2F) + (size_t)(layer * 2 + j) * 4096 + lane * 8;
#pragma unroll
    for (int q = 0; q < 8; ++q) w2f[q >> 2][(q >> 1) & 1][q & 1] = *reinterpret_cast<const bf16x8*>(wf + q * 512); }
  f32x16 acc[2]; acc[0] = f32x16{}; acc[1] = f32x16{};
#pragma unroll 8
  for (int ks = 0; ks < 16; ++ks) { const int i0 = 256 * wid + 16 * ks + 8 * hi;
    const bf16x8 bx = *reinterpret_cast<const bf16x8*>(xf + i0);
    const bf16x8 a0 = *reinterpret_cast<const bf16x8*>(W1T + (size_t)r32 * 2048 + i0), a1 = *reinterpret_cast<const bf16x8*>(W1T + (size_t)(32 + r32) * 2048 + i0);
    acc[0] = MX_MFMA(a0, bx, acc[0]); acc[1] = MX_MFMA(a1, bx, acc[1]); }
  float* red = (float*)lds;
#pragma unroll
  for (int fb = 0; fb < 2; ++fb)
#pragma unroll
    for (int r = 0; r < 16; ++r) red[((wid * 2 + fb) * 16 + r) * 64 + lane] = acc[fb][r];
  MX_WAIT_ALL();
  {
    const float* c1 = (const float*)(p.ws + OFF_C1) + (layer * 2 + j) * 64;
    const int fb = wid >> 2, r0 = 4 * (wid & 3);
#pragma unroll
    for (int rr = 0; rr < 4; ++rr) { const int r = r0 + rr; float a = c1[32 * fb + att::crow(r, hi)];
#pragma unroll
      for (int w = 0; w < 8; ++w) a += red[((w * 2 + fb) * 16 + r) * 64 + lane];
      red[16384 + (fb * 16 + r) * 64 + lane] = gelu_tanh(a); } }
  MX_WAIT_ALL();
  if (wid == 0) {
    bf16x8 hb[2][2];
#pragma unroll
    for (int fb = 0; fb < 2; ++fb)
#pragma unroll
      for (int s2 = 0; s2 < 2; ++s2) { float hv[8];
#pragma unroll
        for (int k = 0; k < 8; ++k) hv[k] = red[16384 + (fb * 16 + 8 * s2 + k) * 64 + lane];
        const u32x4 w = (u32x4){att::cvtpk(hv[0], hv[1]), att::cvtpk(hv[2], hv[3]), att::cvtpk(hv[4], hv[5]), att::cvtpk(hv[6], hv[7])};
        hb[fb][s2] = __builtin_bit_cast(bf16x8, w); }
    f32x16 oc[2]; oc[0] = f32x16{}; oc[1] = f32x16{};
#pragma unroll
    for (int eb = 0; eb < 2; ++eb)
#pragma unroll
      for (int fb = 0; fb < 2; ++fb)
#pragma unroll
        for (int s2 = 0; s2 < 2; ++s2) oc[eb] = MX_MFMA(w2f[eb][fb][s2], hb[fb][s2], oc[eb]);
    if (j == 0) { float ss = 0.f;
#pragma unroll
      for (int eb = 0; eb < 2; ++eb)
#pragma unroll
        for (int r = 0; r < 16; ++r) ss += oc[eb][r] * oc[eb][r];
      ss += __shfl_xor(ss, 32);
      const float rs = rsqrtf(ss * (1.f / 64.f) + EPS);
#pragma unroll
      for (int eb = 0; eb < 2; ++eb)
#pragma unroll
        for (int r = 0; r < 16; ++r) oc[eb][r] *= rs * p.k_gain[(layer * 3 + 0) * 64 + 32 * eb + att::crow(r, hi)]; }
    bf16_t* dst = (bf16_t*)(p.ws + (j == 0 ? OFF_KC : OFF_VC)) + ((size_t)bg * 512 + nt * 32 + r32) * 64;
    const bool real = (nt * 32 + r32) < 511;
    if (real) {
#pragma unroll
      for (int eb = 0; eb < 2; ++eb)
#pragma unroll
        for (int r4 = 0; r4 < 4; ++r4)
        { const unsigned long long w = (unsigned long long)pk2(oc[eb][4 * r4], oc[eb][4 * r4 + 1]) | ((unsigned long long)pk2(oc[eb][4 * r4 + 2], oc[eb][4 * r4 + 3]) << 32);
          unsigned long long* q8 = (unsigned long long*)(dst + 32 * eb + att::crow(4 * r4, hi));
          if (j == 0) __hip_atomic_store(q8, w, __ATOMIC_RELAXED, __HIP_MEMORY_SCOPE_AGENT); else *q8 = w; } }
    if (j == 0) { asm volatile("s_waitcnt vmcnt(0)" ::: "memory"); if (lane == 0) hand_publish((unsigned*)(p.ws + OFF_CTR) + 512 + layer * 64 + bg * 16); }
  }
  MX_WAIT_ALL();
}
#undef MX_MFMA
}

__device__ __forceinline__ void ph_mix1(const Cx& cx, const P& p, int layer, char* lds, int rank, int nranks) {
  for (int item = rank; item < 128 + 384; item += nranks) {
    Cx c2 = cx; c2.tid = cx.wv * 64 + lane_id(); asm volatile("" : "+v"(c2.tid));
    if (item < 128) mx::cmp_unit(c2, p, layer, item, lds); else mx::ret_kv_unit(c2, p, layer, item - 128, lds);
  }
}
__device__ __forceinline__ void ph_mix2(const Cx& cx, const P& p, int layer, char* lds) {
  const int u0 = (cx.bid < 64) ? 192 + cx.bid : cx.bid - 64;
  for (int u = u0; u < 256; u += 256) { Cx c2 = cx; c2.tid = cx.wv * 64 + lane_id(); asm volatile("" : "+v"(c2.tid)); topk_unit(c2, p, layer, u, lds); }
  if (cx.bid >= 160) { if (cx.wv == 0 && lane_id() == 0) hand_wait((unsigned*)(p.ws + OFF_CTR) + 768 + layer * 64, 384u); __syncthreads();
    Cx c3 = cx; c3.bid = cx.bid - 160; c3.G = 96; mx::ret_scan(c3, p); }
  if (layer == 0) convert_weights(p, (LAS unsigned char*)lds, cx.wv, lane_id(), cx.bid * 8 + cx.wv, cx.G * 8, 6400, 8576);
}
__device__ __forceinline__ void ph_mix3(const Cx& cx, const P& p, int layer, char* lds) {
  const int nconv = (layer == 0) ? 148 : 0;
  unsigned* ctr = (unsigned*)(p.ws + OFF_CTR) + layer * 64;
  int* slot = (int*)(lds + 131072);
  for (;;) {
    __syncthreads();
    if (cx.wv == 0 && lane_id() == 0) *slot = (int)atomicAdd(ctr, 1u);
    __syncthreads();
    const int item = __builtin_amdgcn_readfirstlane(*slot);
    if (item >= 384 + 384 + 512 + nconv) break;
    Cx c2 = cx; c2.tid = cx.wv * 64 + lane_id(); asm volatile("" : "+v"(c2.tid));
    if (item < 384) nsa_unit(c2, p, item, lds); else if (item < 768) mx::ret_out_unit(c2, p, item - 384, lds);
    else if (item < 1280) mx::gmlp_unit(c2, p, layer, item - 768, lds);
    else { const int c0 = 1664 + (item - 1280) * 32; convert_weights(p, (LAS unsigned char*)lds, cx.wv, lane_id(), cx.wv, 8, c0, min(c0 + 32, 6400)); }
  }
}
typedef unsigned gu32_t;
#define XB_TMO      128
#define XB_XCNT(j)  (256  + 64 * (j))
#define XB_XSUB(j)  (1280 + 64 * (j))
#define XB_XGEN(j)  (2304 + 64 * (j))
#define XB_TOP      3328
#define XB_TOPGEN   3392
#define XCD_BAR_WORDS 3456
#define XB_SPIN_CAP (1u << 18)

__device__ __forceinline__ unsigned xb_ld(unsigned* p)              { return __hip_atomic_load(p, __ATOMIC_RELAXED, __HIP_MEMORY_SCOPE_AGENT); }
__device__ __forceinline__ unsigned xb_add(unsigned* p, unsigned v) { return __hip_atomic_fetch_add(p, v, __ATOMIC_RELAXED, __HIP_MEMORY_SCOPE_AGENT); }
__device__ __forceinline__ unsigned xb_xcc_id() { return (unsigned)__builtin_amdgcn_s_getreg((3 << 11) | 20) & 0xFu; }
#define XB_SPIN(cond, bar) do { unsigned _sp = 0; while (cond) { __builtin_amdgcn_s_sleep(1); \
    if ((++_sp & 255u) == 0u) { if (xb_ld(&(bar)[XB_TMO])) break; if (_sp > XB_SPIN_CAP) { atomicAdd(&(bar)[XB_TMO], 1u); break; } } } } while (0)

struct XcdBarrier {
    unsigned* bar; unsigned x;
    volatile LAS unsigned* st;
    int wv;
};

__device__ __forceinline__ XcdBarrier xcd_barrier_post(unsigned* bar, volatile LAS unsigned* st, int wv) {
    XcdBarrier b; b.bar = bar; b.x = xb_xcc_id(); b.st = st; b.wv = wv;
    if (wv == 0 && lane_id() == 0) (void)xb_add(&bar[XB_XCNT(b.x)], 1u);
    return b;
}
__device__ __forceinline__ void xcd_barrier_complete(unsigned* bar, unsigned x, unsigned& nloc, unsigned& nx) {
    const unsigned G = gridDim.x * gridDim.y * gridDim.z;
    unsigned sum, cnt, mine, sp = 0u;
    for (;;) {
        sum = 0u; cnt = 0u; mine = 0u;
#pragma unroll
        for (unsigned j = 0; j < 16; ++j) { const unsigned c = xb_ld(&bar[XB_XCNT(j)]); sum += c; cnt += (c > 0u) ? 1u : 0u; mine = (j == x) ? c : mine; }
        if (sum == G) break;
        __builtin_amdgcn_s_sleep(1);
        if ((++sp & 255u) == 0u) { if (xb_ld(&bar[XB_TMO])) break; if (sp > XB_SPIN_CAP) { atomicAdd(&bar[XB_TMO], 1u); break; } }
    }
    nloc = mine > 0u ? mine : 1u; nx = cnt > 0u ? cnt : 1u;
}

__device__ __forceinline__ void xcd_barrier(const XcdBarrier& b) {
    asm volatile("s_waitcnt vmcnt(0)" ::: "memory");
    __syncthreads();
    if (b.wv == 0 && lane_id() == 0) {
        unsigned* bar = b.bar;
        __builtin_amdgcn_s_waitcnt(0);
        unsigned nloc = b.st[0], nx = b.st[1];
        if (nloc == 0u) { xcd_barrier_complete(bar, b.x, nloc, nx); b.st[0] = nloc; b.st[1] = nx; }
        const unsigned old = xb_add(&bar[XB_XSUB(b.x)], 1u);
        const unsigned gen = old / nloc;
        if (old + 1u == (gen + 1u) * nloc) {
            __builtin_amdgcn_fence(__ATOMIC_RELEASE, "agent");
            asm volatile("s_waitcnt vmcnt(0)" ::: "memory");
            const unsigned og = xb_add(&bar[XB_TOP], 1u);
            const unsigned tg = og / nx;
            if (og + 1u == (tg + 1u) * nx) xb_add(&bar[XB_TOPGEN], 1u);
            else XB_SPIN(xb_ld(&bar[XB_TOPGEN]) == tg, bar);
            __builtin_amdgcn_fence(__ATOMIC_ACQUIRE, "agent");
            xb_add(&bar[XB_XGEN(b.x)], 1u);
            asm volatile("s_waitcnt vmcnt(0)" ::: "memory");
        } else {
            XB_SPIN(xb_ld(&bar[XB_XGEN(b.x)]) == gen, bar);
            __builtin_amdgcn_fence(__ATOMIC_ACQUIRE, "agent");
            asm volatile("s_waitcnt vmcnt(0)" ::: "memory");
        }
    }
    __syncthreads();
}

__global__ void __launch_bounds__(NTHR, 2) k_mega(P pk) {
  extern __shared__ __attribute__((aligned(16))) unsigned char lds_raw[];
  LAS unsigned char* lds = (LAS unsigned char*)lds_raw;
  float* sm = (float*)lds_raw;
  const int wave_s = __builtin_amdgcn_readfirstlane((int)threadIdx.x >> 6);
  { volatile LAS unsigned* bst = (volatile LAS unsigned*)(lds + 131072 + 64);
    if (threadIdx.x < 2) bst[threadIdx.x] = 0u;
    __syncthreads();
    (void)xcd_barrier_post((unsigned*)(pk.ws + OFF_BAR), bst, wave_s); }
#define GSYNC() do { kargp_t kb_ = (kargp_t)__builtin_amdgcn_kernarg_segment_ptr(); asm volatile("" : "+s"(kb_)); XcdBarrier xb_; xb_.bar = (unsigned*)(kb_->ws + OFF_BAR); xb_.x = xb_xcc_id(); \
    xb_.st = (volatile LAS unsigned*)(lds + 131072 + 64); xb_.wv = wave_s; xcd_barrier(xb_); } while (0)
#define LOADP(p, k) do { p.x = k->x; p.attn_norm = k->attn_norm; p.w_in = k->w_in; p.w_out = k->w_out; p.q_gain = k->q_gain; p.k_gain = k->k_gain; p.cmp_pe = k->cmp_pe; p.cmp_w1 = k->cmp_w1; p.cmp_w2 = k->cmp_w2; \
    p.gm_ws = k->gm_ws; p.gm_b = k->gm_b; p.ffn_norm = k->ffn_norm; p.w_gu = k->w_gu; p.w_down = k->w_down; p.rel_bias = k->rel_bias; p.out = k->out; p.ws = k->ws; } while (0)
  typedef const __attribute__((address_space(4))) P* kargp_t;
#define PB Cx cx; P p; { int t_ = wave_s * 64 + lane_id(), b_ = blockIdx.x; kargp_t k_ = (kargp_t)__builtin_amdgcn_kernarg_segment_ptr(); asm volatile("" : "+v"(t_), "+s"(b_), "+s"(k_)); LOADP(p, k_); cx.tid = t_; cx.bid = b_; cx.G = gridDim.x; cx.wv = wave_s; }
  { PB; ph_prologue(cx, p, lds); }
  GSYNC();
#pragma unroll 1
  for (int layer = 0; layer < 2; ++layer) {
    { PB; pg8::Gemm g{(const bf16_t*)(p.ws + OFF_XB), (const bf16_t*)(p.ws + OFF_WIN) + (size_t)layer * NPROJ * D_, M_, 3072, D_}; pg8::StaticOrder S; S.init(M_, 3072, cx.G, cx.bid);
      EpiProj E{(const float*)(p.ws + OFF_SSQ), (bf16_t*)(p.ws + OFF_HB), (float*)(p.ws + OFF_GATES), (const float2*)(p.ws + OFF_ROPE), p.q_gain + layer * 64, p.k_gain + layer * 192};
      pg8::gemm_phase<EpiProj, pg8::StaticOrder, PG8_ALIGN, PG8_SP2>(lds, g, S, E, cx.tid); }
    GSYNC();
    { PB; if (cx.bid < 64) {
        pg8::Gemm g2{(const bf16_t*)(p.ws + OFF_XB), (const bf16_t*)(p.ws + OFF_WIN) + (size_t)layer * NPROJ * D_, M_, NPROJ, D_}; pg8::OneUnit S2{cx.bid, 12, true};
        EpiProj E{(const float*)(p.ws + OFF_SSQ), (bf16_t*)(p.ws + OFF_HB), (float*)(p.ws + OFF_GATES), (const float2*)(p.ws + OFF_ROPE), p.q_gain + layer * 64, p.k_gain + layer * 192};
        pg8::gemm_phase<EpiProj, pg8::OneUnit, false, PG8_SP2>(lds, g2, S2, E, cx.tid);
      } else ph_mix1(cx, p, layer, (char*)lds_raw, cx.bid - 64, cx.G - 64); }
    { PB; ph_mix2(cx, p, layer, (char*)lds_raw); } GSYNC();
    { PB; ph_mix3(cx, p, layer, (char*)lds_raw); } GSYNC();
    { PB; pg8::Gemm g{(const bf16_t*)(p.ws + OFF_MIX), (const bf16_t*)(p.ws + OFF_WO) + (size_t)layer * D_ * D_, M_, D_, D_}; pg8::StaticOrder S; S.init(M_, D_, cx.G, cx.bid);
      EpiRes E{(layer == 0) ? p.x : nullptr, nullptr, (bf16_t*)(p.ws + OFF_XB), (float*)(p.ws + OFF_SSQ)};
      pg8::gemm_phase<EpiRes, pg8::StaticOrder, PG8_ALIGN, PG8_SP2>(lds, g, S, E, cx.tid); }
    GSYNC();
    { PB; pg8::Gemm g{(const bf16_t*)(p.ws + OFF_XB), (const bf16_t*)(p.ws + OFF_WGU) + (size_t)layer * 2 * DFF * D_, M_, 2 * DFF, D_}; pg8::StaticOrder S; S.init(M_, 2 * DFF, cx.G, cx.bid);
      EpiGU E{(const float*)(p.ws + OFF_SSQ), (bf16_t*)(p.ws + OFF_ACT)};
      pg8::gemm_phase<EpiGU, pg8::StaticOrder, PG8_ALIGN, PG8_SP2>(lds, g, S, E, cx.tid);
      { const int c0 = (cx.G > 128) ? 128 : 0; if (layer == 0 && cx.bid >= c0) convert_weights(p, lds, cx.wv, cx.tid & 63, (cx.bid - c0) * 8 + cx.wv, (cx.G - c0) * 8, 8576, 12800); } }
    GSYNC();
    { PB; pg8::Gemm g{(const bf16_t*)(p.ws + OFF_ACT), (const bf16_t*)(p.ws + OFF_WD) + (size_t)layer * D_ * DFF, M_, D_, DFF}; pg8::StaticOrder S; S.init(M_, D_, cx.G, cx.bid);
      EpiRes E{nullptr, (layer == 1) ? p.out : nullptr, (bf16_t*)(p.ws + OFF_XB), (float*)(p.ws + OFF_SSQ)};
      pg8::gemm_phase<EpiRes, pg8::StaticOrder, PG8_ALIGN, PG8_SP2>(lds, g, S, E, cx.tid); }
    GSYNC();
  }
}

extern "C" void kernel_launch(void* const* d_in, const int* in_sizes, int n_in, void* d_out, int out_size, void* d_ws, size_t ws_size, hipStream_t stream) {
  P p{};
  p.x = (const float*)d_in[0]; p.attn_norm = (const float*)d_in[1]; p.w_in = (const float*)d_in[2]; p.w_out = (const float*)d_in[3];
  p.q_gain = (const float*)d_in[4]; p.k_gain = (const float*)d_in[5]; p.cmp_pe = (const float*)d_in[6]; p.cmp_w1 = (const float*)d_in[7];
  p.cmp_w2 = (const float*)d_in[8]; p.gm_ws = (const float*)d_in[9]; p.gm_b = (const float*)d_in[10]; p.ffn_norm = (const float*)d_in[11];
  p.w_gu = (const float*)d_in[12]; p.w_down = (const float*)d_in[13]; p.rel_bias = (const float*)d_in[14];
  p.out = (float*)d_out; p.ws = (unsigned char*)d_ws;
  static int grid = 0;
  if (!grid) {
    (void)hipFuncSetAttribute((const void*)k_mega, hipFuncAttributeMaxDynamicSharedMemorySize, LDS_BYTES);
    int dev = 0, cus = 0, per_cu = 0;
    (void)hipGetDevice(&dev);
    (void)hipDeviceGetAttribute(&cus, hipDeviceAttributeMultiprocessorCount, dev);
    (void)hipOccupancyMaxActiveBlocksPerMultiprocessor(&per_cu, (const void*)k_mega, NTHR, LDS_BYTES);
    if (per_cu < 1) per_cu = 1;
    grid = cus;
  }
  (void)hipMemsetAsync((char*)d_ws + OFF_BAR, 0, 16384, stream);
  void* args[] = {&p};
  hipError_t e = hipLaunchCooperativeKernel((const void*)k_mega, dim3(grid), dim3(NTHR), args, LDS_BYTES, stream);
  if (e != hipSuccess) fprintf(stderr, "cooperative launch failed: %s (grid %d)\n", hipGetErrorString(e), grid);
}
```

```cpp
#include <hip/hip_runtime.h>
#include <hip/hip_cooperative_groups.h>
#include <stdint.h>
#include <stdio.h>
namespace cg = cooperative_groups;
namespace pg8 {
#define PG8_LAS __attribute__((address_space(3)))
typedef unsigned short bf16_t;
typedef short bf16x8 __attribute__((ext_vector_type(8)));
typedef float f32x4 __attribute__((ext_vector_type(4)));
typedef unsigned u32x4 __attribute__((ext_vector_type(4)));
constexpr int BM = 256, BK = 64, HALF = 128, HTB = HALF * BK * 2  , STAGE_BYTES = 8 * HTB, NXCD = 8, WGM = 8;

__host__ __device__ __forceinline__ int lds_byte(int r, int c) { const int st = (r >> 4) * 2 + (c >> 5), rr = r & 15, cc = c & 31, ob = rr * 64 + cc * 2; return st * 1024 + (ob ^ (((ob >> 9) & 1) << 5)); }
__host__ __device__ __forceinline__ void stage_rc(int b, int& R, int& C) { const int st = b / 1024, sb = b % 1024, swz = sb ^ (((sb >> 9) & 1) << 5); R = (st >> 1) * 16 + swz / 64; C = (st & 1) * 32 + (swz % 64) / 2; }
__host__ __device__ __forceinline__ int perm32(int rho) { const int n = rho >> 4, i = rho & 15; return 8 * (i >> 2) + 4 * n + (i & 3); }

struct Unit { int pm, pn; };
struct Gemm { const bf16_t* A; const bf16_t* Bt; int M, N, K; };

struct StaticOrder {
    int nM, nN, nwg, G, c;
    __host__ __device__ void init(int M, int N, int G_, int c_) { nM = M / BM; nN = N / BM; nwg = nM * nN; G = G_; c = c_; }
    __host__ __device__ bool next(int i, Unit& u) const {
        const long L = (long)i * G + c; if (L >= nwg) return false;
        int wgid = (int)L; { const int q = nwg / NXCD, r = nwg % NXCD, xcd = wgid % NXCD, off = wgid / NXCD; wgid = (xcd < r ? xcd * (q + 1) : r * (q + 1) + (xcd - r) * q) + off; }
        const int nig = WGM * nN, gid = wgid / nig, fm = gid * WGM, gsz = (nM - fm) < WGM ? (nM - fm) : WGM;
        u.pm = fm + ((wgid % nig) % gsz); u.pn = (wgid % nig) / gsz; return true;
    }
    __device__ __forceinline__ void a_ready(const Unit&) const {}
    __device__ __forceinline__ void done(const Unit&) const {}
};

struct OneUnit {
    int pm, pn; bool have;
    __host__ __device__ bool next(int i, Unit& u) const { if (i > 0 || !have) return false; u.pm = pm; u.pn = pn; return true; }
    __device__ __forceinline__ void a_ready(const Unit&) const {}
    __device__ __forceinline__ void done(const Unit&) const {}
};
__device__ __forceinline__ unsigned cvt_pk_bf16(float lo, float hi) { unsigned r; asm volatile("v_cvt_pk_bf16_f32 %0, %1, %2" : "=v"(r) : "v"(lo), "v"(hi)); return r; }
typedef float f32x2 __attribute__((ext_vector_type(2)));
template <class Epi, class Sched, bool ALIGN_EPI = false, bool SP2 = false>
__device__ __forceinline__ void gemm_phase(PG8_LAS unsigned char* lds, const Gemm g, const Sched& S, const Epi& E, const int tid) {
    const int wid = __builtin_amdgcn_readfirstlane(tid >> 6), lane = tid & 63, wr = wid >> 2, wc = wid & 3, fr = lane & 15, fq = lane >> 4;
    const int K = g.K, nt = K / BK;
    unsigned voffA[2], voffB[2];
#pragma unroll
    for (int i = 0; i < 2; ++i) { int R, C; stage_rc(tid * 16 + i * 8192, R, C); const int Rb = Epi::PERM ? ((R & ~31) + perm32(R & 31)) : R;
        voffA[i] = (unsigned)(R * K + C) * 2u; voffB[i] = (unsigned)(Rb * K + C) * 2u; }
    const size_t kstep = (size_t)(BK * 2);
    const size_t hstep = (size_t)HALF * K * 2;
    const size_t tstep = 2 * hstep;
    const unsigned ldsw = (unsigned)wid * 1024u;
    const int aoff = lds_byte(wr * 64 + fr, fq * 8), boff = lds_byte(wc * 32 + fr, fq * 8);
#define PG8_SA(b, h) (((b) * 2 + (h)) * HTB)
#define PG8_SB(b, h) ((4 + (b) * 2 + (h)) * HTB)
#define PG8_STAGE(bufoff, gbase, voff) do { _Pragma("unroll") for (int _i = 0; _i < 2; ++_i) \
        __builtin_amdgcn_global_load_lds((const unsigned*)((const char*)(gbase) + (voff)[_i]), (PG8_LAS unsigned*)(lds + (bufoff) + ldsw + _i * 8192), 16, 0, 0); } while (0)
#define PG8_LDA(dst, b, h) do { _Pragma("unroll") for (int m = 0; m < 4; ++m) _Pragma("unroll") for (int k = 0; k < 2; ++k) dst[m][k] = *(const PG8_LAS bf16x8*)(lds + PG8_SA(b, h) + aoff + m * 2048 + k * 1024); } while (0)
#define PG8_LDB(dst, b, h) do { _Pragma("unroll") for (int n = 0; n < 2; ++n) _Pragma("unroll") for (int k = 0; k < 2; ++k) dst[n][k] = *(const PG8_LAS bf16x8*)(lds + PG8_SB(b, h) + boff + n * 2048 + k * 1024); } while (0)
#define PG8_MMA(ai, bj, At, Bt) do { __builtin_amdgcn_s_setprio(1); _Pragma("unroll") for (int m = 0; m < 4; ++m) _Pragma("unroll") for (int n = 0; n < 2; ++n) _Pragma("unroll") for (int k = 0; k < 2; ++k) \
        acc[ai][bj][m][n] = __builtin_amdgcn_mfma_f32_16x16x32_bf16(Bt[n][k], At[m][k], acc[ai][bj][m][n], 0, 0, 0); __builtin_amdgcn_s_setprio(0); } while (0)
#define PG8_WAIT_V(n) asm volatile("s_waitcnt vmcnt(" #n ")" ::: "memory")
#define PG8_WAIT_L(n) asm volatile("s_waitcnt lgkmcnt(" #n ")" ::: "memory")
#define PG8_BAR __builtin_amdgcn_s_barrier()
#define PG8_SCHED __builtin_amdgcn_sched_barrier(0)
    Unit cur, nxt; int ui = 0;
    if (!S.next(0, cur)) return;
    f32x4 acc[2][2][4][2];
#pragma unroll
    for (int a = 0; a < 2; ++a)
#pragma unroll
        for (int b = 0; b < 2; ++b)
#pragma unroll
            for (int m = 0; m < 4; ++m)
#pragma unroll
                for (int n = 0; n < 2; ++n) acc[a][b][m][n] = (f32x4){0.f, 0.f, 0.f, 0.f};
    bf16x8 At[4][2], B0[2][2], B1[2][2];
    const char* cA = (const char*)g.A + (size_t)cur.pm * tstep; const char* cB = (const char*)g.Bt + (size_t)cur.pn * tstep;
    S.a_ready(cur);
    if constexpr (SP2) {
        PG8_STAGE(PG8_SB(0, 0), cB, voffB); PG8_STAGE(PG8_SB(0, 1), cB + hstep, voffB); PG8_STAGE(PG8_SA(0, 0), cA, voffA); PG8_STAGE(PG8_SA(0, 1), cA + hstep, voffA);
        if (wr == 1) PG8_BAR;
        PG8_WAIT_V(2); PG8_BAR;
        PG8_STAGE(PG8_SB(1, 0), cB + kstep, voffB); PG8_STAGE(PG8_SA(1, 0), cA + kstep, voffA); PG8_STAGE(PG8_SB(1, 1), cB + hstep + kstep, voffB);
        PG8_WAIT_V(6); PG8_BAR;
    } else {
        PG8_STAGE(PG8_SB(0, 0), cB, voffB); PG8_STAGE(PG8_SA(0, 0), cA, voffA); PG8_STAGE(PG8_SB(0, 1), cB + hstep, voffB); PG8_STAGE(PG8_SA(0, 1), cA + hstep, voffA);
        if (wr == 1) PG8_BAR;
        PG8_WAIT_V(4); PG8_BAR;
        PG8_STAGE(PG8_SB(1, 0), cB + kstep, voffB); PG8_STAGE(PG8_SA(1, 0), cA + kstep, voffA); PG8_STAGE(PG8_SB(1, 1), cB + hstep + kstep, voffB);
        PG8_WAIT_V(6); PG8_BAR;
    }
    for (;;) {
        const bool has_next = S.next(ui + 1, nxt);
        const char* nA = has_next ? (const char*)g.A + (size_t)nxt.pm * tstep : cA; const char* nB = has_next ? (const char*)g.Bt + (size_t)nxt.pn * tstep : cB;
        for (int t = 0; t < nt; t += 2) {
            const bool last = (t == nt - 2);
            const char* a1 = cA + (size_t)(t + 1) * kstep;
            const char* a2 = last ? nA : cA + (size_t)(t + 2) * kstep; const char* b2 = last ? nB : cB + (size_t)(t + 2) * kstep;
            const char* a3 = a2 + kstep; const char* b3 = b2 + kstep;
            if (last && has_next) S.a_ready(nxt);
            if constexpr (SP2) {
            PG8_LDB(B0, 0, 0); PG8_LDB(B1, 0, 1); PG8_SCHED; PG8_LDA(At, 0, 0); PG8_STAGE(PG8_SA(1, 1), a1 + hstep, voffA);
            PG8_WAIT_V(8); PG8_WAIT_L(0); PG8_BAR; PG8_MMA(0, 0, At, B0); PG8_MMA(0, 1, At, B1); PG8_BAR; PG8_SCHED;
            PG8_LDA(At, 0, 1); PG8_STAGE(PG8_SB(0, 0), b2, voffB); PG8_STAGE(PG8_SB(0, 1), b2 + hstep, voffB); PG8_STAGE(PG8_SA(0, 0), a2, voffA);
            PG8_WAIT_V(8); PG8_WAIT_L(0); PG8_BAR; PG8_MMA(1, 0, At, B0); PG8_MMA(1, 1, At, B1); PG8_BAR; PG8_SCHED;
            PG8_LDB(B0, 1, 0); PG8_LDB(B1, 1, 1); PG8_SCHED; PG8_LDA(At, 1, 0); PG8_STAGE(PG8_SA(0, 1), a2 + hstep, voffA);
            PG8_WAIT_V(8); PG8_WAIT_L(0); PG8_BAR; PG8_MMA(0, 0, At, B0); PG8_MMA(0, 1, At, B1); PG8_BAR; PG8_SCHED;
            PG8_LDA(At, 1, 1); PG8_STAGE(PG8_SB(1, 0), b3, voffB); PG8_STAGE(PG8_SB(1, 1), b3 + hstep, voffB); PG8_STAGE(PG8_SA(1, 0), a3, voffA);
            PG8_WAIT_V(8); PG8_WAIT_L(0); PG8_BAR; PG8_MMA(1, 0, At, B0); PG8_MMA(1, 1, At, B1); PG8_BAR; PG8_SCHED;
            } else {
            PG8_LDB(B0, 0, 0); PG8_SCHED; PG8_LDA(At, 0, 0); PG8_STAGE(PG8_SA(1, 1), a1 + hstep, voffA);
            PG8_WAIT_L(8); PG8_BAR; PG8_WAIT_L(0); PG8_MMA(0, 0, At, B0); PG8_BAR; PG8_SCHED;
            PG8_LDB(B1, 0, 1); PG8_STAGE(PG8_SB(0, 0), b2, voffB);
            PG8_BAR; PG8_WAIT_L(0); PG8_MMA(0, 1, At, B1); PG8_BAR;
            PG8_LDA(At, 0, 1); PG8_STAGE(PG8_SA(0, 0), a2, voffA);
            PG8_BAR; PG8_WAIT_L(0); PG8_MMA(1, 0, At, B0); PG8_BAR; PG8_SCHED;
            PG8_STAGE(PG8_SB(0, 1), b2 + hstep, voffB);
            PG8_WAIT_V(6); PG8_BAR; PG8_MMA(1, 1, At, B1); PG8_BAR;
            PG8_LDB(B0, 1, 0); PG8_SCHED; PG8_LDA(At, 1, 0); PG8_STAGE(PG8_SA(0, 1), a2 + hstep, voffA);
            PG8_WAIT_L(8); PG8_BAR; PG8_WAIT_L(0); PG8_MMA(0, 0, At, B0); PG8_BAR; PG8_SCHED;
            PG8_LDB(B1, 1, 1); PG8_STAGE(PG8_SB(1, 0), b3, voffB);
            PG8_BAR; PG8_WAIT_L(0); PG8_MMA(0, 1, At, B1); PG8_BAR;
            PG8_LDA(At, 1, 1); PG8_STAGE(PG8_SA(1, 0), a3, voffA);
            PG8_BAR; PG8_WAIT_L(0); PG8_MMA(1, 0, At, B0); PG8_BAR; PG8_SCHED;
            PG8_STAGE(PG8_SB(1, 1), b3 + hstep, voffB);
            PG8_WAIT_V(6); PG8_BAR; PG8_MMA(1, 1, At, B1); PG8_BAR;
            }
        }
        if constexpr (ALIGN_EPI) { if (wr == 0) PG8_BAR; }
        if constexpr (!Epi::AFTER_DRAIN) { E(acc, cur, wr, wc, fr, fq); S.done(cur); }
        if (!has_next) break;
#pragma unroll
        for (int a = 0; a < 2; ++a)
#pragma unroll
            for (int b = 0; b < 2; ++b)
#pragma unroll
                for (int m = 0; m < 4; ++m)
#pragma unroll
                    for (int n = 0; n < 2; ++n) acc[a][b][m][n] = (f32x4){0.f, 0.f, 0.f, 0.f};
        cur = nxt; cA = nA; cB = nB; ++ui;
        if constexpr (ALIGN_EPI) { if (wr == 1) PG8_BAR; }
    }
    PG8_WAIT_V(0);
    if constexpr (!ALIGN_EPI) { if (wr == 0) PG8_BAR; }
    PG8_BAR;
    if constexpr (Epi::AFTER_DRAIN) { E.fused(acc, cur, wr, wc, fr, fq, lds, wid, lane); S.done(cur); }
#undef PG8_SA
#undef PG8_SB
#undef PG8_STAGE
#undef PG8_LDA
#undef PG8_LDB
#undef PG8_MMA
#undef PG8_WAIT_V
#undef PG8_WAIT_L
#undef PG8_BAR
#undef PG8_SCHED
}
}

#ifndef PG8_SP2
#define PG8_SP2 true
#endif
#ifndef PG8_ALIGN
#define PG8_ALIGN true
#endif

typedef unsigned short bf16_t;
typedef float f32x4 __attribute__((ext_vector_type(4)));
typedef unsigned u32x4 __attribute__((ext_vector_type(4)));
#define LAS __attribute__((address_space(3)))

#define T_ 8192
#define M_ 16384
#define D_ 1024
#define INW 3218
#define NPROJ 3328
#define DFF 2816
#define EPS 1e-6f
#define NTHR 512

struct Cx { int tid, bid, G, wv; };
__device__ __forceinline__ int lane_id() { int l; asm volatile("v_mbcnt_lo_u32_b32 %0, -1, 0\n\tv_mbcnt_hi_u32_b32 %0, -1, %0" : "=v"(l)); return l; }
__device__ __forceinline__ void hand_publish(unsigned* cnt) { asm volatile("s_waitcnt vmcnt(0)" ::: "memory"); __hip_atomic_fetch_add(cnt, 1u, __ATOMIC_RELAXED, __HIP_MEMORY_SCOPE_AGENT); }
__device__ __forceinline__ void hand_wait(unsigned* cnt, unsigned need) { unsigned sp = 0; while (__hip_atomic_load(cnt, __ATOMIC_RELAXED, __HIP_MEMORY_SCOPE_AGENT) < need) { __builtin_amdgcn_s_sleep(4); if (++sp > (1u << 22)) break; }
  asm volatile("" ::: "memory"); }
struct P {
  const float *x, *attn_norm, *w_in, *w_out, *q_gain, *k_gain, *cmp_pe, *cmp_w1, *cmp_w2, *gm_ws, *gm_b, *ffn_norm, *w_gu, *w_down, *rel_bias;
  float* out; unsigned char* ws;
};

constexpr size_t MiB = 1u << 20;
constexpr size_t OFF_HB = 0;
constexpr size_t OFF_ACT = 0;
constexpr size_t OFF_MIX = 100 * MiB;
constexpr size_t OFF_GATES = 132 * MiB;
constexpr size_t OFF_KC = 134 * MiB;
constexpr size_t OFF_VC = 134 * MiB + 512 * 1024;
constexpr size_t OFF_RS = 135 * MiB;
constexpr size_t OFF_ROPE = 148 * MiB;
constexpr size_t OFF_WIN = 152 * MiB;
constexpr size_t OFF_WO = 165 * MiB;
constexpr size_t OFF_WGU = 169 * MiB;
constexpr size_t OFF_WD = 191 * MiB;
constexpr size_t OFF_XB = 204 * MiB;
constexpr size_t OFF_SSQ = 236 * MiB;
constexpr size_t OFF_SELQ = 237 * MiB;
constexpr size_t OFF_CTR = 238 * MiB;
constexpr size_t OFF_BAR = 238 * MiB + 65536;
constexpr size_t OFF_RT = 239 * MiB;
constexpr size_t OFF_W1T = 245 * MiB;
constexpr size_t OFF_C1 = 246 * MiB;
constexpr size_t OFF_WSB = 246 * MiB + 65536;
constexpr size_t OFF_W2F = 247 * MiB + 65536;
constexpr size_t OFF_BTAB = 247 * MiB;

constexpr int LDS_BYTES = 147456;

__device__ __forceinline__ float bf2f(bf16_t v) { return __uint_as_float(((unsigned)v) << 16); }
__device__ __forceinline__ bf16_t f2bf(float f) { unsigned u = __float_as_uint(f); u += 0x7fffu + ((u >> 16) & 1u); return (bf16_t)(u >> 16); }
__device__ __forceinline__ unsigned pk2(float lo, float hi) { unsigned r; asm("v_cvt_pk_bf16_f32 %0, %1, %2" : "=v"(r) : "v"(lo), "v"(hi)); return r; }
__device__ __forceinline__ float gelu_tanh(float x) { const float y = -2.3022082f * (x + 0.044715f * x * x * x); return x * __builtin_amdgcn_rcpf(1.f + __builtin_amdgcn_exp2f(y)); }
__device__ __forceinline__ float sigmoidf(float x) { return __builtin_amdgcn_rcpf(1.f + __builtin_amdgcn_exp2f(-1.4426950408889634f * x)); }
#define rsqrtf(x) __builtin_amdgcn_rsqf(x)
__device__ __forceinline__ float wave_sum(float v) {
#pragma unroll
  for (int o = 1; o < 64; o <<= 1) v += __shfl_xor(v, o);
  return v;
}
__device__ __forceinline__ float wave_max(float v) {
#pragma unroll
  for (int o = 1; o < 64; o <<= 1) v = fmaxf(v, __shfl_xor(v, o));
  return v;
}
__device__ __forceinline__ int t5_bucket(int n) {
  if (n < 16) return n;
  int b = 16;
  b += (n >= 19); b += (n >= 21); b += (n >= 24); b += (n >= 27); b += (n >= 31); b += (n >= 35); b += (n >= 40); b += (n >= 46);
  b += (n >= 52); b += (n >= 59); b += (n >= 67); b += (n >= 77); b += (n >= 87); b += (n >= 99); b += (n >= 113);
  return b;
}
#define WSYNC() do { __builtin_amdgcn_fence(__ATOMIC_RELEASE, "wavefront"); __builtin_amdgcn_wave_barrier(); __builtin_amdgcn_fence(__ATOMIC_ACQUIRE, "wavefront"); } while (0)

__device__ __forceinline__ int proj_col0(int g) { return (g < 42) ? 64 * g : 2706 + 64 * (g - 42); }
__device__ __forceinline__ float row_rstd(const float* ssq, int row, int fq) {
  const f32x4 s = *(const f32x4*)(ssq + (size_t)row * 16 + 4 * fq);
  float t = (s[0] + s[1]) + (s[2] + s[3]);
  t += __shfl_xor(t, 16); t += __shfl_xor(t, 32);
  return rsqrtf(t * (1.f / D_) + EPS);
}
struct EpiProj {
  static constexpr bool PERM = true, AFTER_DRAIN = false;
  const float* ssq; bf16_t* HB; float* gates; const float2* rope; const float* q_gain; const float* k_gain;
  template <int TYPE>
  __device__ __forceinline__ void rows(const f32x4 (&acc)[2][2][4][2], const pg8::Unit& u, int wr, int fr, int fq, int gidx, float sc, float dec_l2, const float* gn_) const {
    const float* __restrict__ ssq = this->ssq; const float2* __restrict__ rope = this->rope; const float* __restrict__ gn = gn_;
    bf16_t* __restrict__ HB = this->HB; float* __restrict__ gates = this->gates;
    float gv[2][8];
    if (TYPE == 2) {
#pragma unroll
      for (int bj = 0; bj < 2; ++bj)
#pragma unroll
        for (int i = 0; i < 8; ++i) gv[bj][i] = gn[32 * bj + 8 * fq + i] * sc;
    }
#pragma unroll
    for (int ai = 0; ai < 2; ++ai)
#pragma unroll
      for (int m = 0; m < 4; ++m) {
        const int row = u.pm * 256 + ai * 128 + wr * 64 + m * 16 + fr;
        const float rstd = row_rstd(ssq, row, fq);
        float v[2][8];
#pragma unroll
        for (int bj = 0; bj < 2; ++bj)
#pragma unroll
          for (int n = 0; n < 2; ++n)
#pragma unroll
            for (int e = 0; e < 4; ++e) v[bj][4 * n + e] = acc[ai][bj][m][n][e] * rstd;
        if (TYPE == 0) {
          const float2* tb = rope + (size_t)(row & (T_ - 1)) * 32 + 8 * fq;
          const float scr = sc * __builtin_amdgcn_exp2f((float)(row & 127) * dec_l2);
#pragma unroll
          for (int i = 0; i < 8; ++i) { const float2 cs = tb[i]; const float x1 = v[0][i], x2 = v[1][i]; v[0][i] = (x1 * cs.x - x2 * cs.y) * scr; v[1][i] = (x2 * cs.x + x1 * cs.y) * scr; }
        }
        if (TYPE == 3 || TYPE == 4) {
#pragma unroll
          for (int bj = 0; bj < 2; ++bj)
#pragma unroll
            for (int i = 0; i < 8; ++i) v[bj][i] = gelu_tanh(v[bj][i]);
        }
        if (TYPE == 2 || TYPE == 4) {
          float ss = 0.f;
#pragma unroll
          for (int bj = 0; bj < 2; ++bj)
#pragma unroll
            for (int i = 0; i < 8; ++i) ss += v[bj][i] * v[bj][i];
          ss += __shfl_xor(ss, 16); ss += __shfl_xor(ss, 32);
          const float rs = rsqrtf(ss * (1.f / 64.f) + EPS);
#pragma unroll
          for (int bj = 0; bj < 2; ++bj)
#pragma unroll
            for (int i = 0; i < 8; ++i) v[bj][i] = (TYPE == 2) ? v[bj][i] * rs * gv[bj][i] : v[bj][i] * rs;
        }
        if (TYPE == 5) {
          float* gp = gates + (size_t)row * 24 + 8 * fq;
#pragma unroll
          for (int i = 0; i < 8; ++i) if (8 * fq + i < 18) gp[i] = sigmoidf(v[0][i]);
        } else {
          bf16_t* dst = HB + ((size_t)gidx * M_ + row) * 64 + 8 * fq;
#pragma unroll
          for (int bj = 0; bj < 2; ++bj) { u32x4 w; w.x = pk2(v[bj][0], v[bj][1]); w.y = pk2(v[bj][2], v[bj][3]); w.z = pk2(v[bj][4], v[bj][5]); w.w = pk2(v[bj][6], v[bj][7]); *(u32x4*)(dst + 32 * bj) = w; }
        }
      }
  }
  __device__ __forceinline__ void operator()(const f32x4 (&acc)[2][2][4][2], const pg8::Unit& u, int wr, int wc, int fr_in, int fq_in) const {
    int fr = fr_in, fq = fq_in; asm volatile("" : "+v"(fr), "+v"(fq));
    const int gidx = u.pn * 4 + wc;
    if (gidx > 50) return;
    if (gidx < 12) { const float lg2 = log2f(1.f - exp2f(-5.f - (float)(gidx % 6))); rows<0>(acc, u, wr, fr, fq, gidx, (gidx >= 6) ? 0.125f : 1.f, (gidx >= 6) ? -lg2 : lg2, nullptr); }
    else if (gidx < 24) rows<1>(acc, u, wr, fr, fq, gidx, 1.f, 0.f, nullptr);
    else if (gidx < 30) rows<2>(acc, u, wr, fr, fq, gidx, 0.125f * 1.4426950408889634f, 0.f, q_gain);
    else if (gidx == 34 || gidx == 35) rows<2>(acc, u, wr, fr, fq, gidx, 1.f, 0.f, k_gain + 64);
    else if (gidx == 38 || gidx == 39) rows<2>(acc, u, wr, fr, fq, gidx, 1.f, 0.f, k_gain + 128);
    else if (gidx < 42) rows<1>(acc, u, wr, fr, fq, gidx, 1.f, 0.f, nullptr);
    else if (gidx < 46) rows<3>(acc, u, wr, fr, fq, gidx, 1.f, 0.f, nullptr);
    else if (gidx < 50) rows<4>(acc, u, wr, fr, fq, gidx, 1.f, 0.f, nullptr);
    else rows<5>(acc, u, wr, fr, fq, gidx, 1.f, 0.f, nullptr);
  }
};
struct EpiRes {
  static constexpr bool PERM = true, AFTER_DRAIN = false;
  const float* xin32; float* xout32; bf16_t* xb; float* ssq;
  template <bool IN32, bool OUT32>
  __device__ __forceinline__ void rows(const f32x4 (&acc)[2][2][4][2], const pg8::Unit& u, int wr, int wc, int fr, int fq) const {
#pragma unroll
    for (int ai = 0; ai < 2; ++ai)
#pragma unroll
      for (int m = 0; m < 4; ++m) {
        const int row = u.pm * 256 + ai * 128 + wr * 64 + m * 16 + fr;
        float ss = 0.f;
#pragma unroll
        for (int bj = 0; bj < 2; ++bj) {
          const size_t o = (size_t)row * D_ + u.pn * 256 + bj * 128 + wc * 32 + 8 * fq;
          f32x4 x0, x1;
          if (IN32) { x0 = *(const f32x4*)(xin32 + o); x1 = *(const f32x4*)(xin32 + o + 4); }
          else { const u32x4 w = *(const u32x4*)(xb + o); x0 = (f32x4){__uint_as_float(w.x << 16), __uint_as_float(w.x & 0xffff0000u), __uint_as_float(w.y << 16), __uint_as_float(w.y & 0xffff0000u)};
                 x1 = (f32x4){__uint_as_float(w.z << 16), __uint_as_float(w.z & 0xffff0000u), __uint_as_float(w.w << 16), __uint_as_float(w.w & 0xffff0000u)}; }
          const f32x4 y0 = x0 + acc[ai][bj][m][0], y1 = x1 + acc[ai][bj][m][1];
          if (OUT32) { *(f32x4*)(xout32 + o) = y0; *(f32x4*)(xout32 + o + 4) = y1; }
          else { u32x4 w; w.x = pk2(y0[0], y0[1]); w.y = pk2(y0[2], y0[3]); w.z = pk2(y1[0], y1[1]); w.w = pk2(y1[2], y1[3]); *(u32x4*)(xb + o) = w;
            ss += (y0[0] * y0[0] + y0[1] * y0[1]) + (y0[2] * y0[2] + y0[3] * y0[3]) + (y1[0] * y1[0] + y1[1] * y1[1]) + (y1[2] * y1[2] + y1[3] * y1[3]); }
        }
        if (!OUT32) { ss += __shfl_xor(ss, 16); ss += __shfl_xor(ss, 32);
          if (fq == 0) ssq[(size_t)row * 16 + u.pn * 4 + wc] = ss; }
      }
  }
  __device__ __forceinline__ void operator()(const f32x4 (&acc)[2][2][4][2], const pg8::Unit& u, int wr, int wc, int fr_in, int fq_in) const {
    int fr = fr_in, fq = fq_in; asm volatile("" : "+v"(fr), "+v"(fq));
    if (xin32) rows<true, false>(acc, u, wr, wc, fr, fq); else if (xout32) rows<false, true>(acc, u, wr, wc, fr, fq); else rows<false, false>(acc, u, wr, wc, fr, fq);
  }
};
struct EpiGU {
  static constexpr bool PERM = true, AFTER_DRAIN = false;
  const float* ssq; bf16_t* act;
  __device__ __forceinline__ void operator()(const f32x4 (&acc)[2][2][4][2], const pg8::Unit& u, int wr, int wc, int fr_in, int fq_in) const {
    int fr = fr_in, fq = fq_in; asm volatile("" : "+v"(fr), "+v"(fq));
    const float* __restrict__ ssq = this->ssq; bf16_t* __restrict__ act = this->act;
#pragma unroll
    for (int ai = 0; ai < 2; ++ai)
#pragma unroll
      for (int m = 0; m < 4; ++m) {
        const int row = u.pm * 256 + ai * 128 + wr * 64 + m * 16 + fr;
        const float rstd = row_rstd(ssq, row, fq);
        float a[8];
#pragma unroll
        for (int n = 0; n < 2; ++n)
#pragma unroll
          for (int e = 0; e < 4; ++e) { const float g = acc[ai][0][m][n][e] * rstd, up = acc[ai][1][m][n][e] * rstd; a[4 * n + e] = g * sigmoidf(g) * up; }
        u32x4 w; w.x = pk2(a[0], a[1]); w.y = pk2(a[2], a[3]); w.z = pk2(a[4], a[5]); w.w = pk2(a[6], a[7]);
        *(u32x4*)(act + (size_t)row * DFF + u.pn * 128 + wc * 32 + 8 * fq) = w;
      }
  }
};

__device__ __forceinline__ void transpose_item(const float* W, int K, int ldw, const float* gain, bf16_t* WT, int v0, int src0, int nvalid, int k0, LAS float* scr, int lane) {
  const int col = lane & 31;
  float wv[32];
#pragma unroll
  for (int i = 0; i < 32; ++i) { const int kk = 2 * i + (lane >> 5); wv[i] = (col < nvalid) ? W[(size_t)(k0 + kk) * ldw + src0 + col] : 0.f; }
#pragma unroll
  for (int i = 0; i < 32; ++i) { const int kk = 2 * i + (lane >> 5); scr[kk * 33 + col] = gain ? wv[i] * gain[k0 + kk] : wv[i]; }
  asm volatile("s_waitcnt lgkmcnt(0)" ::: "memory");
  const int c = lane & 7;
#pragma unroll
  for (int j = 0; j < 4; ++j) { const int n = (lane >> 3) + 8 * j; const LAS float* s = scr + (8 * c) * 33 + n;
    u32x4 o; o.x = pk2(s[0 * 33], s[1 * 33]); o.y = pk2(s[2 * 33], s[3 * 33]); o.z = pk2(s[4 * 33], s[5 * 33]); o.w = pk2(s[6 * 33], s[7 * 33]);
    *(u32x4*)(WT + (size_t)(v0 + n) * K + k0 + 8 * c) = o; }
  asm volatile("s_waitcnt lgkmcnt(0)" ::: "memory");
}
__device__ __forceinline__ void convert_weights(const P& p, LAS unsigned char* lds, int wave, int lane, int gw, int NGW, int it0, int it1) {
  LAS float* scr = (LAS float*)(lds + wave * 16384);
  for (int it = it0 + gw; it < it1; it += NGW) {
    const int layer = it / 6400; int r = it % 6400;
    if (r < 1664) {
      const int vb = r >> 4, kb = r & 15, v0 = vb * 32, pn = v0 >> 8, bj = (v0 >> 7) & 1, wc = (v0 >> 5) & 3, g = pn * 4 + wc;
      int src0 = 0, nvalid = 32;
      if (g < 50) src0 = proj_col0(g) + 32 * bj; else if (g == 50 && bj == 0) { src0 = 2688; nvalid = 18; } else nvalid = 0;
      transpose_item(p.w_in + (size_t)layer * D_ * INW, D_, INW, p.attn_norm + layer * D_, (bf16_t*)(p.ws + OFF_WIN) + (size_t)layer * NPROJ * D_, v0, src0, nvalid, kb * 64, scr, lane);
      continue;
    }
    r -= 1664;
    if (r < 512) { const int vb = r >> 4, kb = r & 15;
      transpose_item(p.w_out + (size_t)layer * D_ * D_, D_, D_, nullptr, (bf16_t*)(p.ws + OFF_WO) + (size_t)layer * D_ * D_, vb * 32, vb * 32, 32, kb * 64, scr, lane); continue; }
    r -= 512;
    if (r < 2816) { const int vb = r >> 4, kb = r & 15, v0 = vb * 32, pn = v0 >> 8, bj = (v0 >> 7) & 1, c0 = v0 & 127;
      transpose_item(p.w_gu + (size_t)layer * D_ * 2 * DFF, D_, 2 * DFF, p.ffn_norm + layer * D_, (bf16_t*)(p.ws + OFF_WGU) + (size_t)layer * 2 * DFF * D_, v0, bj * DFF + 128 * pn + c0, 32, kb * 64, scr, lane); continue; }
    r -= 2816;
    { const int vb = r / 44, kb = r % 44;
      transpose_item(p.w_down + (size_t)layer * DFF * D_, DFF, D_, nullptr, (bf16_t*)(p.ws + OFF_WD) + (size_t)layer * D_ * DFF, vb * 32, vb * 32, 32, kb * 64, scr, lane); }
  }
}
__device__ __forceinline__ void ph_prologue(const Cx& cx, const P& p, LAS unsigned char* lds) {
  const int tid = cx.tid, lane = tid & 63, wave = tid >> 6;
  LAS float* scr = (LAS float*)(lds + wave * 16384);
  const int gw = cx.bid * 8 + wave, NGW = cx.G * 8;
  convert_weights(p, lds, wave, lane, gw, NGW, 0, 1664);
  bf16_t* XB = (bf16_t*)(p.ws + OFF_XB); float* ssq = (float*)(p.ws + OFF_SSQ);
  for (int r = gw; r < M_; r += 2 * NGW) {
    const int r2 = r + NGW;
    const f32x4* xa = (const f32x4*)(p.x + (size_t)r * D_); const f32x4* xb2 = (const f32x4*)(p.x + (size_t)((r2 < M_) ? r2 : r) * D_);
    f32x4 va[4], vb[4];
#pragma unroll
    for (int j = 0; j < 4; ++j) { va[j] = xa[lane + 64 * j]; vb[j] = xb2[lane + 64 * j]; }
    float sa = 0.f, sb = 0.f;
#pragma unroll
    for (int j = 0; j < 4; ++j) { sa += (va[j][0] * va[j][0] + va[j][1] * va[j][1]) + (va[j][2] * va[j][2] + va[j][3] * va[j][3]); sb += (vb[j][0] * vb[j][0] + vb[j][1] * vb[j][1]) + (vb[j][2] * vb[j][2] + vb[j][3] * vb[j][3]);
      *(uint2*)(XB + (size_t)r * D_ + (lane + 64 * j) * 4) = make_uint2(pk2(va[j][0], va[j][1]), pk2(va[j][2], va[j][3]));
      if (r2 < M_) *(uint2*)(XB + (size_t)r2 * D_ + (lane + 64 * j) * 4) = make_uint2(pk2(vb[j][0], vb[j][1]), pk2(vb[j][2], vb[j][3])); }
    sa = wave_sum(sa); sb = wave_sum(sb);
    if (lane < 16) { ssq[(size_t)r * 16 + lane] = (lane == 0) ? sa : 0.f; if (r2 < M_) ssq[(size_t)r2 * 16 + lane] = (lane == 0) ? sb : 0.f; }
  }
  if (cx.bid == 0) for (int i = tid; i < 1024; i += NTHR) ((unsigned*)(p.ws + OFF_CTR))[i] = 0u;
  for (int it = gw; it < 256; it += NGW) { const int mj = it >> 6, vb = (it >> 5) & 1, kb = it & 31;
    transpose_item(p.cmp_w1 + (size_t)mj * 2048 * 64, 2048, 64, nullptr, (bf16_t*)(p.ws + OFF_W1T) + (size_t)mj * 64 * 2048, vb * 32, vb * 32, 32, kb * 64, scr, lane); }
  for (int it = gw; it < 256; it += NGW) { const int mj = it >> 6, f = it & 63; const float* w1 = p.cmp_w1 + (size_t)mj * 2048 * 64 + f; const float* pe = p.cmp_pe + (size_t)mj * 2048;
    float a = 0.f; for (int i = lane; i < 2048; i += 64) a += pe[i] * w1[(size_t)i * 64];
    a = wave_sum(a); if (lane == 0) ((float*)(p.ws + OFF_C1))[it] = a; }
  for (int i = cx.bid * NTHR + tid; i < 6 * 768; i += cx.G * NTHR) { const int hd = i / 768, k = i % 768; float v = 0.f;
    if (k < 115) v = (k == 0) ? -1e30f : p.rel_bias[t5_bucket(k - 1) * 6 + hd] * 1.4426950408889634f;
    else if (k >= 128 && k < 642) { const int kk = k - 128; v = (kk == 0 || kk == 513) ? -1e30f : p.rel_bias[t5_bucket(kk - 1) * 6 + hd] * 1.4426950408889634f; }
    ((float*)(p.ws + OFF_BTAB))[i] = v; }
  for (int i = cx.bid * NTHR + tid; i < 4 * 4096; i += cx.G * NTHR) {
    const int mj = i >> 12, jj = i & 7, ln = (i >> 3) & 63, s2 = (i >> 9) & 1, fb = (i >> 10) & 1, eb = (i >> 11) & 1, r32_ = ln & 31, hi_ = ln >> 5;
    ((bf16_t*)(p.ws + OFF_W2F))[i] = f2bf(p.cmp_w2[(size_t)mj * 4096 + (32 * fb + 16 * s2 + 8 * (jj >> 2) + 4 * hi_ + (jj & 3)) * 64 + 32 * eb + r32_]); }
  for (int i = cx.bid * NTHR + tid; i < 2 * 4 * 128 * 128; i += cx.G * NTHR) { const int tt = (i >> 7) & 127, ss = i & 127; ((bf16_t*)(p.ws + OFF_WSB))[i] = (ss <= tt) ? f2bf(p.gm_ws[i]) : (bf16_t)0; }
  float2* tab = (float2*)(p.ws + OFF_ROPE);
  for (int i = cx.bid * NTHR + tid; i < T_ * 32; i += cx.G * NTHR) {
    const int t = i >> 5, k = i & 31;
    const float inv = powf(10000.0f, -(float)k / 32.0f);
    const float ang = (float)t * inv;
    tab[i] = make_float2(cosf(ang), sinf(ang));
  }
}
namespace att {
using bf16x8 = __attribute__((ext_vector_type(8))) short;
using s16x4 = __attribute__((ext_vector_type(4))) short;
using f32x16 = __attribute__((ext_vector_type(16))) float;
constexpr int NW = 8, QBLK = 32, QB = 256, KVBLK = 64;
constexpr int SLOTB = 8192, LDS_K = 0, LDS_V = 3 * SLOTB, LDS_WS = 6 * SLOTB, LDS_OST = LDS_WS + NW * 256, LDS_TAB = LDS_OST + NW * 8192, LDS_SELW = LDS_TAB + 2304, LDS_END = LDS_SELW + NW * 512;
static_assert(LDS_END <= 131072, "attention LDS");
constexpr float NEGBIG = -1e30f;
#define SBAR() __builtin_amdgcn_sched_barrier(0)
#define PIN(x) asm volatile("" : "+v"(x))
#define MFMA(a, b, c) __builtin_amdgcn_mfma_f32_32x32x16_bf16(a, b, c, 0, 0, 0)
#define WAIT_BAR(N) asm volatile("s_waitcnt vmcnt(" #N ") lgkmcnt(0)\n\ts_barrier" ::: "memory")
__device__ __forceinline__ int crow(int r, int hi) { return (r & 3) + 8 * (r >> 2) + 4 * hi; }
__device__ __forceinline__ unsigned cvtpk(float lo, float hi) { unsigned r; asm("v_cvt_pk_bf16_f32 %0, %1, %2" : "=v"(r) : "v"(lo), "v"(hi)); return r; }
__device__ __forceinline__ void glds16(const void* g, unsigned lds_base) {
  unsigned sv; asm volatile("s_mov_b32 %0, m0\n\ts_mov_b32 m0, %2\n\ts_nop 0\n\tglobal_load_lds_dwordx4 %1, off\n\ts_mov_b32 m0, %0" : "=&s"(sv) : "v"(g), "s"(lds_base) : "memory"); }
typedef __attribute__((address_space(3))) const char* lds_cptr;
typedef short v4i16_t __attribute__((ext_vector_type(4)));
__device__ __forceinline__ void kload2(bf16x8* kf, lds_cptr kp, int d0) { kf[2 * d0] = *(const __attribute__((address_space(3))) bf16x8*)(kp + d0 * 2048); kf[2 * d0 + 1] = *(const __attribute__((address_space(3))) bf16x8*)(kp + d0 * 2048 + 512); }
__device__ __forceinline__ s16x4 vtr(lds_cptr p) { return __builtin_bit_cast(s16x4, __builtin_amdgcn_ds_read_tr16_b64_v4i16((__attribute__((address_space(3))) v4i16_t*)p)); }
#define MX3(a, b, c) __builtin_fmaxf(__builtin_fmaxf((a), (b)), (c))
__device__ __forceinline__ float rowmax(const f32x16& p0, const f32x16& p1) {
  float a = MX3(p0[0], p0[1], p1[0]), b = MX3(p0[2], p0[3], p1[1]); a = MX3(a, p1[2], p1[3]);
#pragma unroll
  for (int r = 4; r < 16; r += 4) { a = MX3(a, p0[r], p0[r + 1]); b = MX3(b, p0[r + 2], p0[r + 3]); a = MX3(a, p1[r], p1[r + 1]); b = MX3(b, p1[r + 2], p1[r + 3]); }
  float m = __builtin_fmaxf(a, b); auto rr = __builtin_amdgcn_permlane32_swap(__float_as_uint(m), __float_as_uint(m), false, false);
  return __builtin_fmaxf(__uint_as_float(rr[0]), __uint_as_float(rr[1])); }
template <int S, int IMAX>
__device__ __forceinline__ void bias_hook(f32x16& p0, f32x16& p1, int dl, const __attribute__((address_space(3))) float* tab) {
#pragma unroll
  for (int r = 0; r < 16; ++r) { const int c = (r & 3) + 8 * (r >> 2); const int d0 = dl - S * c, d1 = d0 - 32 * S;
    p0[r] += tab[1 + min(max(d0, -1), IMAX)]; p1[r] += tab[1 + min(max(d1, -1), IMAX)]; } }

template <int MODE>
__device__ __forceinline__ void nsa_pass(const int tid, const bf16_t* Qrows, const bf16_t* __restrict__ Kt0, const bf16_t* __restrict__ Vt0, const int NT, const int dq, const float b31,
                                         const float* gate, char* lds, const bool first, const bool preK = false, const bf16_t* __restrict__ nextK = nullptr) {
  constexpr int S = (MODE == 2) ? 16 : 1, IMAX = (MODE == 1) ? 512 : 113; constexpr float REF = 8.f;
  const int lane = tid & 63, r32 = lane & 31, hi = lane >> 5; const int wid = __builtin_amdgcn_readfirstlane(tid >> 6);
  const bf16_t* Qw = Qrows + (size_t)(wid * QBLK) * 64;
  const unsigned lds0 = (unsigned)(uintptr_t)lds; float* wsf = (float*)(lds + LDS_WS) + wid * 64;
  const __attribute__((address_space(3))) float* tab = (const __attribute__((address_space(3))) float*)(uintptr_t)(lds0 + LDS_TAB);
  const __attribute__((address_space(3))) unsigned* selw = (const __attribute__((address_space(3))) unsigned*)(uintptr_t)(lds0 + LDS_SELW + wid * 512);
  const bf16_t* ksrc = Kt0 + (size_t)lane * 64 + wid * 8;
  const bf16_t* vsrc = Vt0 + (size_t)(16 * (wid & 3) + (lane >> 2)) * 64 + (wid >> 2) * 32 + (lane & 3) * 8;
  const unsigned kdst = lds0 + LDS_K + wid * 1024, vdst = lds0 + LDS_V + wid * 1024;
#define DMA_K(t, slot) glds16(ksrc + (size_t)(t) * KVBLK * 64, (unsigned)__builtin_amdgcn_readfirstlane(kdst + (slot)))
#define DMA_V(t, slot) glds16(vsrc + (size_t)(t) * KVBLK * 64, (unsigned)__builtin_amdgcn_readfirstlane(vdst + (slot)))
  const lds_cptr vp0 = (lds_cptr)(uintptr_t)lds0 + LDS_V + ((lane >> 4) & 1) * 32 + (lane & 3) * 8 + (4 * hi + ((lane & 15) >> 2)) * 64;
  const lds_cptr kp0 = (lds_cptr)(uintptr_t)lds0 + LDS_K + hi * 1024 + r32 * 16;
  if (!preK) { DMA_K(0, 0); DMA_V(0, 0); DMA_K(1, SLOTB); } else { DMA_V(0, 0); }
  bf16x8 qr[4];
#pragma unroll
  for (int d0 = 0; d0 < 4; ++d0) qr[d0] = *reinterpret_cast<const bf16x8*>(&Qw[(size_t)r32 * 64 + d0 * 16 + hi * 8]);
  float l_reg = 0.f; f32x16 o[2]; o[0] = f32x16{}; o[1] = f32x16{};
  f32x16 zero16 = f32x16{}; PIN(zero16);
  const int qrel = wid * QBLK + r32;
  const int dlq = dq + qrel - S * 4 * hi;
  f32x16 pA0, pA1, pB0, pB1; bf16x8 kf[8]; s16x4 vlo[8], vhi[8]; u32x4 pw0, pw1, pw2, pw3;
  int sl_prev = 0, sl_cur = 0, sl_next = SLOTB;
#define ROT() do { sl_prev = sl_cur; sl_cur = sl_next; sl_next = (sl_next == 2 * SLOTB) ? 0 : sl_next + SLOTB; } while (0)
#define EX(v) __builtin_amdgcn_exp2f((v) + nmh)
#define SELBIT(t) ((MODE == 0) ? (((selw[(t)] >> r32) & 1u) != 0u) : true)
  if (!preK) { DMA_K(2, 2 * SLOTB); WAIT_BAR(3); } else { WAIT_BAR(1); }
  _Pragma("unroll") for (int d0 = 0; d0 < 4; ++d0) kload2(kf, kp0, d0);
  pA0 = MFMA(kf[0], qr[0], zero16); pA1 = MFMA(kf[1], qr[0], zero16); pA0 = MFMA(kf[2], qr[1], pA0); pA1 = MFMA(kf[3], qr[1], pA1);
  pA0 = MFMA(kf[4], qr[2], pA0); pA1 = MFMA(kf[5], qr[2], pA1); pA0 = MFMA(kf[6], qr[3], pA0); pA1 = MFMA(kf[7], qr[3], pA1);
  { const bool band0 = (MODE != 0) || (NT < 8);
    if (band0) bias_hook<S, IMAX>(pA0, pA1, dlq, tab);
    const float bc = band0 ? 0.f : b31; const bool sb = SELBIT(0);
    const float nmh = sb ? bc - REF : NEGBIG;
#pragma unroll
    for (int r = 0; r < 16; ++r) { pA0[r] = EX(pA0[r]); pA1[r] = EX(pA1[r]); } }
  WAIT_BAR(0);
  DMA_K(3, 0); DMA_V(1, SLOTB); ROT();
  _Pragma("unroll") for (int d0 = 0; d0 < 4; ++d0) kload2(kf, kp0 + sl_cur, d0);
  WAIT_BAR(2);
#define PKW(P, i) cvtpk(P[i], P[i + 1])
#define PAF(k) __builtin_bit_cast(bf16x8, pw##k)
#define VFR(i) (bf16x8){vlo[i][0], vlo[i][1], vlo[i][2], vlo[i][3], vhi[i][0], vhi[i][1], vhi[i][2], vhi[i][3]}
#define VRD(i) do { vlo[i] = vtr(vp_ + (((i) >> 2) * 4096 + ((i) & 3) * 1024)); vhi[i] = vtr(vp_ + (((i) >> 2) * 4096 + ((i) & 3) * 1024 + 512)); } while (0)
#define KRD(G, d0) do { if (G) { kload2(kf, kp0 + sl_next, d0); SBAR(); } } while (0)
#define GAPA(MF, a0, a1, a2, a3, W0, W1, PW) do { MF; sacc += a0; sacc += a1; sacc += a2; sacc += a3; W0; W1; PIN(PW); PIN(sacc); SBAR(); } while (0)
#define GAPB(MF, X, i) do { MF; X[i] = EX(X[i]); X[i + 1] = EX(X[i + 1]); X[i + 2] = EX(X[i + 2]); X[i + 3] = EX(X[i + 3]); PIN(X); SBAR(); } while (0)
#define STEP(C0, C1, P0, P1, t, MASK, GK, GV, GL) do { SBAR(); \
    const lds_cptr vp_ = vp0 + sl_prev; \
    VRD(0); SBAR(); float sacc = P0[0] + P0[1]; \
                    GAPA(C0 = MFMA(kf[0], qr[0], zero16), P0[2], P0[3], P0[4], P0[5],     pw0[0] = PKW(P0, 0),  pw0[1] = PKW(P0, 2),  pw0); \
    VRD(4); SBAR(); GAPA(C1 = MFMA(kf[1], qr[0], zero16), P0[6], P0[7], P0[8], P0[9],     pw0[2] = PKW(P0, 4),  pw0[3] = PKW(P0, 6),  pw0); \
    VRD(1); SBAR(); GAPA(C0 = MFMA(kf[2], qr[1], C0),    P0[10], P0[11], P0[12], P0[13], pw1[0] = PKW(P0, 8),  pw1[1] = PKW(P0, 10), pw1); \
    VRD(5); SBAR(); GAPA(C1 = MFMA(kf[3], qr[1], C1),    P0[14], P0[15], P1[0], P1[1],   pw1[2] = PKW(P0, 12), pw1[3] = PKW(P0, 14), pw1); \
    VRD(2); SBAR(); GAPA(C0 = MFMA(kf[4], qr[2], C0),    P1[2], P1[3], P1[4], P1[5],     pw2[0] = PKW(P1, 0),  pw2[1] = PKW(P1, 2),  pw2); \
    VRD(6); SBAR(); GAPA(C1 = MFMA(kf[5], qr[2], C1),    P1[6], P1[7], P1[8], P1[9],     pw2[2] = PKW(P1, 4),  pw2[3] = PKW(P1, 6),  pw2); \
    VRD(3); SBAR(); GAPA(C0 = MFMA(kf[6], qr[3], C0),    P1[10], P1[11], P1[12], P1[13], pw3[0] = PKW(P1, 8),  pw3[1] = PKW(P1, 10), pw3); \
    VRD(7); SBAR(); GAPA(C1 = MFMA(kf[7], qr[3], C1),    P1[14], P1[15], 0.f, 0.f,       pw3[2] = PKW(P1, 12), pw3[3] = PKW(P1, 14), pw3); \
    l_reg += sacc; \
    if (GK) DMA_K((t) + 3, sl_cur); if (GV) DMA_V((t) + 1, sl_next); \
    if (MASK) bias_hook<S, IMAX>(C0, C1, dlq - S * 64 * (t), tab); \
    const float bc_ = (MASK) ? 0.f : b31; const bool sb_ = SELBIT(t); \
    const float nmh = sb_ ? bc_ - REF : NEGBIG; SBAR(); \
    GAPB(o[0] = MFMA(PAF(0), VFR(0), o[0]), C0, 0);              GAPB(o[1] = MFMA(PAF(0), VFR(4), o[1]), C0, 4); \
    KRD(GL, 0); GAPB(o[0] = MFMA(PAF(1), VFR(1), o[0]), C0, 8);  KRD(GL, 1); GAPB(o[1] = MFMA(PAF(1), VFR(5), o[1]), C0, 12); \
    KRD(GL, 2); GAPB(o[0] = MFMA(PAF(2), VFR(2), o[0]), C1, 0);  KRD(GL, 3); GAPB(o[1] = MFMA(PAF(2), VFR(6), o[1]), C1, 4); \
    GAPB(o[0] = MFMA(PAF(3), VFR(3), o[0]), C1, 8);              GAPB(o[1] = MFMA(PAF(3), VFR(7), o[1]), C1, 12); \
    } while (0)
  int t = 1;
  if (MODE == 0) {
    for (; t + 7 < NT; t += 2) {
      STEP(pB0, pB1, pA0, pA1, t, false, true, true, true);     WAIT_BAR(2); ROT();
      STEP(pA0, pA1, pB0, pB1, t + 1, false, true, true, true); WAIT_BAR(2); ROT();
    }
  }
#define ENDW(tt) do { if ((tt) + 3 < NT) { WAIT_BAR(2); } else if ((tt) + 2 < NT) { WAIT_BAR(1); } else { WAIT_BAR(0); } } while (0)
  for (; t + 1 < NT; t += 2) {
    STEP(pB0, pB1, pA0, pA1, t, true, (t + 3 < NT), (t + 1 < NT), (t + 1 < NT));         ENDW(t);     ROT();
    STEP(pA0, pA1, pB0, pB1, t + 1, true, (t + 4 < NT), (t + 2 < NT), (t + 2 < NT));     ENDW(t + 1); ROT();
  }
  if (nextK) { const bf16_t* nk = nextK + (size_t)lane * 64 + wid * 8;
    glds16(nk, (unsigned)__builtin_amdgcn_readfirstlane(kdst)); glds16(nk + 4096, (unsigned)__builtin_amdgcn_readfirstlane(kdst + SLOTB)); glds16(nk + 8192, (unsigned)__builtin_amdgcn_readfirstlane(kdst + 2 * SLOTB)); }
  STEP(pB0, pB1, pA0, pA1, NT - 1, true, false, false, false);
  { float sacc = pB0[0] + pB0[1];
#pragma unroll
    for (int r = 2; r < 16; ++r) sacc += pB0[r];
#pragma unroll
    for (int r = 0; r < 16; ++r) sacc += pB1[r];
    l_reg += sacc;
    pw0 = (u32x4){PKW(pB0, 0), PKW(pB0, 2), PKW(pB0, 4), PKW(pB0, 6)}; pw1 = (u32x4){PKW(pB0, 8), PKW(pB0, 10), PKW(pB0, 12), PKW(pB0, 14)};
    pw2 = (u32x4){PKW(pB1, 0), PKW(pB1, 2), PKW(pB1, 4), PKW(pB1, 6)}; pw3 = (u32x4){PKW(pB1, 8), PKW(pB1, 10), PKW(pB1, 12), PKW(pB1, 14)};
    const lds_cptr vp_ = vp0 + sl_cur; _Pragma("unroll") for (int i = 0; i < 8; ++i) VRD(i);
    o[0] = MFMA(PAF(0), VFR(0), o[0]); o[1] = MFMA(PAF(0), VFR(4), o[1]); o[0] = MFMA(PAF(1), VFR(1), o[0]); o[1] = MFMA(PAF(1), VFR(5), o[1]);
    o[0] = MFMA(PAF(2), VFR(2), o[0]); o[1] = MFMA(PAF(2), VFR(6), o[1]); o[0] = MFMA(PAF(3), VFR(3), o[0]); o[1] = MFMA(PAF(3), VFR(7), o[1]); }
  { auto rr = __builtin_amdgcn_permlane32_swap(__float_as_uint(l_reg), __float_as_uint(l_reg), false, false); l_reg = __uint_as_float(rr[0]) + __uint_as_float(rr[1]); }
  if (hi == 0) wsf[32 + r32] = (l_reg > 0.f) ? gate[(size_t)qrel * 24] / l_reg : 0.f;
  asm volatile("s_waitcnt lgkmcnt(0)" ::: "memory");
  float rli[16];
#pragma unroll
  for (int r = 0; r < 16; ++r) rli[r] = wsf[32 + crow(r, hi)];
  float* stg = (float*)(lds + LDS_OST) + wid * 2048;
  if (first) {
#pragma unroll
    for (int r = 0; r < 16; ++r) { const int orow = crow(r, hi);
#pragma unroll
      for (int d0 = 0; d0 < 2; ++d0) stg[orow * 64 + d0 * 32 + r32] = o[d0][r] * rli[r]; }
  } else {
#pragma unroll
    for (int r = 0; r < 16; ++r) { const int orow = crow(r, hi);
#pragma unroll
      for (int d0 = 0; d0 < 2; ++d0) stg[orow * 64 + d0 * 32 + r32] += o[d0][r] * rli[r]; }
  }
  asm volatile("s_waitcnt lgkmcnt(0)\n\ts_barrier" ::: "memory");
#undef DMA_K
#undef DMA_V
#undef ROT
#undef EX
#undef SELBIT
#undef PKW
#undef PAF
#undef VFR
#undef VRD
#undef KRD
#undef ENDW
#undef GAPA
#undef GAPB
#undef STEP
}
#undef SBAR
#undef PIN
#undef MFMA
#undef WAIT_BAR
#undef MX3
}

#define L2E 1.4426950408889634f
__device__ __forceinline__ void topk_unit(const Cx& cx, const P& p, int layer, int u, char* lds) {
  using att::bf16x8; using att::f32x16;
  const int tid = cx.tid, lane = tid & 63, r32 = lane & 31, hi = lane >> 5, wid = cx.wv, grp = wid & 3, half = wid >> 2;
  const int qb = 63 - (u >> 2), bg = u & 3, b = bg >> 1, g = bg & 1, q0 = qb * 128;
  const int ntile64 = ((((q0 + 127) >> 4) + 1) + 63) >> 6;
  if (tid == 0) hand_wait((unsigned*)(p.ws + OFF_CTR) + 512 + layer * 64 + bg * 16, 16u);
  __syncthreads();
  const bf16_t* KCb = (const bf16_t*)(p.ws + OFF_KC) + (size_t)bg * 512 * 64;
  const unsigned lds0 = (unsigned)(uintptr_t)lds;
  constexpr int L_IMP = 65536, L_LSUM = 131072 + 1024, L_TAB = 139264;
  for (int i = tid; i < ntile64 * 512; i += NTHR) { const int n = i >> 3, c = i & 7; const unsigned long long* q8 = (const unsigned long long*)(KCb + (size_t)n * 64 + c * 8);
    const unsigned long long a = __hip_atomic_load(q8, __ATOMIC_RELAXED, __HIP_MEMORY_SCOPE_AGENT), b2 = __hip_atomic_load(q8 + 1, __ATOMIC_RELAXED, __HIP_MEMORY_SCOPE_AGENT);
    *(u32x4*)(lds + (n >> 6) * 8192 + c * 1024 + (n & 63) * 16) = (u32x4){(unsigned)a, (unsigned)(a >> 32), (unsigned)b2, (unsigned)(b2 >> 32)}; }
  float* tabw = (float*)(lds + L_TAB);
  for (int i = tid; i < 3 * 115; i += NTHR) { const int h = i / 115, k = i % 115; tabw[i] = ((const float*)(p.ws + OFF_BTAB))[(g * 3 + h) * 768 + k]; }
  float* impw = (float*)(lds + L_IMP) + wid * 2048;
#pragma unroll
  for (int s2 = 0; s2 < 32; ++s2) impw[s2 * 64 + lane] = 0.f;
  __syncthreads();
  const __attribute__((address_space(3))) float* tab = (const __attribute__((address_space(3))) float*)(uintptr_t)(lds0 + L_TAB);
  const att::lds_cptr kp0 = (att::lds_cptr)(uintptr_t)lds0 + hi * 1024 + r32 * 16;
  const int tq0 = q0 + grp * 32, t = tq0 + r32, cur = tq0 >> 6;
  const int NT32 = ((tq0 >> 4) + 1 + 31) >> 5;
  const int Th = (NT32 + 1) >> 1, T0 = half ? Th : 0, T1 = half ? NT32 : Th;
  const int nfar = (tq0 - 144) >> 4;
  const int Tnear0 = (nfar >= 31) ? ((nfar - 31) >> 5) + 1 : 0;
  const bf16_t* HB = (const bf16_t*)(p.ws + OFF_HB);
  float b31[3];
#pragma unroll
  for (int h = 0; h < 3; ++h) b31[h] = p.rel_bias[31 * 6 + g * 3 + h] * L2E;
  const int dl0 = t - 31 - 64 * hi;
  f32x16 zero16 = f32x16{}; asm volatile("" : "+v"(zero16));
#define TK_SCORES(T, h, sv) do { const att::lds_cptr kp_ = kp0 + ((T) >> 1) * 8192 + ((T) & 1) * 512; \
    const bf16x8 k0_ = *(const __attribute__((address_space(3))) bf16x8*)(kp_), k1_ = *(const __attribute__((address_space(3))) bf16x8*)(kp_ + 2048), \
                 k2_ = *(const __attribute__((address_space(3))) bf16x8*)(kp_ + 4096), k3_ = *(const __attribute__((address_space(3))) bf16x8*)(kp_ + 6144); \
    sv = __builtin_amdgcn_mfma_f32_32x32x16_bf16(k0_, qr[0], zero16, 0, 0, 0); sv = __builtin_amdgcn_mfma_f32_32x32x16_bf16(k1_, qr[1], sv, 0, 0, 0); \
    sv = __builtin_amdgcn_mfma_f32_32x32x16_bf16(k2_, qr[2], sv, 0, 0, 0); sv = __builtin_amdgcn_mfma_f32_32x32x16_bf16(k3_, qr[3], sv, 0, 0, 0); \
    if ((T) >= Tnear0) { const int dl_ = dl0 - 512 * (T); _Pragma("unroll") for (int r = 0; r < 16; ++r) { const int c_ = (r & 3) + 8 * (r >> 2); sv[r] = __builtin_amdgcn_exp2f(sv[r] + tab[(h) * 115 + 1 + min(max(dl_ - 16 * c_, -1), 113)]); } } \
    else { _Pragma("unroll") for (int r = 0; r < 16; ++r) sv[r] = __builtin_amdgcn_exp2f(sv[r] + b31[h]); } } while (0)
  float U[3][32]; float l[3];
#pragma unroll
  for (int h = 0; h < 3; ++h) {
    const bf16_t* Qh = HB + ((size_t)(24 + g * 3 + h) * M_ + (size_t)b * T_ + tq0) * 64;
    bf16x8 qr[4];
#pragma unroll
    for (int d0 = 0; d0 < 4; ++d0) qr[d0] = *reinterpret_cast<const bf16x8*>(Qh + (size_t)r32 * 64 + d0 * 16 + hi * 8);
    float lh = 0.f, carry = 0.f;
    if (half == 1 && T0 < T1) { f32x16 sv; TK_SCORES(T0 - 1, h, sv); carry = __shfl_xor(sv[15], 32); }
#define TK_FINISH(tt_, sv_) do { float body[4], pt[4], a_ = 0.f; \
        _Pragma("unroll") for (int g4 = 0; g4 < 4; ++g4) { const float s3 = (sv_[4 * g4] + sv_[4 * g4 + 1]) + sv_[4 * g4 + 2]; body[g4] = 2.f * s3 + sv_[4 * g4 + 3]; a_ += s3 + sv_[4 * g4 + 3]; } \
        lh += a_; \
        _Pragma("unroll") for (int k = 0; k < 4; ++k) pt[k] = __shfl_xor(sv_[4 * k + 3], 32); \
        U[h][(tt_) * 4 + 0] = body[0] + (hi ? pt[0] : carry); U[h][(tt_) * 4 + 1] = body[1] + (hi ? pt[1] : pt[0]); \
        U[h][(tt_) * 4 + 2] = body[2] + (hi ? pt[2] : pt[1]); U[h][(tt_) * 4 + 3] = body[3] + (hi ? pt[3] : pt[2]); \
        carry = pt[3]; } while (0)
#pragma unroll
    for (int tp = 0; tp < 4; ++tp) {
      const int T = T0 + 2 * tp;
      if (T + 1 < T1 && T + 1 < Tnear0) {
        const att::lds_cptr ka_ = kp0 + (T >> 1) * 8192 + (T & 1) * 512, kb_ = kp0 + ((T + 1) >> 1) * 8192 + ((T + 1) & 1) * 512;
        f32x16 sa, sb;
        { const bf16x8 a0 = *(const __attribute__((address_space(3))) bf16x8*)(ka_), a1 = *(const __attribute__((address_space(3))) bf16x8*)(ka_ + 2048), a2 = *(const __attribute__((address_space(3))) bf16x8*)(ka_ + 4096), a3 = *(const __attribute__((address_space(3))) bf16x8*)(ka_ + 6144);
          const bf16x8 b0 = *(const __attribute__((address_space(3))) bf16x8*)(kb_), b1 = *(const __attribute__((address_space(3))) bf16x8*)(kb_ + 2048), b2 = *(const __attribute__((address_space(3))) bf16x8*)(kb_ + 4096), b3 = *(const __attribute__((address_space(3))) bf16x8*)(kb_ + 6144);
          sa = __builtin_amdgcn_mfma_f32_32x32x16_bf16(a0, qr[0], zero16, 0, 0, 0); sb = __builtin_amdgcn_mfma_f32_32x32x16_bf16(b0, qr[0], zero16, 0, 0, 0);
          sa = __builtin_amdgcn_mfma_f32_32x32x16_bf16(a1, qr[1], sa, 0, 0, 0);     sb = __builtin_amdgcn_mfma_f32_32x32x16_bf16(b1, qr[1], sb, 0, 0, 0);
          sa = __builtin_amdgcn_mfma_f32_32x32x16_bf16(a2, qr[2], sa, 0, 0, 0);     sb = __builtin_amdgcn_mfma_f32_32x32x16_bf16(b2, qr[2], sb, 0, 0, 0);
          sa = __builtin_amdgcn_mfma_f32_32x32x16_bf16(a3, qr[3], sa, 0, 0, 0);     sb = __builtin_amdgcn_mfma_f32_32x32x16_bf16(b3, qr[3], sb, 0, 0, 0); }
#pragma unroll
        for (int r = 0; r < 16; ++r) { sa[r] = __builtin_amdgcn_exp2f(sa[r] + b31[h]); sb[r] = __builtin_amdgcn_exp2f(sb[r] + b31[h]); }
        TK_FINISH(2 * tp, sa); TK_FINISH(2 * tp + 1, sb);
      } else {
        if (T < T1) { f32x16 sv; TK_SCORES(T, h, sv); TK_FINISH(2 * tp, sv); }
        else { U[h][tp * 8 + 0] = 0.f; U[h][tp * 8 + 1] = 0.f; U[h][tp * 8 + 2] = 0.f; U[h][tp * 8 + 3] = 0.f; }
        if (T + 1 < T1) { f32x16 sv; TK_SCORES(T + 1, h, sv); TK_FINISH(2 * tp + 1, sv); }
        else { U[h][tp * 8 + 4] = 0.f; U[h][tp * 8 + 5] = 0.f; U[h][tp * 8 + 6] = 0.f; U[h][tp * 8 + 7] = 0.f; }
      }
    }
#undef TK_FINISH
    l[h] = lh;
  }
  { float* ls = (float*)(lds + L_LSUM);
#pragma unroll
    for (int h = 0; h < 3; ++h) ls[((grp * 2 + half) * 3 + h) * 64 + lane] = l[h]; }
  __syncthreads();
  { const float* ls = (const float*)(lds + L_LSUM); float rl[3];
#pragma unroll
    for (int h = 0; h < 3; ++h) { float lt = ls[((grp * 2 + 0) * 3 + h) * 64 + lane] + ls[((grp * 2 + 1) * 3 + h) * 64 + lane]; lt += __shfl_xor(lt, 32); rl[h] = (lt > 0.f) ? 1.f / lt : 0.f; }
#pragma unroll
    for (int i = 0; i < 32; ++i) impw[i * 64 + lane] = (U[0][i] * rl[0] + U[1][i] * rl[1]) + U[2][i] * rl[2]; }
#undef TK_SCORES
  __syncthreads();
  {
    const int qq = 16 * half + (lane & 15), part = lane >> 4, srcw = part >> 1, shi = part & 1;
    const float* ip = (const float*)(lds + L_IMP) + (grp + 4 * srcw) * 2048 + qq + 32 * shi;
    const int tbase = srcw ? Th : 0;
    unsigned v[32];
#pragma unroll
    for (int i = 0; i < 32; ++i) { const int j = 8 * (tbase + (i >> 2)) + 2 * (i & 3) + shi; v[i] = (j >= 1 && j <= cur - 2) ? __float_as_uint(ip[i * 64]) : 0u; }
    unsigned tau = 0u;
    if (cur >= 16) {
      unsigned thr = 0x7fffffffu;
#pragma unroll 1
      for (int rnd = 0; rnd < 13; ++rnd) {
        unsigned m0 = 0u, m1 = 0u, m2 = 0u, m3 = 0u;
#pragma unroll
        for (int i = 0; i < 32; i += 4) { m0 = max(m0, (v[i] < thr) ? v[i] : 0u); m1 = max(m1, (v[i + 1] < thr) ? v[i + 1] : 0u); m2 = max(m2, (v[i + 2] < thr) ? v[i + 2] : 0u); m3 = max(m3, (v[i + 3] < thr) ? v[i + 3] : 0u); }
        unsigned m = max(max(m0, m1), max(m2, m3));
        m = max(m, (unsigned)__shfl_xor((int)m, 16)); m = max(m, (unsigned)__shfl_xor((int)m, 32));
        thr = m;
      }
      tau = thr;
    }
    unsigned w0 = 0u, w1 = 0u, w2 = 0u, w3 = 0u;
#pragma unroll
    for (int i = 0; i < 32; ++i) { const int j = 8 * (tbase + (i >> 2)) + 2 * (i & 3) + shi;
      const bool ok = (j >= 1 && j <= cur - 2) && (v[i] >= tau); const unsigned m = ok ? (1u << (j & 31)) : 0u; const int wq = j >> 5;
      w0 |= (wq == 0) ? m : 0u; w1 |= (wq == 1) ? m : 0u; w2 |= (wq == 2) ? m : 0u; w3 |= (wq == 3) ? m : 0u; }
    w0 |= (unsigned)__shfl_xor((int)w0, 16); w1 |= (unsigned)__shfl_xor((int)w1, 16); w2 |= (unsigned)__shfl_xor((int)w2, 16); w3 |= (unsigned)__shfl_xor((int)w3, 16);
    w0 |= (unsigned)__shfl_xor((int)w0, 32); w1 |= (unsigned)__shfl_xor((int)w1, 32); w2 |= (unsigned)__shfl_xor((int)w2, 32); w3 |= (unsigned)__shfl_xor((int)w3, 32);
#pragma unroll
    for (int f = 0; f < 3; ++f) { const int jf = (f == 0) ? 0 : (f == 1) ? cur - 1 : cur; if (jf >= 0) { const unsigned m = 1u << (jf & 31); const int wq = jf >> 5;
        w0 |= (wq == 0) ? m : 0u; w1 |= (wq == 1) ? m : 0u; w2 |= (wq == 2) ? m : 0u; w3 |= (wq == 3) ? m : 0u; } }
    if (part == 0) *(uint4*)((unsigned*)(p.ws + OFF_SELQ) + ((size_t)bg * T_ + tq0 + qq) * 4) = make_uint4(w0, w1, w2, w3);
  }
  __syncthreads();
}
__device__ __forceinline__ void nsa_unit(const Cx& cx, const P& p, int u, char* lds) {
  const int tid = cx.tid, lane = tid & 63, r32 = lane & 31, wid = tid >> 6;
  const int qb = 31 - u / 12, bgh = u % 12, b = bgh / 6, g = (bgh / 3) & 1, h = bgh % 3, head = g * 3 + h;
  const size_t rowb = (size_t)b * T_; const int q0 = qb * 256;
  const bf16_t* HB = (const bf16_t*)(p.ws + OFF_HB);
  const bf16_t* Qrows = HB + ((size_t)(24 + head) * M_ + rowb + q0) * 64;
  const float* gate0 = (const float*)(p.ws + OFF_GATES) + (rowb + q0) * 24 + head * 3;
  float* tabw = (float*)(lds + att::LDS_TAB);
  const float b31 = p.rel_bias[31 * 6 + head] * L2E;
  { const uint4 mq = *(const uint4*)((const unsigned*)(p.ws + OFF_SELQ) + ((size_t)(b * 2 + g) * T_ + q0 + wid * 32 + r32) * 4);
    unsigned* sw = (unsigned*)(lds + att::LDS_SELW) + wid * 128;
    const int nblk = 4 * qb + 4;
#pragma unroll
    for (int w4 = 0; w4 < 4; ++w4) { const unsigned w = (w4 == 0) ? mq.x : (w4 == 1) ? mq.y : (w4 == 2) ? mq.z : mq.w;
      if (32 * w4 < nblk) { for (int j = 0; j < 32; ++j) { const unsigned long long bal = __ballot((w >> j) & 1u); if (lane == 0) sw[32 * w4 + j] = (unsigned)bal; } } } }
  const float* btab = (const float*)(p.ws + OFF_BTAB) + head * 768;
  if (tid < 115) tabw[tid] = btab[tid];
  const int t0w = (qb >= 2) ? 4 * qb - 8 : 0;
  const bf16_t* Kwin = HB + ((size_t)(38 + g) * M_ + rowb + 64 * t0w) * 64; const bf16_t* Kcmp = (const bf16_t*)(p.ws + OFF_KC) + (size_t)(b * 2 + g) * 512 * 64;
  att::nsa_pass<0>(tid, Qrows, HB + ((size_t)(34 + g) * M_ + rowb) * 64, HB + ((size_t)(36 + g) * M_ + rowb) * 64, 4 * qb + 4, q0, b31, gate0 + 1, lds, true, false, Kwin);
  for (int i = tid; i < 514; i += NTHR) tabw[i] = btab[128 + i];
  { const int t0 = (qb >= 2) ? 4 * qb - 8 : 0;
    att::nsa_pass<1>(tid, Qrows, HB + ((size_t)(38 + g) * M_ + rowb + 64 * t0) * 64, HB + ((size_t)(40 + g) * M_ + rowb + 64 * t0) * 64, 4 * qb + 4 - t0, q0 - 64 * t0, b31, gate0 + 2, lds, false, true, Kcmp); }
  if (tid < 115) tabw[tid] = btab[tid];
  { const int nt = (qb < 16) ? 4 : (qb < 24) ? 6 : 8;
    att::nsa_pass<2>(tid, Qrows, (const bf16_t*)(p.ws + OFF_KC) + (size_t)(b * 2 + g) * 512 * 64, (const bf16_t*)(p.ws + OFF_VC) + (size_t)(b * 2 + g) * 512 * 64, nt, q0 - 31, b31, gate0, lds, false, true, nullptr); }
  { const float* stg = (const float*)(lds + att::LDS_OST) + wid * 2048;
    bf16_t* mixw = (bf16_t*)(p.ws + OFF_MIX) + (rowb + q0 + wid * 32) * D_ + 384 + head * 64;
#pragma unroll
    for (int i = 0; i < 4; ++i) { const int row = i * 8 + (lane >> 3), ch = lane & 7;
      const f32x4 a0 = *(const f32x4*)(stg + row * 64 + ch * 8), a1 = *(const f32x4*)(stg + row * 64 + ch * 8 + 4);
      u32x4 w; w.x = pk2(a0[0], a0[1]); w.y = pk2(a0[2], a0[3]); w.z = pk2(a1[0], a1[1]); w.w = pk2(a1[2], a1[3]);
      *(u32x4*)(mixw + (size_t)row * D_ + ch * 8) = w; }
    asm volatile("s_waitcnt lgkmcnt(0)\n\ts_barrier" ::: "memory"); }
}
namespace mx {
using att::bf16x8; using att::s16x4; using att::f32x16; using att::lds_cptr;
#define MX_MFMA(a, b, c) __builtin_amdgcn_mfma_f32_32x32x16_bf16(a, b, c, 0, 0, 0)
__device__ __forceinline__ void dma_k_tile(const bf16_t* src, unsigned ldsaddr, int lane, int wid) { att::glds16(src + (size_t)lane * 64 + wid * 8, (unsigned)__builtin_amdgcn_readfirstlane(ldsaddr + wid * 1024)); }
__device__ __forceinline__ void dma_v_tile(const bf16_t* src, unsigned ldsaddr, int lane, int wid) { att::glds16(src + (size_t)(16 * (wid & 3) + (lane >> 2)) * 64 + (wid >> 2) * 32 + (lane & 3) * 8, (unsigned)__builtin_amdgcn_readfirstlane(ldsaddr + wid * 1024)); }
__device__ __forceinline__ int vlane_off(int lane) { return ((lane >> 4) & 1) * 32 + (lane & 3) * 8 + (4 * (lane >> 5) + ((lane & 15) >> 2)) * 64; }
__device__ __forceinline__ bf16x8 vfrag(lds_cptr vp, int i) { const s16x4 lo = att::vtr(vp + (i >> 2) * 4096 + (i & 3) * 1024), hi = att::vtr(vp + (i >> 2) * 4096 + (i & 3) * 1024 + 512);
  return (bf16x8){lo[0], lo[1], lo[2], lo[3], hi[0], hi[1], hi[2], hi[3]}; }
__device__ __forceinline__ bf16x8 kfrag(lds_cptr kp, int d0, int n) { return *(const __attribute__((address_space(3))) bf16x8*)(kp + d0 * 2048 + n * 512); }
#define MX_WAIT_ALL() asm volatile("s_waitcnt vmcnt(0) lgkmcnt(0)\n\ts_barrier" ::: "memory")
__device__ __forceinline__ float loggamma2(int h) { return log2f(1.f - exp2f(-5.f - (float)h)); }

__device__ __forceinline__ void ret_kv_unit(const Cx& cx, const P& p, int layer, int u, char* lds) {
  const int tid = cx.tid, lane = tid & 63, r32 = lane & 31, hi = lane >> 5, wid = cx.wv;
  const int bh = u >> 5, cp = u & 31, b = bh / 6, h = bh % 6;
  const size_t r0 = (size_t)b * T_ + cp * 256;
  const bf16_t* HB = (const bf16_t*)(p.ws + OFF_HB);
  const bf16_t* Kp = HB + ((size_t)(6 + h) * M_ + r0) * 64; const bf16_t* Vp = HB + ((size_t)(12 + h) * M_ + r0) * 64;
  const unsigned lds0 = (unsigned)(uintptr_t)lds;
#pragma unroll
  for (int i = 0; i < 4; ++i) { dma_v_tile(Vp + (size_t)i * 4096, lds0 + i * 8192, lane, wid); dma_v_tile(Kp + (size_t)i * 4096, lds0 + 32768 + i * 8192, lane, wid); }
  MX_WAIT_ALL();
  const int ch = wid >> 2, eb = (wid >> 1) & 1, db = wid & 1;
  f32x16 acc = f32x16{};
#pragma unroll
  for (int kt = 0; kt < 2; ++kt) { const lds_cptr vv = (lds_cptr)(uintptr_t)(lds0 + (ch * 2 + kt) * 8192) + vlane_off(lane), vk = vv + 32768;
#pragma unroll
    for (int ks = 0; ks < 4; ++ks) acc = MX_MFMA(vfrag(vv, 4 * eb + ks), vfrag(vk, 4 * db + ks), acc); }
  const float sc = exp2f(127.f * loggamma2(h));
  float* ST = (float*)(p.ws + OFF_RS) + ((size_t)bh * 64 + cp * 2 + ch) * 4096;
#pragma unroll
  for (int r = 0; r < 16; ++r) __hip_atomic_store(ST + (32 * eb + att::crow(r, hi)) * 64 + 32 * db + r32, acc[r] * sc, __ATOMIC_RELAXED, __HIP_MEMORY_SCOPE_AGENT);
  MX_WAIT_ALL();
  if (tid == 0) hand_publish((unsigned*)(p.ws + OFF_CTR) + 768 + layer * 64);
}
__device__ __forceinline__ void ret_scan(const Cx& cx, const P& p) {
  const float* __restrict__ ST = (const float*)(p.ws + OFF_RS); bf16_t* __restrict__ RT = (bf16_t*)(p.ws + OFF_RT);
  for (int i = cx.bid * NTHR + cx.tid; i < 12 * 4096; i += cx.G * NTHR) {
    const int bh = i >> 12, ed = i & 4095, h = bh % 6; const float lg = loggamma2(h), cd = exp2f(128.f * lg), g1 = exp2f(lg);
    const size_t o0 = (size_t)bh * 64 * 4096 + ed;
    float R = 0.f;
#pragma unroll
    for (int c0 = 0; c0 < 64; c0 += 16) {
      float kv[16];
#pragma unroll
      for (int k = 0; k < 16; ++k) kv[k] = __hip_atomic_load(ST + o0 + (size_t)(c0 + k) * 4096, __ATOMIC_RELAXED, __HIP_MEMORY_SCOPE_AGENT);
#pragma unroll
      for (int k = 0; k < 16; ++k) { RT[o0 + (size_t)(c0 + k) * 4096] = f2bf(R * g1); R = cd * R + kv[k]; }
    }
  }
}
__device__ __forceinline__ void ret_out_unit(const Cx& cx, const P& p, int u, char* lds) {
  const int tid = cx.tid, lane = tid & 63, r32 = lane & 31, hi = lane >> 5, wid = cx.wv;
  const int bh = u >> 5, cp = u & 31, b = bh / 6, h = bh % 6;
  const size_t r0 = (size_t)b * T_ + cp * 256;
  const bf16_t* HB = (const bf16_t*)(p.ws + OFF_HB);
  const bf16_t* Qp = HB + ((size_t)(0 + h) * M_ + r0) * 64; const bf16_t* Kp = HB + ((size_t)(6 + h) * M_ + r0) * 64;
  const bf16_t* Vp = HB + ((size_t)(12 + h) * M_ + r0) * 64; const bf16_t* Gp = HB + ((size_t)(18 + h) * M_ + r0) * 64;
  const unsigned lds0 = (unsigned)(uintptr_t)lds;
#pragma unroll
  for (int i = 0; i < 4; ++i) { dma_k_tile(Kp + (size_t)i * 4096, lds0 + i * 8192, lane, wid); dma_v_tile(Vp + (size_t)i * 4096, lds0 + 32768 + i * 8192, lane, wid); }
  const int ch = wid >> 2, rt = wid & 3, rw = ch * 128 + rt * 32;
  bf16x8 qr[4], rtf[2][4];
  const bf16_t* RT = (const bf16_t*)(p.ws + OFF_RT) + ((size_t)bh * 64 + cp * 2 + ch) * 4096;
#pragma unroll
  for (int d0 = 0; d0 < 4; ++d0) qr[d0] = *reinterpret_cast<const bf16x8*>(Qp + (size_t)(rw + r32) * 64 + d0 * 16 + hi * 8);
#pragma unroll
  for (int eb = 0; eb < 2; ++eb)
#pragma unroll
    for (int ks = 0; ks < 4; ++ks) rtf[eb][ks] = *reinterpret_cast<const bf16x8*>(RT + (size_t)(32 * eb + r32) * 64 + 16 * ks + 8 * hi);
  u32x4 gwv[4];
#pragma unroll
  for (int i = 0; i < 4; ++i) gwv[i] = *(const u32x4*)(Gp + (size_t)(rw + i * 8 + (lane >> 3)) * 64 + (lane & 7) * 8);
  MX_WAIT_ALL();
  f32x16 o[2]; o[0] = f32x16{}; o[1] = f32x16{};
  const f32x16 zero16 = f32x16{};
  const int n = rt * 32 + r32;
  for (int kt = 0; kt <= (rt >> 1); ++kt) {
    const int tile = ch * 2 + kt;
    const lds_cptr kp = (lds_cptr)(uintptr_t)(lds0 + tile * 8192) + hi * 1024 + r32 * 16;
    f32x16 p0 = MX_MFMA(kfrag(kp, 0, 0), qr[0], zero16), p1 = MX_MFMA(kfrag(kp, 0, 1), qr[0], zero16);
#pragma unroll
    for (int d0 = 1; d0 < 4; ++d0) { p0 = MX_MFMA(kfrag(kp, d0, 0), qr[d0], p0); p1 = MX_MFMA(kfrag(kp, d0, 1), qr[d0], p1); }
    if (kt == (rt >> 1)) {
#pragma unroll
      for (int r = 0; r < 16; ++r) { const int m = 64 * kt + att::crow(r, hi); if (m > n) p0[r] = 0.f; if (m + 32 > n) p1[r] = 0.f; }
    }
    u32x4 pw0, pw1, pw2, pw3;
    pw0 = (u32x4){att::cvtpk(p0[0], p0[1]), att::cvtpk(p0[2], p0[3]), att::cvtpk(p0[4], p0[5]), att::cvtpk(p0[6], p0[7])};
    pw1 = (u32x4){att::cvtpk(p0[8], p0[9]), att::cvtpk(p0[10], p0[11]), att::cvtpk(p0[12], p0[13]), att::cvtpk(p0[14], p0[15])};
    pw2 = (u32x4){att::cvtpk(p1[0], p1[1]), att::cvtpk(p1[2], p1[3]), att::cvtpk(p1[4], p1[5]), att::cvtpk(p1[6], p1[7])};
    pw3 = (u32x4){att::cvtpk(p1[8], p1[9]), att::cvtpk(p1[10], p1[11]), att::cvtpk(p1[12], p1[13]), att::cvtpk(p1[14], p1[15])};
    const lds_cptr vp = (lds_cptr)(uintptr_t)(lds0 + 32768 + tile * 8192) + vlane_off(lane);
#pragma unroll
    for (int d0 = 0; d0 < 2; ++d0) {
      o[d0] = MX_MFMA(__builtin_bit_cast(bf16x8, pw0), vfrag(vp, 4 * d0 + 0), o[d0]); o[d0] = MX_MFMA(__builtin_bit_cast(bf16x8, pw1), vfrag(vp, 4 * d0 + 1), o[d0]);
      o[d0] = MX_MFMA(__builtin_bit_cast(bf16x8, pw2), vfrag(vp, 4 * d0 + 2), o[d0]); o[d0] = MX_MFMA(__builtin_bit_cast(bf16x8, pw3), vfrag(vp, 4 * d0 + 3), o[d0]); }
  }
#pragma unroll
  for (int eb = 0; eb < 2; ++eb)
#pragma unroll
    for (int ks = 0; ks < 4; ++ks) o[eb] = MX_MFMA(qr[ks], rtf[eb][ks], o[eb]);
  float* stg = (float*)(lds + 65536) + wid * 2048;
#pragma unroll
  for (int r = 0; r < 16; ++r) { const int orow = att::crow(r, hi); stg[orow * 64 + r32] = o[0][r]; stg[orow * 64 + 32 + r32] = o[1][r]; }
  asm volatile("s_waitcnt lgkmcnt(0)" ::: "memory");
  bf16_t* mix = (bf16_t*)(p.ws + OFF_MIX) + (r0 + rw) * D_ + h * 64;
#pragma unroll
  for (int i = 0; i < 4; ++i) { const int row = i * 8 + (lane >> 3), c8 = lane & 7;
    const f32x4 a0 = *(const f32x4*)(stg + row * 64 + c8 * 8), a1 = *(const f32x4*)(stg + row * 64 + c8 * 8 + 4);
    float ss = (a0[0] * a0[0] + a0[1] * a0[1]) + (a0[2] * a0[2] + a0[3] * a0[3]) + (a1[0] * a1[0] + a1[1] * a1[1]) + (a1[2] * a1[2] + a1[3] * a1[3]);
    ss += __shfl_xor(ss, 1); ss += __shfl_xor(ss, 2); ss += __shfl_xor(ss, 4);
    const float rs = rsqrtf(ss * (1.f / 64.f) + EPS);
    const u32x4 gw = gwv[i];
    float gv[8] = {__uint_as_float(gw.x << 16), __uint_as_float(gw.x & 0xffff0000u), __uint_as_float(gw.y << 16), __uint_as_float(gw.y & 0xffff0000u),
                   __uint_as_float(gw.z << 16), __uint_as_float(gw.z & 0xffff0000u), __uint_as_float(gw.w << 16), __uint_as_float(gw.w & 0xffff0000u)};
    float ov[8] = {a0[0], a0[1], a0[2], a0[3], a1[0], a1[1], a1[2], a1[3]};
#pragma unroll
    for (int k = 0; k < 8; ++k) ov[k] = ov[k] * rs * (gv[k] * sigmoidf(gv[k]));
    u32x4 w; w.x = pk2(ov[0], ov[1]); w.y = pk2(ov[2], ov[3]); w.z = pk2(ov[4], ov[5]); w.w = pk2(ov[6], ov[7]);
    *(u32x4*)(mix + (size_t)row * D_ + c8 * 8) = w; }
  MX_WAIT_ALL();
}
__device__ __forceinline__ void gmlp_unit(const Cx& cx, const P& p, int layer, int u, char* lds) {
  const int tid = cx.tid, lane = tid & 63, r32 = lane & 31, hi = lane >> 5, wid = cx.wv;
  const int g = u & 3, bc = u >> 2; const size_t r0 = (size_t)bc * 128;
  const bf16_t* HB = (const bf16_t*)(p.ws + OFF_HB);
  const bf16_t* Up = HB + ((size_t)(42 + g) * M_ + r0) * 64; const bf16_t* Vp = HB + ((size_t)(46 + g) * M_ + r0) * 64;
  const unsigned lds0 = (unsigned)(uintptr_t)lds;
  dma_v_tile(Vp, lds0, lane, wid); dma_v_tile(Vp + 4096, lds0 + 8192, lane, wid);
  const int rt = wid & 3, dh = wid >> 2;
  const bf16_t* Wr = (const bf16_t*)(p.ws + OFF_WSB) + ((size_t)(layer * 4 + g) * 128 + rt * 32 + r32) * 128;
  u32x4 uwv[2]; float bsv[2];
#pragma unroll
  for (int i = 0; i < 2; ++i) { const int t = rt * 32 + i * 16 + (lane >> 2); uwv[i] = *(const u32x4*)(Up + (size_t)t * 64 + dh * 32 + (lane & 3) * 8); bsv[i] = p.gm_b[(layer * 4 + g) * 128 + t]; }
  MX_WAIT_ALL();
  f32x16 acc = f32x16{};
  for (int ks = 0; ks < 2 * rt + 2; ++ks) {
    const uint2 alo = *(const uint2*)(Wr + 16 * ks + 4 * hi), ahi = *(const uint2*)(Wr + 16 * ks + 8 + 4 * hi);
    const u32x4 aw = (u32x4){alo.x, alo.y, ahi.x, ahi.y};
    const lds_cptr vp = (lds_cptr)(uintptr_t)(lds0 + (ks >> 2) * 8192) + vlane_off(lane);
    acc = MX_MFMA(__builtin_bit_cast(bf16x8, aw), vfrag(vp, 4 * dh + (ks & 3)), acc);
  }
  float* stg = (float*)(lds + 16384) + wid * 1024;
#pragma unroll
  for (int r = 0; r < 16; ++r) stg[att::crow(r, hi) * 32 + r32] = acc[r];
  asm volatile("s_waitcnt lgkmcnt(0)" ::: "memory");
  bf16_t* mix = (bf16_t*)(p.ws + OFF_MIX) + (r0 + rt * 32) * D_ + 768 + g * 64 + dh * 32;
#pragma unroll
  for (int i = 0; i < 2; ++i) { const int row = i * 16 + (lane >> 2), c8 = lane & 3, t = rt * 32 + row;
    const f32x4 a0 = *(const f32x4*)(stg + row * 32 + c8 * 8), a1 = *(const f32x4*)(stg + row * 32 + c8 * 8 + 4);
    const float bias = bsv[i];
    const u32x4 uw = uwv[i];
    u32x4 w; w.x = pk2(__uint_as_float(uw.x << 16) * (a0[0] + bias), __uint_as_float(uw.x & 0xffff0000u) * (a0[1] + bias));
    w.y = pk2(__uint_as_float(uw.y << 16) * (a0[2] + bias), __uint_as_float(uw.y & 0xffff0000u) * (a0[3] + bias));
    w.z = pk2(__uint_as_float(uw.z << 16) * (a1[0] + bias), __uint_as_float(uw.z & 0xffff0000u) * (a1[1] + bias));
    w.w = pk2(__uint_as_float(uw.w << 16) * (a1[2] + bias), __uint_as_float(uw.w & 0xffff0000u) * (a1[3] + bias));
    *(u32x4*)(mix + (size_t)row * D_ + c8 * 8) = w; }
  MX_WAIT_ALL();
}
__device__ __forceinline__ void cmp_unit(const Cx& cx, const P& p, int layer, int u, char* lds) {
  const int tid = cx.tid, lane = tid & 63, r32 = lane & 31, hi = lane >> 5, wid = cx.wv;
  const int nt = u & 15, bgj = u >> 4, bg = bgj >> 1, j = bgj & 1, b = bg >> 1, g = bg & 1;
  const int nrow = min(nt * 32 + r32, 510);
  const bf16_t* xf = (const bf16_t*)(p.ws + OFF_HB) + ((size_t)(30 + j * 2 + g) * M_ + (size_t)b * T_) * 64 + (size_t)nrow * 1024;
  const bf16_t* W1T = (const bf16_t*)(p.ws + OFF_W1T) + (size_t)(layer * 2 + j) * 64 * 2048;
  bf16x8 w2f[2][2][2];
  if (wid == 0) { const bf16_t* wf = (const bf16_t*)(p.ws + OFF_W2F) + (size_t)(layer * 2 + j) * 4096 + lane * 8;
#pragma unroll
    for (int q = 0; q < 8; ++q) w2f[q >> 2][(q >> 1) & 1][q & 1] = *reinterpret_cast<const bf16x8*>(wf + q * 512); }
  f32x16 acc[2]; acc[0] = f32x16{}; acc[1] = f32x16{};
#pragma unroll 8
  for (int ks = 0; ks < 16; ++ks) { const int i0 = 256 * wid + 16 * ks + 8 * hi;
    const bf16x8 bx = *reinterpret_cast<const bf16x8*>(xf + i0);
    const bf16x8 a0 = *reinterpret_cast<const bf16x8*>(W1T + (size_t)r32 * 2048 + i0), a1 = *reinterpret_cast<const bf16x8*>(W1T + (size_t)(32 + r32) * 2048 + i0);
    acc[0] = MX_MFMA(a0, bx, acc[0]); acc[1] = MX_MFMA(a1, bx, acc[1]); }
  float* red = (float*)lds;
#pragma unroll
  for (int fb = 0; fb < 2; ++fb)
#pragma unroll
    for (int r = 0; r < 16; ++r) red[((wid * 2 + fb) * 16 + r) * 64 + lane] = acc[fb][r];
  MX_WAIT_ALL();
  {
    const float* c1 = (const float*)(p.ws + OFF_C1) + (layer * 2 + j) * 64;
    const int fb = wid >> 2, r0 = 4 * (wid & 3);
#pragma unroll
    for (int rr = 0; rr < 4; ++rr) { const int r = r0 + rr; float a = c1[32 * fb + att::crow(r, hi)];
#pragma unroll
      for (int w = 0; w < 8; ++w) a += red[((w * 2 + fb) * 16 + r) * 64 + lane];
      red[16384 + (fb * 16 + r) * 64 + lane] = gelu_tanh(a); } }
  MX_WAIT_ALL();
  if (wid == 0) {
    bf16x8 hb[2][2];
#pragma unroll
    for (int fb = 0; fb < 2; ++fb)
#pragma unroll
      for (int s2 = 0; s2 < 2; ++s2) { float hv[8];
#pragma unroll
        for (int k = 0; k < 8; ++k) hv[k] = red[16384 + (fb * 16 + 8 * s2 + k) * 64 + lane];
        const u32x4 w = (u32x4){att::cvtpk(hv[0], hv[1]), att::cvtpk(hv[2], hv[3]), att::cvtpk(hv[4], hv[5]), att::cvtpk(hv[6], hv[7])};
        hb[fb][s2] = __builtin_bit_cast(bf16x8, w); }
    f32x16 oc[2]; oc[0] = f32x16{}; oc[1] = f32x16{};
#pragma unroll
    for (int eb = 0; eb < 2; ++eb)
#pragma unroll
      for (int fb = 0; fb < 2; ++fb)
#pragma unroll
        for (int s2 = 0; s2 < 2; ++s2) oc[eb] = MX_MFMA(w2f[eb][fb][s2], hb[fb][s2], oc[eb]);
    if (j == 0) { float ss = 0.f;
#pragma unroll
      for (int eb = 0; eb < 2; ++eb)
#pragma unroll
        for (int r = 0; r < 16; ++r) ss += oc[eb][r] * oc[eb][r];
      ss += __shfl_xor(ss, 32);
      const float rs = rsqrtf(ss * (1.f / 64.f) + EPS);
#pragma unroll
      for (int eb = 0; eb < 2; ++eb)
#pragma unroll
        for (int r = 0; r < 16; ++r) oc[eb][r] *= rs * p.k_gain[(layer * 3 + 0) * 64 + 32 * eb + att::crow(r, hi)]; }
    bf16_t* dst = (bf16_t*)(p.ws + (j == 0 ? OFF_KC : OFF_VC)) + ((size_t)bg * 512 + nt * 32 + r32) * 64;
    const bool real = (nt * 32 + r32) < 511;
    if (real) {
#pragma unroll
      for (int eb = 0; eb < 2; ++eb)
#pragma unroll
        for (int r4 = 0; r4 < 4; ++r4)
        { const unsigned long long w = (unsigned long long)pk2(oc[eb][4 * r4], oc[eb][4 * r4 + 1]) | ((unsigned long long)pk2(oc[eb][4 * r4 + 2], oc[eb][4 * r4 + 3]) << 32);
          unsigned long long* q8 = (unsigned long long*)(dst + 32 * eb + att::crow(4 * r4, hi));
          if (j == 0) __hip_atomic_store(q8, w, __ATOMIC_RELAXED, __HIP_MEMORY_SCOPE_AGENT); else *q8 = w; } }
    if (j == 0) { asm volatile("s_waitcnt vmcnt(0)" ::: "memory"); if (lane == 0) hand_publish((unsigned*)(p.ws + OFF_CTR) + 512 + layer * 64 + bg * 16); }
  }
  MX_WAIT_ALL();
}
#undef MX_MFMA
}

__device__ __forceinline__ void ph_mix1(const Cx& cx, const P& p, int layer, char* lds, int rank, int nranks) {
  for (int item = rank; item < 128 + 384; item += nranks) {
    Cx c2 = cx; c2.tid = cx.wv * 64 + lane_id(); asm volatile("" : "+v"(c2.tid));
    if (item < 128) mx::cmp_unit(c2, p, layer, item, lds); else mx::ret_kv_unit(c2, p, layer, item - 128, lds);
  }
}
__device__ __forceinline__ void ph_mix2(const Cx& cx, const P& p, int layer, char* lds) {
  const int u0 = (cx.bid < 64) ? 192 + cx.bid : cx.bid - 64;
  for (int u = u0; u < 256; u += 256) { Cx c2 = cx; c2.tid = cx.wv * 64 + lane_id(); asm volatile("" : "+v"(c2.tid)); topk_unit(c2, p, layer, u, lds); }
  if (cx.bid >= 160) { if (cx.wv == 0 && lane_id() == 0) hand_wait((unsigned*)(p.ws + OFF_CTR) + 768 + layer * 64, 384u); __syncthreads();
    Cx c3 = cx; c3.bid = cx.bid - 160; c3.G = 96; mx::ret_scan(c3, p); }
  if (layer == 0) convert_weights(p, (LAS unsigned char*)lds, cx.wv, lane_id(), cx.bid * 8 + cx.wv, cx.G * 8, 6400, 8576);
}
__device__ __forceinline__ void ph_mix3(const Cx& cx, const P& p, int layer, char* lds) {
  const int nconv = (layer == 0) ? 148 : 0;
  unsigned* ctr = (unsigned*)(p.ws + OFF_CTR) + layer * 64;
  int* slot = (int*)(lds + 131072);
  for (;;) {
    __syncthreads();
    if (cx.wv == 0 && lane_id() == 0) *slot = (int)atomicAdd(ctr, 1u);
    __syncthreads();
    const int item = __builtin_amdgcn_readfirstlane(*slot);
    if (item >= 384 + 384 + 512 + nconv) break;
    Cx c2 = cx; c2.tid = cx.wv * 64 + lane_id(); asm volatile("" : "+v"(c2.tid));
    if (item < 384) nsa_unit(c2, p, item, lds); else if (item < 768) mx::ret_out_unit(c2, p, item - 384, lds);
    else if (item < 1280) mx::gmlp_unit(c2, p, layer, item - 768, lds);
    else { const int c0 = 1664 + (item - 1280) * 32; convert_weights(p, (LAS unsigned char*)lds, cx.wv, lane_id(), cx.wv, 8, c0, min(c0 + 32, 6400)); }
  }
}
typedef unsigned gu32_t;
#define XB_TMO      128
#define XB_XCNT(j)  (256  + 64 * (j))
#define XB_XSUB(j)  (1280 + 64 * (j))
#define XB_XGEN(j)  (2304 + 64 * (j))
#define XB_TOP      3328
#define XB_TOPGEN   3392
#define XCD_BAR_WORDS 3456
#define XB_SPIN_CAP (1u << 18)

__device__ __forceinline__ unsigned xb_ld(unsigned* p)              { return __hip_atomic_load(p, __ATOMIC_RELAXED, __HIP_MEMORY_SCOPE_AGENT); }
__device__ __forceinline__ unsigned xb_add(unsigned* p, unsigned v) { return __hip_atomic_fetch_add(p, v, __ATOMIC_RELAXED, __HIP_MEMORY_SCOPE_AGENT); }
__device__ __forceinline__ unsigned xb_xcc_id() { return (unsigned)__builtin_amdgcn_s_getreg((3 << 11) | 20) & 0xFu; }
#define XB_SPIN(cond, bar) do { unsigned _sp = 0; while (cond) { __builtin_amdgcn_s_sleep(1); \
    if ((++_sp & 255u) == 0u) { if (xb_ld(&(bar)[XB_TMO])) break; if (_sp > XB_SPIN_CAP) { atomicAdd(&(bar)[XB_TMO], 1u); break; } } } } while (0)

struct XcdBarrier {
    unsigned* bar; unsigned x;
    volatile LAS unsigned* st;
    int wv;
};

__device__ __forceinline__ XcdBarrier xcd_barrier_post(unsigned* bar, volatile LAS unsigned* st, int wv) {
    XcdBarrier b; b.bar = bar; b.x = xb_xcc_id(); b.st = st; b.wv = wv;
    if (wv == 0 && lane_id() == 0) (void)xb_add(&bar[XB_XCNT(b.x)], 1u);
    return b;
}
__device__ __forceinline__ void xcd_barrier_complete(unsigned* bar, unsigned x, unsigned& nloc, unsigned& nx) {
    const unsigned G = gridDim.x * gridDim.y * gridDim.z;
    unsigned sum, cnt, mine, sp = 0u;
    for (;;) {
        sum = 0u; cnt = 0u; mine = 0u;
#pragma unroll
        for (unsigned j = 0; j < 16; ++j) { const unsigned c = xb_ld(&bar[XB_XCNT(j)]); sum += c; cnt += (c > 0u) ? 1u : 0u; mine = (j == x) ? c : mine; }
        if (sum == G) break;
        __builtin_amdgcn_s_sleep(1);
        if ((++sp & 255u) == 0u) { if (xb_ld(&bar[XB_TMO])) break; if (sp > XB_SPIN_CAP) { atomicAdd(&bar[XB_TMO], 1u); break; } }
    }
    nloc = mine > 0u ? mine : 1u; nx = cnt > 0u ? cnt : 1u;
}

__device__ __forceinline__ void xcd_barrier(const XcdBarrier& b) {
    asm volatile("s_waitcnt vmcnt(0)" ::: "memory");
    __syncthreads();
    if (b.wv == 0 && lane_id() == 0) {
        unsigned* bar = b.bar;
        __builtin_amdgcn_s_waitcnt(0);
        unsigned nloc = b.st[0], nx = b.st[1];
        if (nloc == 0u) { xcd_barrier_complete(bar, b.x, nloc, nx); b.st[0] = nloc; b.st[1] = nx; }
        const unsigned old = xb_add(&bar[XB_XSUB(b.x)], 1u);
        const unsigned gen = old / nloc;
        if (old + 1u == (gen + 1u) * nloc) {
            __builtin_amdgcn_fence(__ATOMIC_RELEASE, "agent");
            asm volatile("s_waitcnt vmcnt(0)" ::: "memory");
            const unsigned og = xb_add(&bar[XB_TOP], 1u);
            const unsigned tg = og / nx;
            if (og + 1u == (tg + 1u) * nx) xb_add(&bar[XB_TOPGEN], 1u);
            else XB_SPIN(xb_ld(&bar[XB_TOPGEN]) == tg, bar);
            __builtin_amdgcn_fence(__ATOMIC_ACQUIRE, "agent");
            xb_add(&bar[XB_XGEN(b.x)], 1u);
            asm volatile("s_waitcnt vmcnt(0)" ::: "memory");
        } else {
            XB_SPIN(xb_ld(&bar[XB_XGEN(b.x)]) == gen, bar);
            __builtin_amdgcn_fence(__ATOMIC_ACQUIRE, "agent");
            asm volatile("s_waitcnt vmcnt(0)" ::: "memory");
        }
    }
    __syncthreads();
}

__global__ void __launch_bounds__(NTHR, 2) k_mega(P pk) {
  extern __shared__ __attribute__((aligned(16))) unsigned char lds_raw[];
  LAS unsigned char* lds = (LAS unsigned char*)lds_raw;
  float* sm = (float*)lds_raw;
  const int wave_s = __builtin_amdgcn_readfirstlane((int)threadIdx.x >> 6);
  { volatile LAS unsigned* bst = (volatile LAS unsigned*)(lds + 131072 + 64);
    if (threadIdx.x < 2) bst[threadIdx.x] = 0u;
    __syncthreads();
    (void)xcd_barrier_post((unsigned*)(pk.ws + OFF_BAR), bst, wave_s); }
#define GSYNC() do { kargp_t kb_ = (kargp_t)__builtin_amdgcn_kernarg_segment_ptr(); asm volatile("" : "+s"(kb_)); XcdBarrier xb_; xb_.bar = (unsigned*)(kb_->ws + OFF_BAR); xb_.x = xb_xcc_id(); \
    xb_.st = (volatile LAS unsigned*)(lds + 131072 + 64); xb_.wv = wave_s; xcd_barrier(xb_); } while (0)
#define LOADP(p, k) do { p.x = k->x; p.attn_norm = k->attn_norm; p.w_in = k->w_in; p.w_out = k->w_out; p.q_gain = k->q_gain; p.k_gain = k->k_gain; p.cmp_pe = k->cmp_pe; p.cmp_w1 = k->cmp_w1; p.cmp_w2 = k->cmp_w2; \
    p.gm_ws = k->gm_ws; p.gm_b = k->gm_b; p.ffn_norm = k->ffn_norm; p.w_gu = k->w_gu; p.w_down = k->w_down; p.rel_bias = k->rel_bias; p.out = k->out; p.ws = k->ws; } while (0)
  typedef const __attribute__((address_space(4))) P* kargp_t;
#define PB Cx cx; P p; { int t_ = wave_s * 64 + lane_id(), b_ = blockIdx.x; kargp_t k_ = (kargp_t)__builtin_amdgcn_kernarg_segment_ptr(); asm volatile("" : "+v"(t_), "+s"(b_), "+s"(k_)); LOADP(p, k_); cx.tid = t_; cx.bid = b_; cx.G = gridDim.x; cx.wv = wave_s; }
  { PB; ph_prologue(cx, p, lds); }
  GSYNC();
#pragma unroll 1
  for (int layer = 0; layer < 2; ++layer) {
    { PB; pg8::Gemm g{(const bf16_t*)(p.ws + OFF_XB), (const bf16_t*)(p.ws + OFF_WIN) + (size_t)layer * NPROJ * D_, M_, 3072, D_}; pg8::StaticOrder S; S.init(M_, 3072, cx.G, cx.bid);
      EpiProj E{(const float*)(p.ws + OFF_SSQ), (bf16_t*)(p.ws + OFF_HB), (float*)(p.ws + OFF_GATES), (const float2*)(p.ws + OFF_ROPE), p.q_gain + layer * 64, p.k_gain + layer * 192};
      pg8::gemm_phase<EpiProj, pg8::StaticOrder, PG8_ALIGN, PG8_SP2>(lds, g, S, E, cx.tid); }
    GSYNC();
    { PB; if (cx.bid < 64) {
        pg8::Gemm g2{(const bf16_t*)(p.ws + OFF_XB), (const bf16_t*)(p.ws + OFF_WIN) + (size_t)layer * NPROJ * D_, M_, NPROJ, D_}; pg8::OneUnit S2{cx.bid, 12, true};
        EpiProj E{(const float*)(p.ws + OFF_SSQ), (bf16_t*)(p.ws + OFF_HB), (float*)(p.ws + OFF_GATES), (const float2*)(p.ws + OFF_ROPE), p.q_gain + layer * 64, p.k_gain + layer * 192};
        pg8::gemm_phase<EpiProj, pg8::OneUnit, false, PG8_SP2>(lds, g2, S2, E, cx.tid);
      } else ph_mix1(cx, p, layer, (char*)lds_raw, cx.bid - 64, cx.G - 64); }
    { PB; ph_mix2(cx, p, layer, (char*)lds_raw); } GSYNC();
    { PB; ph_mix3(cx, p, layer, (char*)lds_raw); } GSYNC();
    { PB; pg8::Gemm g{(const bf16_t*)(p.ws + OFF_MIX), (const bf16_t*)(p.ws + OFF_WO) + (size_t)layer * D_ * D_, M_, D_, D_}; pg8::StaticOrder S; S.init(M_, D_, cx.G, cx.bid);
      EpiRes E{(layer == 0) ? p.x : nullptr, nullptr, (bf16_t*)(p.ws + OFF_XB), (float*)(p.ws + OFF_SSQ)};
      pg8::gemm_phase<EpiRes, pg8::StaticOrder, PG8_ALIGN, PG8_SP2>(lds, g, S, E, cx.tid); }
    GSYNC();
    { PB; pg8::Gemm g{(const bf16_t*)(p.ws + OFF_XB), (const bf16_t*)(p.ws + OFF_WGU) + (size_t)layer * 2 * DFF * D_, M_, 2 * DFF, D_}; pg8::StaticOrder S; S.init(M_, 2 * DFF, cx.G, cx.bid);
      EpiGU E{(const float*)(p.ws + OFF_SSQ), (bf16_t*)(p.ws + OFF_ACT)};
      pg8::gemm_phase<EpiGU, pg8::StaticOrder, PG8_ALIGN, PG8_SP2>(lds, g, S, E, cx.tid);
      { const int c0 = (cx.G > 128) ? 128 : 0; if (layer == 0 && cx.bid >= c0) convert_weights(p, lds, cx.wv, cx.tid & 63, (cx.bid - c0) * 8 + cx.wv, (cx.G - c0) * 8, 8576, 12800); } }
    GSYNC();
    { PB; pg8::Gemm g{(const bf16_t*)(p.ws + OFF_ACT), (const bf16_t*)(p.ws + OFF_WD) + (size_t)layer * D_ * DFF, M_, D_, DFF}; pg8::StaticOrder S; S.init(M_, D_, cx.G, cx.bid);
      EpiRes E{nullptr, (layer == 1) ? p.out : nullptr, (bf16_t*)(p.ws + OFF_XB), (float*)(p.ws + OFF_SSQ)};
      pg8::gemm_phase<EpiRes, pg8::StaticOrder, PG8_ALIGN, PG8_SP2>(lds, g, S, E, cx.tid); }
    GSYNC();
  }
}

extern "C" void kernel_launch(void* const* d_in, const int* in_sizes, int n_in, void* d_out, int out_size, void* d_ws, size_t ws_size, hipStream_t stream) {
  P p{};
  p.x = (const float*)d_in[0]; p.attn_norm = (const float*)d_in[1]; p.w_in = (const float*)d_in[2]; p.w_out = (const float*)d_in[3];
  p.q_gain = (const float*)d_in[4]; p.k_gain = (const float*)d_in[5]; p.cmp_pe = (const float*)d_in[6]; p.cmp_w1 = (const float*)d_in[7];
  p.cmp_w2 = (const float*)d_in[8]; p.gm_ws = (const float*)d_in[9]; p.gm_b = (const float*)d_in[10]; p.ffn_norm = (const float*)d_in[11];
  p.w_gu = (const float*)d_in[12]; p.w_down = (const float*)d_in[13]; p.rel_bias = (const float*)d_in[14];
  p.out = (float*)d_out; p.ws = (unsigned char*)d_ws;
  static int grid = 0;
  if (!grid) {
    (void)hipFuncSetAttribute((const void*)k_mega, hipFuncAttributeMaxDynamicSharedMemorySize, LDS_BYTES);
    int dev = 0, cus = 0, per_cu = 0;
    (void)hipGetDevice(&dev);
    (void)hipDeviceGetAttribute(&cus, hipDeviceAttributeMultiprocessorCount, dev);
    (void)hipOccupancyMaxActiveBlocksPerMultiprocessor(&per_cu, (const void*)k_mega, NTHR, LDS_BYTES);
    if (per_cu < 1) per_cu = 1;
    grid = cus;
  }
  (void)hipMemsetAsync((char*)d_ws + OFF_BAR, 0, 16384, stream);
  void* args[] = {&p};
  hipError_t e = hipLaunchCooperativeKernel((const void*)k_mega, dim3(grid), dim3(NTHR), args, LDS_BYTES, stream);
  if (e != hipSuccess) fprintf(stderr, "cooperative launch failed: %s (grid %d)\n", hipGetErrorString(e), grid);
}
```

```cpp
#include <hip/hip_runtime.h>
#include <hip/hip_cooperative_groups.h>
#include <stdint.h>
#include <stdio.h>
namespace cg = cooperative_groups;
namespace pg8 {
#define PG8_LAS __attribute__((address_space(3)))
typedef unsigned short bf16_t;
typedef short bf16x8 __attribute__((ext_vector_type(8)));
typedef float f32x4 __attribute__((ext_vector_type(4)));
typedef unsigned u32x4 __attribute__((ext_vector_type(4)));
constexpr int BM = 256, BK = 64, HALF = 128, HTB = HALF * BK * 2  , STAGE_BYTES = 8 * HTB, NXCD = 8, WGM = 8;

__host__ __device__ __forceinline__ int lds_byte(int r, int c) { const int st = (r >> 4) * 2 + (c >> 5), rr = r & 15, cc = c & 31, ob = rr * 64 + cc * 2; return st * 1024 + (ob ^ (((ob >> 9) & 1) << 5)); }
__host__ __device__ __forceinline__ void stage_rc(int b, int& R, int& C) { const int st = b / 1024, sb = b % 1024, swz = sb ^ (((sb >> 9) & 1) << 5); R = (st >> 1) * 16 + swz / 64; C = (st & 1) * 32 + (swz % 64) / 2; }
__host__ __device__ __forceinline__ int perm32(int rho) { const int n = rho >> 4, i = rho & 15; return 8 * (i >> 2) + 4 * n + (i & 3); }

struct Unit { int pm, pn; };
struct Gemm { const bf16_t* A; const bf16_t* Bt; int M, N, K; };

struct StaticOrder {
    int nM, nN, nwg, G, c;
    __host__ __device__ void init(int M, int N, int G_, int c_) { nM = M / BM; nN = N / BM; nwg = nM * nN; G = G_; c = c_; }
    __host__ __device__ bool next(int i, Unit& u) const {
        const long L = (long)i * G + c; if (L >= nwg) return false;
        int wgid = (int)L; { const int q = nwg / NXCD, r = nwg % NXCD, xcd = wgid % NXCD, off = wgid / NXCD; wgid = (xcd < r ? xcd * (q + 1) : r * (q + 1) + (xcd - r) * q) + off; }
        const int nig = WGM * nN, gid = wgid / nig, fm = gid * WGM, gsz = (nM - fm) < WGM ? (nM - fm) : WGM;
        u.pm = fm + ((wgid % nig) % gsz); u.pn = (wgid % nig) / gsz; return true;
    }
    __device__ __forceinline__ void a_ready(const Unit&) const {}
    __device__ __forceinline__ void done(const Unit&) const {}
};

struct OneUnit {
    int pm, pn; bool have;
    __host__ __device__ bool next(int i, Unit& u) const { if (i > 0 || !have) return false; u.pm = pm; u.pn = pn; return true; }
    __device__ __forceinline__ void a_ready(const Unit&) const {}
    __device__ __forceinline__ void done(const Unit&) const {}
};
__device__ __forceinline__ unsigned cvt_pk_bf16(float lo, float hi) { unsigned r; asm volatile("v_cvt_pk_bf16_f32 %0, %1, %2" : "=v"(r) : "v"(lo), "v"(hi)); return r; }
typedef float f32x2 __attribute__((ext_vector_type(2)));
template <class Epi, class Sched, bool ALIGN_EPI = false, bool SP2 = false>
__device__ __forceinline__ void gemm_phase(PG8_LAS unsigned char* lds, const Gemm g, const Sched& S, const Epi& E, const int tid) {
    const int wid = __builtin_amdgcn_readfirstlane(tid >> 6), lane = tid & 63, wr = wid >> 2, wc = wid & 3, fr = lane & 15, fq = lane >> 4;
    const int K = g.K, nt = K / BK;
    unsigned voffA[2], voffB[2];
#pragma unroll
    for (int i = 0; i < 2; ++i) { int R, C; stage_rc(tid * 16 + i * 8192, R, C); const int Rb = Epi::PERM ? ((R & ~31) + perm32(R & 31)) : R;
        voffA[i] = (unsigned)(R * K + C) * 2u; voffB[i] = (unsigned)(Rb * K + C) * 2u; }
    const size_t kstep = (size_t)(BK * 2);
    const size_t hstep = (size_t)HALF * K * 2;
    const size_t tstep = 2 * hstep;
    const unsigned ldsw = (unsigned)wid * 1024u;
    const int aoff = lds_byte(wr * 64 + fr, fq * 8), boff = lds_byte(wc * 32 + fr, fq * 8);
#define PG8_SA(b, h) (((b) * 2 + (h)) * HTB)
#define PG8_SB(b, h) ((4 + (b) * 2 + (h)) * HTB)
#define PG8_STAGE(bufoff, gbase, voff) do { _Pragma("unroll") for (int _i = 0; _i < 2; ++_i) \
        __builtin_amdgcn_global_load_lds((const unsigned*)((const char*)(gbase) + (voff)[_i]), (PG8_LAS unsigned*)(lds + (bufoff) + ldsw + _i * 8192), 16, 0, 0); } while (0)
#define PG8_LDA(dst, b, h) do { _Pragma("unroll") for (int m = 0; m < 4; ++m) _Pragma("unroll") for (int k = 0; k < 2; ++k) dst[m][k] = *(const PG8_LAS bf16x8*)(lds + PG8_SA(b, h) + aoff + m * 2048 + k * 1024); } while (0)
#define PG8_LDB(dst, b, h) do { _Pragma("unroll") for (int n = 0; n < 2; ++n) _Pragma("unroll") for (int k = 0; k < 2; ++k) dst[n][k] = *(const PG8_LAS bf16x8*)(lds + PG8_SB(b, h) + boff + n * 2048 + k * 1024); } while (0)
#define PG8_MMA(ai, bj, At, Bt) do { __builtin_amdgcn_s_setprio(1); _Pragma("unroll") for (int m = 0; m < 4; ++m) _Pragma("unroll") for (int n = 0; n < 2; ++n) _Pragma("unroll") for (int k = 0; k < 2; ++k) \
        acc[ai][bj][m][n] = __builtin_amdgcn_mfma_f32_16x16x32_bf16(Bt[n][k], At[m][k], acc[ai][bj][m][n], 0, 0, 0); __builtin_amdgcn_s_setprio(0); } while (0)
#define PG8_WAIT_V(n) asm volatile("s_waitcnt vmcnt(" #n ")" ::: "memory")
#define PG8_WAIT_L(n) asm volatile("s_waitcnt lgkmcnt(" #n ")" ::: "memory")
#define PG8_BAR __builtin_amdgcn_s_barrier()
#define PG8_SCHED __builtin_amdgcn_sched_barrier(0)
    Unit cur, nxt; int ui = 0;
    if (!S.next(0, cur)) return;
    f32x4 acc[2][2][4][2];
#pragma unroll
    for (int a = 0; a < 2; ++a)
#pragma unroll
        for (int b = 0; b < 2; ++b)
#pragma unroll
            for (int m = 0; m < 4; ++m)
#pragma unroll
                for (int n = 0; n < 2; ++n) acc[a][b][m][n] = (f32x4){0.f, 0.f, 0.f, 0.f};
    bf16x8 At[4][2], B0[2][2], B1[2][2];
    const char* cA = (const char*)g.A + (size_t)cur.pm * tstep; const char* cB = (const char*)g.Bt + (size_t)cur.pn * tstep;
    S.a_ready(cur);
    if constexpr (SP2) {
        PG8_STAGE(PG8_SB(0, 0), cB, voffB); PG8_STAGE(PG8_SB(0, 1), cB + hstep, voffB); PG8_STAGE(PG8_SA(0, 0), cA, voffA); PG8_STAGE(PG8_SA(0, 1), cA + hstep, voffA);
        if (wr == 1) PG8_BAR;
        PG8_WAIT_V(2); PG8_BAR;
        PG8_STAGE(PG8_SB(1, 0), cB + kstep, voffB); PG8_STAGE(PG8_SA(1, 0), cA + kstep, voffA); PG8_STAGE(PG8_SB(1, 1), cB + hstep + kstep, voffB);
        PG8_WAIT_V(6); PG8_BAR;
    } else {
        PG8_STAGE(PG8_SB(0, 0), cB, voffB); PG8_STAGE(PG8_SA(0, 0), cA, voffA); PG8_STAGE(PG8_SB(0, 1), cB + hstep, voffB); PG8_STAGE(PG8_SA(0, 1), cA + hstep, voffA);
        if (wr == 1) PG8_BAR;
        PG8_WAIT_V(4); PG8_BAR;
        PG8_STAGE(PG8_SB(1, 0), cB + kstep, voffB); PG8_STAGE(PG8_SA(1, 0), cA + kstep, voffA); PG8_STAGE(PG8_SB(1, 1), cB + hstep + kstep, voffB);
        PG8_WAIT_V(6); PG8_BAR;
    }
    for (;;) {
        const bool has_next = S.next(ui + 1, nxt);
        const char* nA = has_next ? (const char*)g.A + (size_t)nxt.pm * tstep : cA; const char* nB = has_next ? (const char*)g.Bt + (size_t)nxt.pn * tstep : cB;
        for (int t = 0; t < nt; t += 2) {
            const bool last = (t == nt - 2);
            const char* a1 = cA + (size_t)(t + 1) * kstep;
            const char* a2 = last ? nA : cA + (size_t)(t + 2) * kstep; const char* b2 = last ? nB : cB + (size_t)(t + 2) * kstep;
            const char* a3 = a2 + kstep; const char* b3 = b2 + kstep;
            if (last && has_next) S.a_ready(nxt);
            if constexpr (SP2) {
            PG8_LDB(B0, 0, 0); PG8_LDB(B1, 0, 1); PG8_SCHED; PG8_LDA(At, 0, 0); PG8_STAGE(PG8_SA(1, 1), a1 + hstep, voffA);
            PG8_WAIT_V(8); PG8_WAIT_L(0); PG8_BAR; PG8_MMA(0, 0, At, B0); PG8_MMA(0, 1, At, B1); PG8_BAR; PG8_SCHED;
            PG8_LDA(At, 0, 1); PG8_STAGE(PG8_SB(0, 0), b2, voffB); PG8_STAGE(PG8_SB(0, 1), b2 + hstep, voffB); PG8_STAGE(PG8_SA(0, 0), a2, voffA);
            PG8_WAIT_V(8); PG8_WAIT_L(0); PG8_BAR; PG8_MMA(1, 0, At, B0); PG8_MMA(1, 1, At, B1); PG8_BAR; PG8_SCHED;
            PG8_LDB(B0, 1, 0); PG8_LDB(B1, 1, 1); PG8_SCHED; PG8_LDA(At, 1, 0); PG8_STAGE(PG8_SA(0, 1), a2 + hstep, voffA);
            PG8_WAIT_V(8); PG8_WAIT_L(0); PG8_BAR; PG8_MMA(0, 0, At, B0); PG8_MMA(0, 1, At, B1); PG8_BAR; PG8_SCHED;
            PG8_LDA(At, 1, 1); PG8_STAGE(PG8_SB(1, 0), b3, voffB); PG8_STAGE(PG8_SB(1, 1), b3 + hstep, voffB); PG8_STAGE(PG8_SA(1, 0), a3, voffA);
            PG8_WAIT_V(8); PG8_WAIT_L(0); PG8_BAR; PG8_MMA(1, 0, At, B0); PG8_MMA(1, 1, At, B1); PG8_BAR; PG8_SCHED;
            } else {
            PG8_LDB(B0, 0, 0); PG8_SCHED; PG8_LDA(At, 0, 0); PG8_STAGE(PG8_SA(1, 1), a1 + hstep, voffA);
            PG8_WAIT_L(8); PG8_BAR; PG8_WAIT_L(0); PG8_MMA(0, 0, At, B0); PG8_BAR; PG8_SCHED;
            PG8_LDB(B1, 0, 1); PG8_STAGE(PG8_SB(0, 0), b2, voffB);
            PG8_BAR; PG8_WAIT_L(0); PG8_MMA(0, 1, At, B1); PG8_BAR;
            PG8_LDA(At, 0, 1); PG8_STAGE(PG8_SA(0, 0), a2, voffA);
            PG8_BAR; PG8_WAIT_L(0); PG8_MMA(1, 0, At, B0); PG8_BAR; PG8_SCHED;
            PG8_STAGE(PG8_SB(0, 1), b2 + hstep, voffB);
            PG8_WAIT_V(6); PG8_BAR; PG8_MMA(1, 1, At, B1); PG8_BAR;
            PG8_LDB(B0, 1, 0); PG8_SCHED; PG8_LDA(At, 1, 0); PG8_STAGE(PG8_SA(0, 1), a2 + hstep, voffA);
            PG8_WAIT_L(8); PG8_BAR; PG8_WAIT_L(0); PG8_MMA(0, 0, At, B0); PG8_BAR; PG8_SCHED;
            PG8_LDB(B1, 1, 1); PG8_STAGE(PG8_SB(1, 0), b3, voffB);
            PG8_BAR; PG8_WAIT_L(0); PG8_MMA(0, 1, At, B1); PG8_BAR;
            PG8_LDA(At, 1, 1); PG8_STAGE(PG8_SA(1, 0), a3, voffA);
            PG8_BAR; PG8_WAIT_L(0); PG8_MMA(1, 0, At, B0); PG8_BAR; PG8_SCHED;
            PG8_STAGE(PG8_SB(1, 1), b3 + hstep, voffB);
            PG8_WAIT_V(6); PG8_BAR; PG8_MMA(1, 1, At, B1); PG8_BAR;
            }
        }
        if constexpr (ALIGN_EPI) { if (wr == 0) PG8_BAR; }
        if constexpr (!Epi::AFTER_DRAIN) { E(acc, cur, wr, wc, fr, fq); S.done(cur); }
        if (!has_next) break;
#pragma unroll
        for (int a = 0; a < 2; ++a)
#pragma unroll
            for (int b = 0; b < 2; ++b)
#pragma unroll
                for (int m = 0; m < 4; ++m)
#pragma unroll
                    for (int n = 0; n < 2; ++n) acc[a][b][m][n] = (f32x4){0.f, 0.f, 0.f, 0.f};
        cur = nxt; cA = nA; cB = nB; ++ui;
        if constexpr (ALIGN_EPI) { if (wr == 1) PG8_BAR; }
    }
    PG8_WAIT_V(0);
    if constexpr (!ALIGN_EPI) { if (wr == 0) PG8_BAR; }
    PG8_BAR;
    if constexpr (Epi::AFTER_DRAIN) { E.fused(acc, cur, wr, wc, fr, fq, lds, wid, lane); S.done(cur); }
#undef PG8_SA
#undef PG8_SB
#undef PG8_STAGE
#undef PG8_LDA
#undef PG8_LDB
#undef PG8_MMA
#undef PG8_WAIT_V
#undef PG8_WAIT_L
#undef PG8_BAR
#undef PG8_SCHED
}
}

#ifndef PG8_SP2
#define PG8_SP2 true
#endif
#ifndef PG8_ALIGN
#define PG8_ALIGN true
#endif

typedef unsigned short bf16_t;
typedef float f32x4 __attribute__((ext_vector_type(4)));
typedef unsigned u32x4 __attribute__((ext_vector_type(4)));
#define LAS __attribute__((address_space(3)))

#define T_ 8192
#define M_ 16384
#define D_ 1024
#define INW 3218
#define NPROJ 3328
#define DFF 2816
#define EPS 1e-6f
#define NTHR 512

struct Cx { int tid, bid, G, wv; };
__device__ __forceinline__ int lane_id() { int l; asm volatile("v_mbcnt_lo_u32_b32 %0, -1, 0\n\tv_mbcnt_hi_u32_b32 %0, -1, %0" : "=v"(l)); return l; }
__device__ __forceinline__ void hand_publish(unsigned* cnt) { asm volatile("s_waitcnt vmcnt(0)" ::: "memory"); __hip_atomic_fetch_add(cnt, 1u, __ATOMIC_RELAXED, __HIP_MEMORY_SCOPE_AGENT); }
__device__ __forceinline__ void hand_wait(unsigned* cnt, unsigned need) { unsigned sp = 0; while (__hip_atomic_load(cnt, __ATOMIC_RELAXED, __HIP_MEMORY_SCOPE_AGENT) < need) { __builtin_amdgcn_s_sleep(4); if (++sp > (1u << 22)) break; }
  asm volatile("" ::: "memory"); }
struct P {
  const float *x, *attn_norm, *w_in, *w_out, *q_gain, *k_gain, *cmp_pe, *cmp_w1, *cmp_w2, *gm_ws, *gm_b, *ffn_norm, *w_gu, *w_down, *rel_bias;
  float* out; unsigned char* ws;
};

constexpr size_t MiB = 1u << 20;
constexpr size_t OFF_HB = 0;
constexpr size_t OFF_ACT = 0;
constexpr size_t OFF_MIX = 100 * MiB;
constexpr size_t OFF_GATES = 132 * MiB;
constexpr size_t OFF_KC = 134 * MiB;
constexpr size_t OFF_VC = 134 * MiB + 512 * 1024;
constexpr size_t OFF_RS = 135 * MiB;
constexpr size_t OFF_ROPE = 148 * MiB;
constexpr size_t OFF_WIN = 152 * MiB;
constexpr size_t OFF_WO = 165 * MiB;
constexpr size_t OFF_WGU = 169 * MiB;
constexpr size_t OFF_WD = 191 * MiB;
constexpr size_t OFF_XB = 204 * MiB;
constexpr size_t OFF_SSQ = 236 * MiB;
constexpr size_t OFF_SELQ = 237 * MiB;
constexpr size_t OFF_CTR = 238 * MiB;
constexpr size_t OFF_BAR = 238 * MiB + 65536;
constexpr size_t OFF_RT = 239 * MiB;
constexpr size_t OFF_W1T = 245 * MiB;
constexpr size_t OFF_C1 = 246 * MiB;
constexpr size_t OFF_WSB = 246 * MiB + 65536;
constexpr size_t OFF_W2F = 247 * MiB + 65536;
constexpr size_t OFF_BTAB = 247 * MiB;

constexpr int LDS_BYTES = 147456;

__device__ __forceinline__ float bf2f(bf16_t v) { return __uint_as_float(((unsigned)v) << 16); }
__device__ __forceinline__ bf16_t f2bf(float f) { unsigned u = __float_as_uint(f); u += 0x7fffu + ((u >> 16) & 1u); return (bf16_t)(u >> 16); }
__device__ __forceinline__ unsigned pk2(float lo, float hi) { unsigned r; asm("v_cvt_pk_bf16_f32 %0, %1, %2" : "=v"(r) : "v"(lo), "v"(hi)); return r; }
__device__ __forceinline__ float gelu_tanh(float x) { const float y = -2.3022082f * (x + 0.044715f * x * x * x); return x * __builtin_amdgcn_rcpf(1.f + __builtin_amdgcn_exp2f(y)); }
__device__ __forceinline__ void div2(float n0, float d0, float n1, float d1, float& q0, float& q1) { const float r = __builtin_amdgcn_rcpf(d0 * d1); q0 = n0 * d1 * r; q1 = n1 * d0 * r; }
__device__ __forceinline__ void gelu2(float& a, float& b) {
  const float ea = fminf(__builtin_amdgcn_exp2f(-2.3022082f * (a + 0.044715f * a * a * a)), 1e15f), eb = fminf(__builtin_amdgcn_exp2f(-2.3022082f * (b + 0.044715f * b * b * b)), 1e15f);
  div2(a, 1.f + ea, b, 1.f + eb, a, b); }
__device__ __forceinline__ float sigmoidf(float x) { return __builtin_amdgcn_rcpf(1.f + __builtin_amdgcn_exp2f(-1.4426950408889634f * x)); }
#define rsqrtf(x) __builtin_amdgcn_rsqf(x)
__device__ __forceinline__ float wave_sum(float v) {
#pragma unroll
  for (int o = 1; o < 64; o <<= 1) v += __shfl_xor(v, o);
  return v;
}
__device__ __forceinline__ float wave_max(float v) {
#pragma unroll
  for (int o = 1; o < 64; o <<= 1) v = fmaxf(v, __shfl_xor(v, o));
  return v;
}
__device__ __forceinline__ int t5_bucket(int n) {
  if (n < 16) return n;
  int b = 16;
  b += (n >= 19); b += (n >= 21); b += (n >= 24); b += (n >= 27); b += (n >= 31); b += (n >= 35); b += (n >= 40); b += (n >= 46);
  b += (n >= 52); b += (n >= 59); b += (n >= 67); b += (n >= 77); b += (n >= 87); b += (n >= 99); b += (n >= 113);
  return b;
}
#define WSYNC() do { __builtin_amdgcn_fence(__ATOMIC_RELEASE, "wavefront"); __builtin_amdgcn_wave_barrier(); __builtin_amdgcn_fence(__ATOMIC_ACQUIRE, "wavefront"); } while (0)

__device__ __forceinline__ int proj_col0(int g) { return (g < 42) ? 64 * g : 2706 + 64 * (g - 42); }
__device__ __forceinline__ float row_rstd(const float* ssq, int row, int fq) {
  const f32x4 s = *(const f32x4*)(ssq + (size_t)row * 16 + 4 * fq);
  float t = (s[0] + s[1]) + (s[2] + s[3]);
  t += __shfl_xor(t, 16); t += __shfl_xor(t, 32);
  return rsqrtf(t * (1.f / D_) + EPS);
}
struct EpiProj {
  static constexpr bool PERM = true, AFTER_DRAIN = false;
  const float* ssq; bf16_t* HB; float* gates; const float2* rope; const float* q_gain; const float* k_gain;
  template <int TYPE>
  __device__ __forceinline__ void rows(const f32x4 (&acc)[2][2][4][2], const pg8::Unit& u, int wr, int fr, int fq, int gidx, float sc, float dec_l2, const float* gn_) const {
    const float* __restrict__ ssq = this->ssq; const float2* __restrict__ rope = this->rope; const float* __restrict__ gn = gn_;
    bf16_t* __restrict__ HB = this->HB; float* __restrict__ gates = this->gates;
    float gv[2][8];
    if (TYPE == 2) {
#pragma unroll
      for (int bj = 0; bj < 2; ++bj)
#pragma unroll
        for (int i = 0; i < 8; ++i) gv[bj][i] = gn[32 * bj + 8 * fq + i] * sc;
    }
#pragma unroll
    for (int ai = 0; ai < 2; ++ai)
#pragma unroll
      for (int m = 0; m < 4; ++m) {
        const int row = u.pm * 256 + ai * 128 + wr * 64 + m * 16 + fr;
        const float rstd = row_rstd(ssq, row, fq);
        float v[2][8];
#pragma unroll
        for (int bj = 0; bj < 2; ++bj)
#pragma unroll
          for (int n = 0; n < 2; ++n)
#pragma unroll
            for (int e = 0; e < 4; ++e) v[bj][4 * n + e] = acc[ai][bj][m][n][e] * rstd;
        if (TYPE == 0) {
          const float2* tb = rope + (size_t)(row & (T_ - 1)) * 32 + 8 * fq;
          const float scr = sc * __builtin_amdgcn_exp2f((float)(row & 127) * dec_l2);
#pragma unroll
          for (int i = 0; i < 8; ++i) { const float2 cs = tb[i]; const float x1 = v[0][i], x2 = v[1][i]; v[0][i] = (x1 * cs.x - x2 * cs.y) * scr; v[1][i] = (x2 * cs.x + x1 * cs.y) * scr; }
        }
        if (TYPE == 3 || TYPE == 4) {
#pragma unroll
          for (int bj = 0; bj < 2; ++bj)
#pragma unroll
            for (int i = 0; i < 8; i += 2) gelu2(v[bj][i], v[bj][i + 1]);
        }
        if (TYPE == 2 || TYPE == 4) {
          float ss = 0.f;
#pragma unroll
          for (int bj = 0; bj < 2; ++bj)
#pragma unroll
            for (int i = 0; i < 8; ++i) ss += v[bj][i] * v[bj][i];
          ss += __shfl_xor(ss, 16); ss += __shfl_xor(ss, 32);
          const float rs = rsqrtf(ss * (1.f / 64.f) + EPS);
#pragma unroll
          for (int bj = 0; bj < 2; ++bj)
#pragma unroll
            for (int i = 0; i < 8; ++i) v[bj][i] = (TYPE == 2) ? v[bj][i] * rs * gv[bj][i] : v[bj][i] * rs;
        }
        if (TYPE == 5) {
          float* gp = gates + (size_t)row * 24 + 8 * fq;
#pragma unroll
          for (int i = 0; i < 8; ++i) if (8 * fq + i < 18) gp[i] = sigmoidf(v[0][i]);
        } else {
          bf16_t* dst = HB + ((size_t)gidx * M_ + row) * 64 + 8 * fq;
#pragma unroll
          for (int bj = 0; bj < 2; ++bj) { u32x4 w; w.x = pk2(v[bj][0], v[bj][1]); w.y = pk2(v[bj][2], v[bj][3]); w.z = pk2(v[bj][4], v[bj][5]); w.w = pk2(v[bj][6], v[bj][7]); *(u32x4*)(dst + 32 * bj) = w; }
        }
      }
  }
  __device__ __forceinline__ void operator()(const f32x4 (&acc)[2][2][4][2], const pg8::Unit& u, int wr, int wc, int fr_in, int fq_in) const {
    int fr = fr_in, fq = fq_in; asm volatile("" : "+v"(fr), "+v"(fq));
    const int gidx = u.pn * 4 + wc;
    if (gidx > 50) return;
    if (gidx < 12) { const float lg2 = log2f(1.f - exp2f(-5.f - (float)(gidx % 6))); rows<0>(acc, u, wr, fr, fq, gidx, (gidx >= 6) ? 0.125f : 1.f, (gidx >= 6) ? -lg2 : lg2, nullptr); }
    else if (gidx < 24) rows<1>(acc, u, wr, fr, fq, gidx, 1.f, 0.f, nullptr);
    else if (gidx < 30) rows<2>(acc, u, wr, fr, fq, gidx, 0.125f * 1.4426950408889634f, 0.f, q_gain);
    else if (gidx == 34 || gidx == 35) rows<2>(acc, u, wr, fr, fq, gidx, 1.f, 0.f, k_gain + 64);
    else if (gidx == 38 || gidx == 39) rows<2>(acc, u, wr, fr, fq, gidx, 1.f, 0.f, k_gain + 128);
    else if (gidx < 42) rows<1>(acc, u, wr, fr, fq, gidx, 1.f, 0.f, nullptr);
    else if (gidx < 46) rows<3>(acc, u, wr, fr, fq, gidx, 1.f, 0.f, nullptr);
    else if (gidx < 50) rows<4>(acc, u, wr, fr, fq, gidx, 1.f, 0.f, nullptr);
    else rows<5>(acc, u, wr, fr, fq, gidx, 1.f, 0.f, nullptr);
  }
};
struct EpiRes {
  static constexpr bool PERM = true, AFTER_DRAIN = false;
  const float* xin32; float* xout32; bf16_t* xb; float* ssq;
  template <bool IN32, bool OUT32>
  __device__ __forceinline__ void rows(const f32x4 (&acc)[2][2][4][2], const pg8::Unit& u, int wr, int wc, int fr, int fq) const {
#pragma unroll
    for (int ai = 0; ai < 2; ++ai)
#pragma unroll
      for (int m = 0; m < 4; ++m) {
        const int row = u.pm * 256 + ai * 128 + wr * 64 + m * 16 + fr;
        float ss = 0.f;
#pragma unroll
        for (int bj = 0; bj < 2; ++bj) {
          const size_t o = (size_t)row * D_ + u.pn * 256 + bj * 128 + wc * 32 + 8 * fq;
          f32x4 x0, x1;
          if (IN32) { x0 = *(const f32x4*)(xin32 + o); x1 = *(const f32x4*)(xin32 + o + 4); }
          else { const u32x4 w = *(const u32x4*)(xb + o); x0 = (f32x4){__uint_as_float(w.x << 16), __uint_as_float(w.x & 0xffff0000u), __uint_as_float(w.y << 16), __uint_as_float(w.y & 0xffff0000u)};
                 x1 = (f32x4){__uint_as_float(w.z << 16), __uint_as_float(w.z & 0xffff0000u), __uint_as_float(w.w << 16), __uint_as_float(w.w & 0xffff0000u)}; }
          const f32x4 y0 = x0 + acc[ai][bj][m][0], y1 = x1 + acc[ai][bj][m][1];
          if (OUT32) { *(f32x4*)(xout32 + o) = y0; *(f32x4*)(xout32 + o + 4) = y1; }
          else { u32x4 w; w.x = pk2(y0[0], y0[1]); w.y = pk2(y0[2], y0[3]); w.z = pk2(y1[0], y1[1]); w.w = pk2(y1[2], y1[3]); *(u32x4*)(xb + o) = w;
            ss += (y0[0] * y0[0] + y0[1] * y0[1]) + (y0[2] * y0[2] + y0[3] * y0[3]) + (y1[0] * y1[0] + y1[1] * y1[1]) + (y1[2] * y1[2] + y1[3] * y1[3]); }
        }
        if (!OUT32) { ss += __shfl_xor(ss, 16); ss += __shfl_xor(ss, 32);
          if (fq == 0) ssq[(size_t)row * 16 + u.pn * 4 + wc] = ss; }
      }
  }
  __device__ __forceinline__ void operator()(const f32x4 (&acc)[2][2][4][2], const pg8::Unit& u, int wr, int wc, int fr_in, int fq_in) const {
    int fr = fr_in, fq = fq_in; asm volatile("" : "+v"(fr), "+v"(fq));
    if (xin32) rows<true, false>(acc, u, wr, wc, fr, fq); else if (xout32) rows<false, true>(acc, u, wr, wc, fr, fq); else rows<false, false>(acc, u, wr, wc, fr, fq);
  }
};
struct EpiGU {
  static constexpr bool PERM = true, AFTER_DRAIN = false;
  const float* ssq; bf16_t* act;
  __device__ __forceinline__ void operator()(const f32x4 (&acc)[2][2][4][2], const pg8::Unit& u, int wr, int wc, int fr_in, int fq_in) const {
    int fr = fr_in, fq = fq_in; asm volatile("" : "+v"(fr), "+v"(fq));
    const float* __restrict__ ssq = this->ssq; bf16_t* __restrict__ act = this->act;
#pragma unroll
    for (int ai = 0; ai < 2; ++ai)
#pragma unroll
      for (int m = 0; m < 4; ++m) {
        const int row = u.pm * 256 + ai * 128 + wr * 64 + m * 16 + fr;
        const float rstd = row_rstd(ssq, row, fq);
        float a[8];
#pragma unroll
        for (int n = 0; n < 2; ++n)
#pragma unroll
          for (int e = 0; e < 4; e += 2) { const float g0 = acc[ai][0][m][n][e] * rstd, u0 = acc[ai][1][m][n][e] * rstd, g1 = acc[ai][0][m][n][e + 1] * rstd, u1 = acc[ai][1][m][n][e + 1] * rstd;
            const float e0 = fminf(__builtin_amdgcn_exp2f(-1.4426950408889634f * g0), 1e15f), e1 = fminf(__builtin_amdgcn_exp2f(-1.4426950408889634f * g1), 1e15f);
            div2(g0 * u0, 1.f + e0, g1 * u1, 1.f + e1, a[4 * n + e], a[4 * n + e + 1]); }
        u32x4 w; w.x = pk2(a[0], a[1]); w.y = pk2(a[2], a[3]); w.z = pk2(a[4], a[5]); w.w = pk2(a[6], a[7]);
        *(u32x4*)(act + (size_t)row * DFF + u.pn * 128 + wc * 32 + 8 * fq) = w;
      }
  }
};

__device__ __forceinline__ void transpose_item(const float* W, int K, int ldw, const float* gain, bf16_t* WT, int v0, int src0, int nvalid, int k0, LAS float* scr, int lane) {
  const int col = lane & 31;
  float wv[32];
#pragma unroll
  for (int i = 0; i < 32; ++i) { const int kk = 2 * i + (lane >> 5); wv[i] = (col < nvalid) ? W[(size_t)(k0 + kk) * ldw + src0 + col] : 0.f; }
#pragma unroll
  for (int i = 0; i < 32; ++i) { const int kk = 2 * i + (lane >> 5); scr[kk * 33 + col] = gain ? wv[i] * gain[k0 + kk] : wv[i]; }
  asm volatile("s_waitcnt lgkmcnt(0)" ::: "memory");
  const int c = lane & 7;
#pragma unroll
  for (int j = 0; j < 4; ++j) { const int n = (lane >> 3) + 8 * j; const LAS float* s = scr + (8 * c) * 33 + n;
    u32x4 o; o.x = pk2(s[0 * 33], s[1 * 33]); o.y = pk2(s[2 * 33], s[3 * 33]); o.z = pk2(s[4 * 33], s[5 * 33]); o.w = pk2(s[6 * 33], s[7 * 33]);
    *(u32x4*)(WT + (size_t)(v0 + n) * K + k0 + 8 * c) = o; }
  asm volatile("s_waitcnt lgkmcnt(0)" ::: "memory");
}
__device__ __forceinline__ void convert_weights(const P& p, LAS unsigned char* lds, int wave, int lane, int gw, int NGW, int it0, int it1) {
  LAS float* scr = (LAS float*)(lds + wave * 16384);
  for (int it = it0 + gw; it < it1; it += NGW) {
    const int layer = it / 6400; int r = it % 6400;
    if (r < 1664) {
      const int vb = r >> 4, kb = r & 15, v0 = vb * 32, pn = v0 >> 8, bj = (v0 >> 7) & 1, wc = (v0 >> 5) & 3, g = pn * 4 + wc;
      int src0 = 0, nvalid = 32;
      if (g < 50) src0 = proj_col0(g) + 32 * bj; else if (g == 50 && bj == 0) { src0 = 2688; nvalid = 18; } else nvalid = 0;
      transpose_item(p.w_in + (size_t)layer * D_ * INW, D_, INW, p.attn_norm + layer * D_, (bf16_t*)(p.ws + OFF_WIN) + (size_t)layer * NPROJ * D_, v0, src0, nvalid, kb * 64, scr, lane);
      continue;
    }
    r -= 1664;
    if (r < 512) { const int vb = r >> 4, kb = r & 15;
      transpose_item(p.w_out + (size_t)layer * D_ * D_, D_, D_, nullptr, (bf16_t*)(p.ws + OFF_WO) + (size_t)layer * D_ * D_, vb * 32, vb * 32, 32, kb * 64, scr, lane); continue; }
    r -= 512;
    if (r < 2816) { const int vb = r >> 4, kb = r & 15, v0 = vb * 32, pn = v0 >> 8, bj = (v0 >> 7) & 1, c0 = v0 & 127;
      transpose_item(p.w_gu + (size_t)layer * D_ * 2 * DFF, D_, 2 * DFF, p.ffn_norm + layer * D_, (bf16_t*)(p.ws + OFF_WGU) + (size_t)layer * 2 * DFF * D_, v0, bj * DFF + 128 * pn + c0, 32, kb * 64, scr, lane); continue; }
    r -= 2816;
    { const int vb = r / 44, kb = r % 44;
      transpose_item(p.w_down + (size_t)layer * DFF * D_, DFF, D_, nullptr, (bf16_t*)(p.ws + OFF_WD) + (size_t)layer * D_ * DFF, vb * 32, vb * 32, 32, kb * 64, scr, lane); }
  }
}
__device__ __forceinline__ void ph_prologue(const Cx& cx, const P& p, LAS unsigned char* lds) {
  const int tid = cx.tid, lane = tid & 63, wave = tid >> 6;
  LAS float* scr = (LAS float*)(lds + wave * 16384);
  const int gw = cx.bid * 8 + wave, NGW = cx.G * 8;
  convert_weights(p, lds, wave, lane, gw, NGW, 0, 1664);
  bf16_t* XB = (bf16_t*)(p.ws + OFF_XB); float* ssq = (float*)(p.ws + OFF_SSQ);
  for (int r = gw; r < M_; r += 2 * NGW) {
    const int r2 = r + NGW;
    const f32x4* xa = (const f32x4*)(p.x + (size_t)r * D_); const f32x4* xb2 = (const f32x4*)(p.x + (size_t)((r2 < M_) ? r2 : r) * D_);
    f32x4 va[4], vb[4];
#pragma unroll
    for (int j = 0; j < 4; ++j) { va[j] = xa[lane + 64 * j]; vb[j] = xb2[lane + 64 * j]; }
    float sa = 0.f, sb = 0.f;
#pragma unroll
    for (int j = 0; j < 4; ++j) { sa += (va[j][0] * va[j][0] + va[j][1] * va[j][1]) + (va[j][2] * va[j][2] + va[j][3] * va[j][3]); sb += (vb[j][0] * vb[j][0] + vb[j][1] * vb[j][1]) + (vb[j][2] * vb[j][2] + vb[j][3] * vb[j][3]);
      *(uint2*)(XB + (size_t)r * D_ + (lane + 64 * j) * 4) = make_uint2(pk2(va[j][0], va[j][1]), pk2(va[j][2], va[j][3]));
      if (r2 < M_) *(uint2*)(XB + (size_t)r2 * D_ + (lane + 64 * j) * 4) = make_uint2(pk2(vb[j][0], vb[j][1]), pk2(vb[j][2], vb[j][3])); }
    sa = wave_sum(sa); sb = wave_sum(sb);
    if (lane < 16) { ssq[(size_t)r * 16 + lane] = (lane == 0) ? sa : 0.f; if (r2 < M_) ssq[(size_t)r2 * 16 + lane] = (lane == 0) ? sb : 0.f; }
  }
  if (cx.bid == 0) for (int i = tid; i < 1024; i += NTHR) ((unsigned*)(p.ws + OFF_CTR))[i] = 0u;
  for (int it = gw; it < 256; it += NGW) { const int mj = it >> 6, vb = (it >> 5) & 1, kb = it & 31;
    transpose_item(p.cmp_w1 + (size_t)mj * 2048 * 64, 2048, 64, nullptr, (bf16_t*)(p.ws + OFF_W1T) + (size_t)mj * 64 * 2048, vb * 32, vb * 32, 32, kb * 64, scr, lane); }
  for (int it = gw; it < 256; it += NGW) { const int mj = it >> 6, f = it & 63; const float* w1 = p.cmp_w1 + (size_t)mj * 2048 * 64 + f; const float* pe = p.cmp_pe + (size_t)mj * 2048;
    float a = 0.f; for (int i = lane; i < 2048; i += 64) a += pe[i] * w1[(size_t)i * 64];
    a = wave_sum(a); if (lane == 0) ((float*)(p.ws + OFF_C1))[it] = a; }
  for (int i = cx.bid * NTHR + tid; i < 6 * 768; i += cx.G * NTHR) { const int hd = i / 768, k = i % 768; float v = 0.f;
    if (k < 115) v = (k == 0) ? -1e30f : p.rel_bias[t5_bucket(k - 1) * 6 + hd] * 1.4426950408889634f;
    else if (k >= 128 && k < 642) { const int kk = k - 128; v = (kk == 0 || kk == 513) ? -1e30f : p.rel_bias[t5_bucket(kk - 1) * 6 + hd] * 1.4426950408889634f; }
    ((float*)(p.ws + OFF_BTAB))[i] = v; }
  for (int i = cx.bid * NTHR + tid; i < 4 * 4096; i += cx.G * NTHR) {
    const int mj = i >> 12, jj = i & 7, ln = (i >> 3) & 63, s2 = (i >> 9) & 1, fb = (i >> 10) & 1, eb = (i >> 11) & 1, r32_ = ln & 31, hi_ = ln >> 5;
    ((bf16_t*)(p.ws + OFF_W2F))[i] = f2bf(p.cmp_w2[(size_t)mj * 4096 + (32 * fb + 16 * s2 + 8 * (jj >> 2) + 4 * hi_ + (jj & 3)) * 64 + 32 * eb + r32_]); }
  for (int i = cx.bid * NTHR + tid; i < 2 * 4 * 128 * 128; i += cx.G * NTHR) { const int tt = (i >> 7) & 127, ss = i & 127; ((bf16_t*)(p.ws + OFF_WSB))[i] = (ss <= tt) ? f2bf(p.gm_ws[i]) : (bf16_t)0; }
  float2* tab = (float2*)(p.ws + OFF_ROPE);
  for (int i = cx.bid * NTHR + tid; i < T_ * 32; i += cx.G * NTHR) {
    const int t = i >> 5, k = i & 31;
    const float inv = powf(10000.0f, -(float)k / 32.0f);
    const float ang = (float)t * inv;
    tab[i] = make_float2(cosf(ang), sinf(ang));
  }
}
namespace att {
using bf16x8 = __attribute__((ext_vector_type(8))) short;
using s16x4 = __attribute__((ext_vector_type(4))) short;
using f32x16 = __attribute__((ext_vector_type(16))) float;
constexpr int NW = 8, QBLK = 32, QB = 256, KVBLK = 64;
constexpr int SLOTB = 8192, LDS_K = 0, LDS_V = 3 * SLOTB, LDS_WS = 6 * SLOTB, LDS_OST = LDS_WS + NW * 256, LDS_TAB = LDS_OST + NW * 8192, LDS_SELW = LDS_TAB + 2304, LDS_END = LDS_SELW + NW * 512;
static_assert(LDS_END <= 131072, "attention LDS");
constexpr float NEGBIG = -1e30f;
#define SBAR() __builtin_amdgcn_sched_barrier(0)
#define PIN(x) asm volatile("" : "+v"(x))
#define MFMA(a, b, c) __builtin_amdgcn_mfma_f32_32x32x16_bf16(a, b, c, 0, 0, 0)
#define WAIT_BAR(N) asm volatile("s_waitcnt vmcnt(" #N ") lgkmcnt(0)\n\ts_barrier" ::: "memory")
__device__ __forceinline__ int crow(int r, int hi) { return (r & 3) + 8 * (r >> 2) + 4 * hi; }
__device__ __forceinline__ unsigned cvtpk(float lo, float hi) { unsigned r; asm("v_cvt_pk_bf16_f32 %0, %1, %2" : "=v"(r) : "v"(lo), "v"(hi)); return r; }
__device__ __forceinline__ void glds16(const void* g, unsigned lds_base) {
  unsigned sv; asm volatile("s_mov_b32 %0, m0\n\ts_mov_b32 m0, %2\n\ts_nop 0\n\tglobal_load_lds_dwordx4 %1, off\n\ts_mov_b32 m0, %0" : "=&s"(sv) : "v"(g), "s"(lds_base) : "memory"); }
typedef __attribute__((address_space(3))) const char* lds_cptr;
typedef short v4i16_t __attribute__((ext_vector_type(4)));
__device__ __forceinline__ void kload2(bf16x8* kf, lds_cptr kp, int d0) { kf[2 * d0] = *(const __attribute__((address_space(3))) bf16x8*)(kp + d0 * 2048); kf[2 * d0 + 1] = *(const __attribute__((address_space(3))) bf16x8*)(kp + d0 * 2048 + 512); }
__device__ __forceinline__ s16x4 vtr(lds_cptr p) { return __builtin_bit_cast(s16x4, __builtin_amdgcn_ds_read_tr16_b64_v4i16((__attribute__((address_space(3))) v4i16_t*)p)); }
#define MX3(a, b, c) __builtin_fmaxf(__builtin_fmaxf((a), (b)), (c))
__device__ __forceinline__ float rowmax(const f32x16& p0, const f32x16& p1) {
  float a = MX3(p0[0], p0[1], p1[0]), b = MX3(p0[2], p0[3], p1[1]); a = MX3(a, p1[2], p1[3]);
#pragma unroll
  for (int r = 4; r < 16; r += 4) { a = MX3(a, p0[r], p0[r + 1]); b = MX3(b, p0[r + 2], p0[r + 3]); a = MX3(a, p1[r], p1[r + 1]); b = MX3(b, p1[r + 2], p1[r + 3]); }
  float m = __builtin_fmaxf(a, b); auto rr = __builtin_amdgcn_permlane32_swap(__float_as_uint(m), __float_as_uint(m), false, false);
  return __builtin_fmaxf(__uint_as_float(rr[0]), __uint_as_float(rr[1])); }
template <int S, int IMAX>
__device__ __forceinline__ void bias_hook(f32x16& p0, f32x16& p1, int dl, const __attribute__((address_space(3))) float* tab) {
#pragma unroll
  for (int r = 0; r < 16; ++r) { const int c = (r & 3) + 8 * (r >> 2); const int d0 = dl - S * c, d1 = d0 - 32 * S;
    p0[r] += tab[1 + min(max(d0, -1), IMAX)]; p1[r] += tab[1 + min(max(d1, -1), IMAX)]; } }

template <int MODE>
__device__ __forceinline__ void nsa_pass(const int tid, const bf16_t* Qrows, const bf16_t* __restrict__ Kt0, const bf16_t* __restrict__ Vt0, const int NT, const int dq, const float b31,
                                         const float* gate, char* lds, const bool first, const bool preK = false, const bf16_t* __restrict__ nextK = nullptr) {
  constexpr int S = (MODE == 2) ? 16 : 1, IMAX = (MODE == 1) ? 512 : 113; constexpr float REF = 8.f;
  const int lane = tid & 63, r32 = lane & 31, hi = lane >> 5; const int wid = __builtin_amdgcn_readfirstlane(tid >> 6);
  const bf16_t* Qw = Qrows + (size_t)(wid * QBLK) * 64;
  const unsigned lds0 = (unsigned)(uintptr_t)lds; float* wsf = (float*)(lds + LDS_WS) + wid * 64;
  const __attribute__((address_space(3))) float* tab = (const __attribute__((address_space(3))) float*)(uintptr_t)(lds0 + LDS_TAB);
  const __attribute__((address_space(3))) unsigned* selw = (const __attribute__((address_space(3))) unsigned*)(uintptr_t)(lds0 + LDS_SELW + wid * 512);
  const bf16_t* ksrc = Kt0 + (size_t)lane * 64 + wid * 8;
  const bf16_t* vsrc = Vt0 + (size_t)(16 * (wid & 3) + (lane >> 2)) * 64 + (wid >> 2) * 32 + (lane & 3) * 8;
  const unsigned kdst = lds0 + LDS_K + wid * 1024, vdst = lds0 + LDS_V + wid * 1024;
#define DMA_K(t, slot) glds16(ksrc + (size_t)(t) * KVBLK * 64, (unsigned)__builtin_amdgcn_readfirstlane(kdst + (slot)))
#define DMA_V(t, slot) glds16(vsrc + (size_t)(t) * KVBLK * 64, (unsigned)__builtin_amdgcn_readfirstlane(vdst + (slot)))
  const lds_cptr vp0 = (lds_cptr)(uintptr_t)lds0 + LDS_V + ((lane >> 4) & 1) * 32 + (lane & 3) * 8 + (4 * hi + ((lane & 15) >> 2)) * 64;
  const lds_cptr kp0 = (lds_cptr)(uintptr_t)lds0 + LDS_K + hi * 1024 + r32 * 16;
  if (!preK) { DMA_K(0, 0); DMA_V(0, 0); DMA_K(1, SLOTB); } else { DMA_V(0, 0); }
  bf16x8 qr[4];
#pragma unroll
  for (int d0 = 0; d0 < 4; ++d0) qr[d0] = *reinterpret_cast<const bf16x8*>(&Qw[(size_t)r32 * 64 + d0 * 16 + hi * 8]);
  float l_reg = 0.f; f32x16 o[2]; o[0] = f32x16{}; o[1] = f32x16{};
  f32x16 zero16 = f32x16{}; PIN(zero16);
  const int qrel = wid * QBLK + r32;
  const int dlq = dq + qrel - S * 4 * hi;
  f32x16 pA0, pA1, pB0, pB1; bf16x8 kf[8]; s16x4 vlo[8], vhi[8]; u32x4 pw0, pw1, pw2, pw3;
  int sl_prev = 0, sl_cur = 0, sl_next = SLOTB;
#define ROT() do { sl_prev = sl_cur; sl_cur = sl_next; sl_next = (sl_next == 2 * SLOTB) ? 0 : sl_next + SLOTB; } while (0)
#define EX(v) __builtin_amdgcn_exp2f((v) + nmh)
#define SELBIT(t) ((MODE == 0) ? (((selw[(t)] >> r32) & 1u) != 0u) : true)
  if (!preK) { DMA_K(2, 2 * SLOTB); WAIT_BAR(3); } else { WAIT_BAR(1); }
  _Pragma("unroll") for (int d0 = 0; d0 < 4; ++d0) kload2(kf, kp0, d0);
  pA0 = MFMA(kf[0], qr[0], zero16); pA1 = MFMA(kf[1], qr[0], zero16); pA0 = MFMA(kf[2], qr[1], pA0); pA1 = MFMA(kf[3], qr[1], pA1);
  pA0 = MFMA(kf[4], qr[2], pA0); pA1 = MFMA(kf[5], qr[2], pA1); pA0 = MFMA(kf[6], qr[3], pA0); pA1 = MFMA(kf[7], qr[3], pA1);
  { const bool band0 = (MODE != 0) || (NT < 8);
    if (band0) bias_hook<S, IMAX>(pA0, pA1, dlq, tab);
    const float bc = band0 ? 0.f : b31; const bool sb = SELBIT(0);
    const float nmh = sb ? bc - REF : NEGBIG;
#pragma unroll
    for (int r = 0; r < 16; ++r) { pA0[r] = EX(pA0[r]); pA1[r] = EX(pA1[r]); } }
  WAIT_BAR(0);
  DMA_K(3, 0); DMA_V(1, SLOTB); ROT();
  _Pragma("unroll") for (int d0 = 0; d0 < 4; ++d0) kload2(kf, kp0 + sl_cur, d0);
  WAIT_BAR(2);
#define PKW(P, i) cvtpk(P[i], P[i + 1])
#define PAF(k) __builtin_bit_cast(bf16x8, pw##k)
#define VFR(i) (bf16x8){vlo[i][0], vlo[i][1], vlo[i][2], vlo[i][3], vhi[i][0], vhi[i][1], vhi[i][2], vhi[i][3]}
#define VRD(i) do { vlo[i] = vtr(vp_ + (((i) >> 2) * 4096 + ((i) & 3) * 1024)); vhi[i] = vtr(vp_ + (((i) >> 2) * 4096 + ((i) & 3) * 1024 + 512)); } while (0)
#define KRD(G, d0) do { if (G) { kload2(kf, kp0 + sl_next, d0); SBAR(); } } while (0)
#define GAPA(MF, a0, a1, a2, a3, W0, W1, PW) do { MF; sacc += a0; sacc += a1; sacc += a2; sacc += a3; W0; W1; PIN(PW); PIN(sacc); SBAR(); } while (0)
#define GAPB(MF, X, i) do { MF; X[i] = EX(X[i]); X[i + 1] = EX(X[i + 1]); X[i + 2] = EX(X[i + 2]); X[i + 3] = EX(X[i + 3]); PIN(X); SBAR(); } while (0)
#define STEP(C0, C1, P0, P1, t, MASK, GK, GV, GL) do { SBAR(); \
    const lds_cptr vp_ = vp0 + sl_prev; \
    VRD(0); SBAR(); float sacc = P0[0] + P0[1]; \
                    GAPA(C0 = MFMA(kf[0], qr[0], zero16), P0[2], P0[3], P0[4], P0[5],     pw0[0] = PKW(P0, 0),  pw0[1] = PKW(P0, 2),  pw0); \
    VRD(4); SBAR(); GAPA(C1 = MFMA(kf[1], qr[0], zero16), P0[6], P0[7], P0[8], P0[9],     pw0[2] = PKW(P0, 4),  pw0[3] = PKW(P0, 6),  pw0); \
    VRD(1); SBAR(); GAPA(C0 = MFMA(kf[2], qr[1], C0),    P0[10], P0[11], P0[12], P0[13], pw1[0] = PKW(P0, 8),  pw1[1] = PKW(P0, 10), pw1); \
    VRD(5); SBAR(); GAPA(C1 = MFMA(kf[3], qr[1], C1),    P0[14], P0[15], P1[0], P1[1],   pw1[2] = PKW(P0, 12), pw1[3] = PKW(P0, 14), pw1); \
    VRD(2); SBAR(); GAPA(C0 = MFMA(kf[4], qr[2], C0),    P1[2], P1[3], P1[4], P1[5],     pw2[0] = PKW(P1, 0),  pw2[1] = PKW(P1, 2),  pw2); \
    VRD(6); SBAR(); GAPA(C1 = MFMA(kf[5], qr[2], C1),    P1[6], P1[7], P1[8], P1[9],     pw2[2] = PKW(P1, 4),  pw2[3] = PKW(P1, 6),  pw2); \
    VRD(3); SBAR(); GAPA(C0 = MFMA(kf[6], qr[3], C0),    P1[10], P1[11], P1[12], P1[13], pw3[0] = PKW(P1, 8),  pw3[1] = PKW(P1, 10), pw3); \
    VRD(7); SBAR(); GAPA(C1 = MFMA(kf[7], qr[3], C1),    P1[14], P1[15], 0.f, 0.f,       pw3[2] = PKW(P1, 12), pw3[3] = PKW(P1, 14), pw3); \
    l_reg += sacc; \
    if (GK) DMA_K((t) + 3, sl_cur); if (GV) DMA_V((t) + 1, sl_next); \
    if (MASK) bias_hook<S, IMAX>(C0, C1, dlq - S * 64 * (t), tab); \
    const float bc_ = (MASK) ? 0.f : b31; const bool sb_ = SELBIT(t); \
    const float nmh = sb_ ? bc_ - REF : NEGBIG; SBAR(); \
    GAPB(o[0] = MFMA(PAF(0), VFR(0), o[0]), C0, 0);              GAPB(o[1] = MFMA(PAF(0), VFR(4), o[1]), C0, 4); \
    KRD(GL, 0); GAPB(o[0] = MFMA(PAF(1), VFR(1), o[0]), C0, 8);  KRD(GL, 1); GAPB(o[1] = MFMA(PAF(1), VFR(5), o[1]), C0, 12); \
    KRD(GL, 2); GAPB(o[0] = MFMA(PAF(2), VFR(2), o[0]), C1, 0);  KRD(GL, 3); GAPB(o[1] = MFMA(PAF(2), VFR(6), o[1]), C1, 4); \
    GAPB(o[0] = MFMA(PAF(3), VFR(3), o[0]), C1, 8);              GAPB(o[1] = MFMA(PAF(3), VFR(7), o[1]), C1, 12); \
    } while (0)
  int t = 1;
  if (MODE == 0) {
    for (; t + 7 < NT; t += 2) {
      STEP(pB0, pB1, pA0, pA1, t, false, true, true, true);     WAIT_BAR(2); ROT();
      STEP(pA0, pA1, pB0, pB1, t + 1, false, true, true, true); WAIT_BAR(2); ROT();
    }
  }
#define ENDW(tt) do { if ((tt) + 3 < NT) { WAIT_BAR(2); } else if ((tt) + 2 < NT) { WAIT_BAR(1); } else { WAIT_BAR(0); } } while (0)
  for (; t + 1 < NT; t += 2) {
    STEP(pB0, pB1, pA0, pA1, t, true, (t + 3 < NT), (t + 1 < NT), (t + 1 < NT));         ENDW(t);     ROT();
    STEP(pA0, pA1, pB0, pB1, t + 1, true, (t + 4 < NT), (t + 2 < NT), (t + 2 < NT));     ENDW(t + 1); ROT();
  }
  if (nextK) { const bf16_t* nk = nextK + (size_t)lane * 64 + wid * 8;
    glds16(nk, (unsigned)__builtin_amdgcn_readfirstlane(kdst)); glds16(nk + 4096, (unsigned)__builtin_amdgcn_readfirstlane(kdst + SLOTB)); glds16(nk + 8192, (unsigned)__builtin_amdgcn_readfirstlane(kdst + 2 * SLOTB)); }
  STEP(pB0, pB1, pA0, pA1, NT - 1, true, false, false, false);
  { float sacc = pB0[0] + pB0[1];
#pragma unroll
    for (int r = 2; r < 16; ++r) sacc += pB0[r];
#pragma unroll
    for (int r = 0; r < 16; ++r) sacc += pB1[r];
    l_reg += sacc;
    pw0 = (u32x4){PKW(pB0, 0), PKW(pB0, 2), PKW(pB0, 4), PKW(pB0, 6)}; pw1 = (u32x4){PKW(pB0, 8), PKW(pB0, 10), PKW(pB0, 12), PKW(pB0, 14)};
    pw2 = (u32x4){PKW(pB1, 0), PKW(pB1, 2), PKW(pB1, 4), PKW(pB1, 6)}; pw3 = (u32x4){PKW(pB1, 8), PKW(pB1, 10), PKW(pB1, 12), PKW(pB1, 14)};
    const lds_cptr vp_ = vp0 + sl_cur; _Pragma("unroll") for (int i = 0; i < 8; ++i) VRD(i);
    o[0] = MFMA(PAF(0), VFR(0), o[0]); o[1] = MFMA(PAF(0), VFR(4), o[1]); o[0] = MFMA(PAF(1), VFR(1), o[0]); o[1] = MFMA(PAF(1), VFR(5), o[1]);
    o[0] = MFMA(PAF(2), VFR(2), o[0]); o[1] = MFMA(PAF(2), VFR(6), o[1]); o[0] = MFMA(PAF(3), VFR(3), o[0]); o[1] = MFMA(PAF(3), VFR(7), o[1]); }
  { auto rr = __builtin_amdgcn_permlane32_swap(__float_as_uint(l_reg), __float_as_uint(l_reg), false, false); l_reg = __uint_as_float(rr[0]) + __uint_as_float(rr[1]); }
  if (hi == 0) wsf[32 + r32] = (l_reg > 0.f) ? gate[(size_t)qrel * 24] / l_reg : 0.f;
  asm volatile("s_waitcnt lgkmcnt(0)" ::: "memory");
  float rli[16];
#pragma unroll
  for (int r = 0; r < 16; ++r) rli[r] = wsf[32 + crow(r, hi)];
  float* stg = (float*)(lds + LDS_OST) + wid * 2048;
  if (first) {
#pragma unroll
    for (int r = 0; r < 16; ++r) { const int orow = crow(r, hi);
#pragma unroll
      for (int d0 = 0; d0 < 2; ++d0) stg[orow * 64 + d0 * 32 + r32] = o[d0][r] * rli[r]; }
  } else {
#pragma unroll
    for (int r = 0; r < 16; ++r) { const int orow = crow(r, hi);
#pragma unroll
      for (int d0 = 0; d0 < 2; ++d0) stg[orow * 64 + d0 * 32 + r32] += o[d0][r] * rli[r]; }
  }
  asm volatile("s_waitcnt lgkmcnt(0)\n\ts_barrier" ::: "memory");
#undef DMA_K
#undef DMA_V
#undef ROT
#undef EX
#undef SELBIT
#undef PKW
#undef PAF
#undef VFR
#undef VRD
#undef KRD
#undef ENDW
#undef GAPA
#undef GAPB
#undef STEP
}
#undef SBAR
#undef PIN
#undef MFMA
#undef WAIT_BAR
#undef MX3
}

#define L2E 1.4426950408889634f
__device__ __forceinline__ void topk_unit(const Cx& cx, const P& p, int layer, int u, char* lds) {
  using att::bf16x8; using att::f32x16;
  const int tid = cx.tid, lane = tid & 63, r32 = lane & 31, hi = lane >> 5, wid = cx.wv, grp = wid & 3, half = wid >> 2;
  const int qb = 63 - (u >> 2), bg = u & 3, b = bg >> 1, g = bg & 1, q0 = qb * 128;
  const int ntile64 = ((((q0 + 127) >> 4) + 1) + 63) >> 6;
  if (tid == 0) hand_wait((unsigned*)(p.ws + OFF_CTR) + 512 + layer * 64 + bg * 16, 16u);
  __syncthreads();
  const bf16_t* KCb = (const bf16_t*)(p.ws + OFF_KC) + (size_t)bg * 512 * 64;
  const unsigned lds0 = (unsigned)(uintptr_t)lds;
  constexpr int L_IMP = 65536, L_LSUM = 131072 + 1024, L_TAB = 139264;
  for (int i = tid; i < ntile64 * 512; i += NTHR) { const int n = i >> 3, c = i & 7; const unsigned long long* q8 = (const unsigned long long*)(KCb + (size_t)n * 64 + c * 8);
    const unsigned long long a = __hip_atomic_load(q8, __ATOMIC_RELAXED, __HIP_MEMORY_SCOPE_AGENT), b2 = __hip_atomic_load(q8 + 1, __ATOMIC_RELAXED, __HIP_MEMORY_SCOPE_AGENT);
    *(u32x4*)(lds + (n >> 6) * 8192 + c * 1024 + (n & 63) * 16) = (u32x4){(unsigned)a, (unsigned)(a >> 32), (unsigned)b2, (unsigned)(b2 >> 32)}; }
  float* tabw = (float*)(lds + L_TAB);
  for (int i = tid; i < 3 * 115; i += NTHR) { const int h = i / 115, k = i % 115; tabw[i] = ((const float*)(p.ws + OFF_BTAB))[(g * 3 + h) * 768 + k]; }
  float* impw = (float*)(lds + L_IMP) + wid * 2048;
#pragma unroll
  for (int s2 = 0; s2 < 32; ++s2) impw[s2 * 64 + lane] = 0.f;
  __syncthreads();
  const __attribute__((address_space(3))) float* tab = (const __attribute__((address_space(3))) float*)(uintptr_t)(lds0 + L_TAB);
  const att::lds_cptr kp0 = (att::lds_cptr)(uintptr_t)lds0 + hi * 1024 + r32 * 16;
  const int tq0 = q0 + grp * 32, t = tq0 + r32, cur = tq0 >> 6;
  const int NT32 = ((tq0 >> 4) + 1 + 31) >> 5;
  const int Th = (NT32 + 1) >> 1, T0 = half ? Th : 0, T1 = half ? NT32 : Th;
  const int nfar = (tq0 - 144) >> 4;
  const int Tnear0 = (nfar >= 31) ? ((nfar - 31) >> 5) + 1 : 0;
  const bf16_t* HB = (const bf16_t*)(p.ws + OFF_HB);
  float b31[3];
#pragma unroll
  for (int h = 0; h < 3; ++h) b31[h] = p.rel_bias[31 * 6 + g * 3 + h] * L2E;
  const int dl0 = t - 31 - 64 * hi;
  f32x16 zero16 = f32x16{}; asm volatile("" : "+v"(zero16));
#define TK_SCORES(T, h, sv) do { const att::lds_cptr kp_ = kp0 + ((T) >> 1) * 8192 + ((T) & 1) * 512; \
    const bf16x8 k0_ = *(const __attribute__((address_space(3))) bf16x8*)(kp_), k1_ = *(const __attribute__((address_space(3))) bf16x8*)(kp_ + 2048), \
                 k2_ = *(const __attribute__((address_space(3))) bf16x8*)(kp_ + 4096), k3_ = *(const __attribute__((address_space(3))) bf16x8*)(kp_ + 6144); \
    sv = __builtin_amdgcn_mfma_f32_32x32x16_bf16(k0_, qr[0], zero16, 0, 0, 0); sv = __builtin_amdgcn_mfma_f32_32x32x16_bf16(k1_, qr[1], sv, 0, 0, 0); \
    sv = __builtin_amdgcn_mfma_f32_32x32x16_bf16(k2_, qr[2], sv, 0, 0, 0); sv = __builtin_amdgcn_mfma_f32_32x32x16_bf16(k3_, qr[3], sv, 0, 0, 0); \
    if ((T) >= Tnear0) { const int dl_ = dl0 - 512 * (T); _Pragma("unroll") for (int r = 0; r < 16; ++r) { const int c_ = (r & 3) + 8 * (r >> 2); sv[r] = __builtin_amdgcn_exp2f(sv[r] + tab[(h) * 115 + 1 + min(max(dl_ - 16 * c_, -1), 113)]); } } \
    else { _Pragma("unroll") for (int r = 0; r < 16; ++r) sv[r] = __builtin_amdgcn_exp2f(sv[r] + b31[h]); } } while (0)
  float U[3][32]; float l[3];
#pragma unroll
  for (int h = 0; h < 3; ++h) {
    const bf16_t* Qh = HB + ((size_t)(24 + g * 3 + h) * M_ + (size_t)b * T_ + tq0) * 64;
    bf16x8 qr[4];
#pragma unroll
    for (int d0 = 0; d0 < 4; ++d0) qr[d0] = *reinterpret_cast<const bf16x8*>(Qh + (size_t)r32 * 64 + d0 * 16 + hi * 8);
    float lh = 0.f, carry = 0.f;
    if (half == 1 && T0 < T1) { f32x16 sv; TK_SCORES(T0 - 1, h, sv); carry = __shfl_xor(sv[15], 32); }
#define TK_FINISH(tt_, sv_) do { float body[4], pt[4], a_ = 0.f; \
        _Pragma("unroll") for (int g4 = 0; g4 < 4; ++g4) { const float s3 = (sv_[4 * g4] + sv_[4 * g4 + 1]) + sv_[4 * g4 + 2]; body[g4] = 2.f * s3 + sv_[4 * g4 + 3]; a_ += s3 + sv_[4 * g4 + 3]; } \
        lh += a_; \
        _Pragma("unroll") for (int k = 0; k < 4; ++k) pt[k] = __shfl_xor(sv_[4 * k + 3], 32); \
        U[h][(tt_) * 4 + 0] = body[0] + (hi ? pt[0] : carry); U[h][(tt_) * 4 + 1] = body[1] + (hi ? pt[1] : pt[0]); \
        U[h][(tt_) * 4 + 2] = body[2] + (hi ? pt[2] : pt[1]); U[h][(tt_) * 4 + 3] = body[3] + (hi ? pt[3] : pt[2]); \
        carry = pt[3]; } while (0)
#pragma unroll
    for (int tp = 0; tp < 4; ++tp) {
      const int T = T0 + 2 * tp;
      if (T + 1 < T1 && T + 1 < Tnear0) {
        const att::lds_cptr ka_ = kp0 + (T >> 1) * 8192 + (T & 1) * 512, kb_ = kp0 + ((T + 1) >> 1) * 8192 + ((T + 1) & 1) * 512;
        f32x16 sa, sb;
        { const bf16x8 a0 = *(const __attribute__((address_space(3))) bf16x8*)(ka_), a1 = *(const __attribute__((address_space(3))) bf16x8*)(ka_ + 2048), a2 = *(const __attribute__((address_space(3))) bf16x8*)(ka_ + 4096), a3 = *(const __attribute__((address_space(3))) bf16x8*)(ka_ + 6144);
          const bf16x8 b0 = *(const __attribute__((address_space(3))) bf16x8*)(kb_), b1 = *(const __attribute__((address_space(3))) bf16x8*)(kb_ + 2048), b2 = *(const __attribute__((address_space(3))) bf16x8*)(kb_ + 4096), b3 = *(const __attribute__((address_space(3))) bf16x8*)(kb_ + 6144);
          sa = __builtin_amdgcn_mfma_f32_32x32x16_bf16(a0, qr[0], zero16, 0, 0, 0); sb = __builtin_amdgcn_mfma_f32_32x32x16_bf16(b0, qr[0], zero16, 0, 0, 0);
          sa = __builtin_amdgcn_mfma_f32_32x32x16_bf16(a1, qr[1], sa, 0, 0, 0);     sb = __builtin_amdgcn_mfma_f32_32x32x16_bf16(b1, qr[1], sb, 0, 0, 0);
          sa = __builtin_amdgcn_mfma_f32_32x32x16_bf16(a2, qr[2], sa, 0, 0, 0);     sb = __builtin_amdgcn_mfma_f32_32x32x16_bf16(b2, qr[2], sb, 0, 0, 0);
          sa = __builtin_amdgcn_mfma_f32_32x32x16_bf16(a3, qr[3], sa, 0, 0, 0);     sb = __builtin_amdgcn_mfma_f32_32x32x16_bf16(b3, qr[3], sb, 0, 0, 0); }
#pragma unroll
        for (int r = 0; r < 16; ++r) { sa[r] = __builtin_amdgcn_exp2f(sa[r] + b31[h]); sb[r] = __builtin_amdgcn_exp2f(sb[r] + b31[h]); }
        TK_FINISH(2 * tp, sa); TK_FINISH(2 * tp + 1, sb);
      } else {
        if (T < T1) { f32x16 sv; TK_SCORES(T, h, sv); TK_FINISH(2 * tp, sv); }
        else { U[h][tp * 8 + 0] = 0.f; U[h][tp * 8 + 1] = 0.f; U[h][tp * 8 + 2] = 0.f; U[h][tp * 8 + 3] = 0.f; }
        if (T + 1 < T1) { f32x16 sv; TK_SCORES(T + 1, h, sv); TK_FINISH(2 * tp + 1, sv); }
        else { U[h][tp * 8 + 4] = 0.f; U[h][tp * 8 + 5] = 0.f; U[h][tp * 8 + 6] = 0.f; U[h][tp * 8 + 7] = 0.f; }
      }
    }
#undef TK_FINISH
    l[h] = lh;
  }
  { float* ls = (float*)(lds + L_LSUM);
#pragma unroll
    for (int h = 0; h < 3; ++h) ls[((grp * 2 + half) * 3 + h) * 64 + lane] = l[h]; }
  __syncthreads();
  { const float* ls = (const float*)(lds + L_LSUM); float rl[3];
#pragma unroll
    for (int h = 0; h < 3; ++h) { float lt = ls[((grp * 2 + 0) * 3 + h) * 64 + lane] + ls[((grp * 2 + 1) * 3 + h) * 64 + lane]; lt += __shfl_xor(lt, 32); rl[h] = (lt > 0.f) ? 1.f / lt : 0.f; }
#pragma unroll
    for (int i = 0; i < 32; ++i) impw[i * 64 + lane] = (U[0][i] * rl[0] + U[1][i] * rl[1]) + U[2][i] * rl[2]; }
#undef TK_SCORES
  __syncthreads();
  {
    const int qq = 16 * half + (lane & 15), part = lane >> 4, srcw = part >> 1, shi = part & 1;
    const float* ip = (const float*)(lds + L_IMP) + (grp + 4 * srcw) * 2048 + qq + 32 * shi;
    const int tbase = srcw ? Th : 0;
    unsigned v[32];
#pragma unroll
    for (int i = 0; i < 32; ++i) { const int j = 8 * (tbase + (i >> 2)) + 2 * (i & 3) + shi; v[i] = (j >= 1 && j <= cur - 2) ? __float_as_uint(ip[i * 64]) : 0u; }
    unsigned tau = 0u;
    if (cur >= 16) {
      unsigned thr = 0x7fffffffu;
#pragma unroll 1
      for (int rnd = 0; rnd < 13; ++rnd) {
        unsigned m0 = 0u, m1 = 0u, m2 = 0u, m3 = 0u;
#pragma unroll
        for (int i = 0; i < 32; i += 4) { m0 = max(m0, (v[i] < thr) ? v[i] : 0u); m1 = max(m1, (v[i + 1] < thr) ? v[i + 1] : 0u); m2 = max(m2, (v[i + 2] < thr) ? v[i + 2] : 0u); m3 = max(m3, (v[i + 3] < thr) ? v[i + 3] : 0u); }
        unsigned m = max(max(m0, m1), max(m2, m3));
        m = max(m, (unsigned)__shfl_xor((int)m, 16)); m = max(m, (unsigned)__shfl_xor((int)m, 32));
        thr = m;
      }
      tau = thr;
    }
    unsigned w0 = 0u, w1 = 0u, w2 = 0u, w3 = 0u;
#pragma unroll
    for (int i = 0; i < 32; ++i) { const int j = 8 * (tbase + (i >> 2)) + 2 * (i & 3) + shi;
      const bool ok = (j >= 1 && j <= cur - 2) && (v[i] >= tau); const unsigned m = ok ? (1u << (j & 31)) : 0u; const int wq = j >> 5;
      w0 |= (wq == 0) ? m : 0u; w1 |= (wq == 1) ? m : 0u; w2 |= (wq == 2) ? m : 0u; w3 |= (wq == 3) ? m : 0u; }
    w0 |= (unsigned)__shfl_xor((int)w0, 16); w1 |= (unsigned)__shfl_xor((int)w1, 16); w2 |= (unsigned)__shfl_xor((int)w2, 16); w3 |= (unsigned)__shfl_xor((int)w3, 16);
    w0 |= (unsigned)__shfl_xor((int)w0, 32); w1 |= (unsigned)__shfl_xor((int)w1, 32); w2 |= (unsigned)__shfl_xor((int)w2, 32); w3 |= (unsigned)__shfl_xor((int)w3, 32);
#pragma unroll
    for (int f = 0; f < 3; ++f) { const int jf = (f == 0) ? 0 : (f == 1) ? cur - 1 : cur; if (jf >= 0) { const unsigned m = 1u << (jf & 31); const int wq = jf >> 5;
        w0 |= (wq == 0) ? m : 0u; w1 |= (wq == 1) ? m : 0u; w2 |= (wq == 2) ? m : 0u; w3 |= (wq == 3) ? m : 0u; } }
    if (part == 0) *(uint4*)((unsigned*)(p.ws + OFF_SELQ) + ((size_t)bg * T_ + tq0 + qq) * 4) = make_uint4(w0, w1, w2, w3);
  }
  __syncthreads();
}
__device__ __forceinline__ void nsa_unit(const Cx& cx, const P& p, int u, char* lds) {
  const int tid = cx.tid, lane = tid & 63, r32 = lane & 31, wid = tid >> 6;
  const int qb = 31 - u / 12, bgh = u % 12, b = bgh / 6, g = (bgh / 3) & 1, h = bgh % 3, head = g * 3 + h;
  const size_t rowb = (size_t)b * T_; const int q0 = qb * 256;
  const bf16_t* HB = (const bf16_t*)(p.ws + OFF_HB);
  const bf16_t* Qrows = HB + ((size_t)(24 + head) * M_ + rowb + q0) * 64;
  const float* gate0 = (const float*)(p.ws + OFF_GATES) + (rowb + q0) * 24 + head * 3;
  float* tabw = (float*)(lds + att::LDS_TAB);
  const float b31 = p.rel_bias[31 * 6 + head] * L2E;
  { const uint4 mq = *(const uint4*)((const unsigned*)(p.ws + OFF_SELQ) + ((size_t)(b * 2 + g) * T_ + q0 + wid * 32 + r32) * 4);
    unsigned* sw = (unsigned*)(lds + att::LDS_SELW) + wid * 128;
    const int nblk = 4 * qb + 4;
#pragma unroll
    for (int w4 = 0; w4 < 4; ++w4) { const unsigned w = (w4 == 0) ? mq.x : (w4 == 1) ? mq.y : (w4 == 2) ? mq.z : mq.w;
      if (32 * w4 < nblk) { for (int j = 0; j < 32; ++j) { const unsigned long long bal = __ballot((w >> j) & 1u); if (lane == 0) sw[32 * w4 + j] = (unsigned)bal; } } } }
  const float* btab = (const float*)(p.ws + OFF_BTAB) + head * 768;
  if (tid < 115) tabw[tid] = btab[tid];
  const int t0w = (qb >= 2) ? 4 * qb - 8 : 0;
  const bf16_t* Kwin = HB + ((size_t)(38 + g) * M_ + rowb + 64 * t0w) * 64; const bf16_t* Kcmp = (const bf16_t*)(p.ws + OFF_KC) + (size_t)(b * 2 + g) * 512 * 64;
  att::nsa_pass<0>(tid, Qrows, HB + ((size_t)(34 + g) * M_ + rowb) * 64, HB + ((size_t)(36 + g) * M_ + rowb) * 64, 4 * qb + 4, q0, b31, gate0 + 1, lds, true, false, Kwin);
  for (int i = tid; i < 514; i += NTHR) tabw[i] = btab[128 + i];
  { const int t0 = (qb >= 2) ? 4 * qb - 8 : 0;
    att::nsa_pass<1>(tid, Qrows, HB + ((size_t)(38 + g) * M_ + rowb + 64 * t0) * 64, HB + ((size_t)(40 + g) * M_ + rowb + 64 * t0) * 64, 4 * qb + 4 - t0, q0 - 64 * t0, b31, gate0 + 2, lds, false, true, Kcmp); }
  if (tid < 115) tabw[tid] = btab[tid];
  { const int nt = (qb < 16) ? 4 : (qb < 24) ? 6 : 8;
    att::nsa_pass<2>(tid, Qrows, (const bf16_t*)(p.ws + OFF_KC) + (size_t)(b * 2 + g) * 512 * 64, (const bf16_t*)(p.ws + OFF_VC) + (size_t)(b * 2 + g) * 512 * 64, nt, q0 - 31, b31, gate0, lds, false, true, nullptr); }
  { const float* stg = (const float*)(lds + att::LDS_OST) + wid * 2048;
    bf16_t* mixw = (bf16_t*)(p.ws + OFF_MIX) + (rowb + q0 + wid * 32) * D_ + 384 + head * 64;
#pragma unroll
    for (int i = 0; i < 4; ++i) { const int row = i * 8 + (lane >> 3), ch = lane & 7;
      const f32x4 a0 = *(const f32x4*)(stg + row * 64 + ch * 8), a1 = *(const f32x4*)(stg + row * 64 + ch * 8 + 4);
      u32x4 w; w.x = pk2(a0[0], a0[1]); w.y = pk2(a0[2], a0[3]); w.z = pk2(a1[0], a1[1]); w.w = pk2(a1[2], a1[3]);
      *(u32x4*)(mixw + (size_t)row * D_ + ch * 8) = w; }
    asm volatile("s_waitcnt lgkmcnt(0)\n\ts_barrier" ::: "memory"); }
}
namespace mx {
using att::bf16x8; using att::s16x4; using att::f32x16; using att::lds_cptr;
#define MX_MFMA(a, b, c) __builtin_amdgcn_mfma_f32_32x32x16_bf16(a, b, c, 0, 0, 0)
__device__ __forceinline__ void dma_k_tile(const bf16_t* src, unsigned ldsaddr, int lane, int wid) { att::glds16(src + (size_t)lane * 64 + wid * 8, (unsigned)__builtin_amdgcn_readfirstlane(ldsaddr + wid * 1024)); }
__device__ __forceinline__ void dma_v_tile(const bf16_t* src, unsigned ldsaddr, int lane, int wid) { att::glds16(src + (size_t)(16 * (wid & 3) + (lane >> 2)) * 64 + (wid >> 2) * 32 + (lane & 3) * 8, (unsigned)__builtin_amdgcn_readfirstlane(ldsaddr + wid * 1024)); }
__device__ __forceinline__ int vlane_off(int lane) { return ((lane >> 4) & 1) * 32 + (lane & 3) * 8 + (4 * (lane >> 5) + ((lane & 15) >> 2)) * 64; }
__device__ __forceinline__ bf16x8 vfrag(lds_cptr vp, int i) { const s16x4 lo = att::vtr(vp + (i >> 2) * 4096 + (i & 3) * 1024), hi = att::vtr(vp + (i >> 2) * 4096 + (i & 3) * 1024 + 512);
  return (bf16x8){lo[0], lo[1], lo[2], lo[3], hi[0], hi[1], hi[2], hi[3]}; }
__device__ __forceinline__ bf16x8 kfrag(lds_cptr kp, int d0, int n) { return *(const __attribute__((address_space(3))) bf16x8*)(kp + d0 * 2048 + n * 512); }
#define MX_WAIT_ALL() asm volatile("s_waitcnt vmcnt(0) lgkmcnt(0)\n\ts_barrier" ::: "memory")
__device__ __forceinline__ float loggamma2(int h) { return log2f(1.f - exp2f(-5.f - (float)h)); }

__device__ __forceinline__ void ret_kv_unit(const Cx& cx, const P& p, int layer, int u, char* lds) {
  const int tid = cx.tid, lane = tid & 63, r32 = lane & 31, hi = lane >> 5, wid = cx.wv;
  const int bh = u >> 5, cp = u & 31, b = bh / 6, h = bh % 6;
  const size_t r0 = (size_t)b * T_ + cp * 256;
  const bf16_t* HB = (const bf16_t*)(p.ws + OFF_HB);
  const bf16_t* Kp = HB + ((size_t)(6 + h) * M_ + r0) * 64; const bf16_t* Vp = HB + ((size_t)(12 + h) * M_ + r0) * 64;
  const unsigned lds0 = (unsigned)(uintptr_t)lds;
#pragma unroll
  for (int i = 0; i < 4; ++i) { dma_v_tile(Vp + (size_t)i * 4096, lds0 + i * 8192, lane, wid); dma_v_tile(Kp + (size_t)i * 4096, lds0 + 32768 + i * 8192, lane, wid); }
  MX_WAIT_ALL();
  const int ch = wid >> 2, eb = (wid >> 1) & 1, db = wid & 1;
  f32x16 acc = f32x16{};
#pragma unroll
  for (int kt = 0; kt < 2; ++kt) { const lds_cptr vv = (lds_cptr)(uintptr_t)(lds0 + (ch * 2 + kt) * 8192) + vlane_off(lane), vk = vv + 32768;
#pragma unroll
    for (int ks = 0; ks < 4; ++ks) acc = MX_MFMA(vfrag(vv, 4 * eb + ks), vfrag(vk, 4 * db + ks), acc); }
  const float sc = exp2f(127.f * loggamma2(h));
  float* ST = (float*)(p.ws + OFF_RS) + ((size_t)bh * 64 + cp * 2 + ch) * 4096;
#pragma unroll
  for (int r = 0; r < 16; ++r) __hip_atomic_store(ST + (32 * eb + att::crow(r, hi)) * 64 + 32 * db + r32, acc[r] * sc, __ATOMIC_RELAXED, __HIP_MEMORY_SCOPE_AGENT);
  MX_WAIT_ALL();
  if (tid == 0) hand_publish((unsigned*)(p.ws + OFF_CTR) + 768 + layer * 64);
}
__device__ __forceinline__ void ret_scan(const Cx& cx, const P& p) {
  const float* __restrict__ ST = (const float*)(p.ws + OFF_RS); bf16_t* __restrict__ RT = (bf16_t*)(p.ws + OFF_RT);
  for (int i = cx.bid * NTHR + cx.tid; i < 12 * 4096; i += cx.G * NTHR) {
    const int bh = i >> 12, ed = i & 4095, h = bh % 6; const float lg = loggamma2(h), cd = exp2f(128.f * lg), g1 = exp2f(lg);
    const size_t o0 = (size_t)bh * 64 * 4096 + ed;
    float R = 0.f;
#pragma unroll
    for (int c0 = 0; c0 < 64; c0 += 16) {
      float kv[16];
#pragma unroll
      for (int k = 0; k < 16; ++k) kv[k] = __hip_atomic_load(ST + o0 + (size_t)(c0 + k) * 4096, __ATOMIC_RELAXED, __HIP_MEMORY_SCOPE_AGENT);
#pragma unroll
      for (int k = 0; k < 16; ++k) { RT[o0 + (size_t)(c0 + k) * 4096] = f2bf(R * g1); R = cd * R + kv[k]; }
    }
  }
}
__device__ __forceinline__ void ret_out_unit(const Cx& cx, const P& p, int u, char* lds) {
  const int tid = cx.tid, lane = tid & 63, r32 = lane & 31, hi = lane >> 5, wid = cx.wv;
  const int bh = u >> 5, cp = u & 31, b = bh / 6, h = bh % 6;
  const size_t r0 = (size_t)b * T_ + cp * 256;
  const bf16_t* HB = (const bf16_t*)(p.ws + OFF_HB);
  const bf16_t* Qp = HB + ((size_t)(0 + h) * M_ + r0) * 64; const bf16_t* Kp = HB + ((size_t)(6 + h) * M_ + r0) * 64;
  const bf16_t* Vp = HB + ((size_t)(12 + h) * M_ + r0) * 64; const bf16_t* Gp = HB + ((size_t)(18 + h) * M_ + r0) * 64;
  const unsigned lds0 = (unsigned)(uintptr_t)lds;
#pragma unroll
  for (int i = 0; i < 4; ++i) { dma_k_tile(Kp + (size_t)i * 4096, lds0 + i * 8192, lane, wid); dma_v_tile(Vp + (size_t)i * 4096, lds0 + 32768 + i * 8192, lane, wid); }
  const int ch = wid >> 2, rt = wid & 3, rw = ch * 128 + rt * 32;
  bf16x8 qr[4], rtf[2][4];
  const bf16_t* RT = (const bf16_t*)(p.ws + OFF_RT) + ((size_t)bh * 64 + cp * 2 + ch) * 4096;
#pragma unroll
  for (int d0 = 0; d0 < 4; ++d0) qr[d0] = *reinterpret_cast<const bf16x8*>(Qp + (size_t)(rw + r32) * 64 + d0 * 16 + hi * 8);
#pragma unroll
  for (int eb = 0; eb < 2; ++eb)
#pragma unroll
    for (int ks = 0; ks < 4; ++ks) rtf[eb][ks] = *reinterpret_cast<const bf16x8*>(RT + (size_t)(32 * eb + r32) * 64 + 16 * ks + 8 * hi);
  u32x4 gwv[4];
#pragma unroll
  for (int i = 0; i < 4; ++i) gwv[i] = *(const u32x4*)(Gp + (size_t)(rw + i * 8 + (lane >> 3)) * 64 + (lane & 7) * 8);
  MX_WAIT_ALL();
  f32x16 o[2]; o[0] = f32x16{}; o[1] = f32x16{};
  const f32x16 zero16 = f32x16{};
  const int n = rt * 32 + r32;
  for (int kt = 0; kt <= (rt >> 1); ++kt) {
    const int tile = ch * 2 + kt;
    const lds_cptr kp = (lds_cptr)(uintptr_t)(lds0 + tile * 8192) + hi * 1024 + r32 * 16;
    f32x16 p0 = MX_MFMA(kfrag(kp, 0, 0), qr[0], zero16), p1 = MX_MFMA(kfrag(kp, 0, 1), qr[0], zero16);
#pragma unroll
    for (int d0 = 1; d0 < 4; ++d0) { p0 = MX_MFMA(kfrag(kp, d0, 0), qr[d0], p0); p1 = MX_MFMA(kfrag(kp, d0, 1), qr[d0], p1); }
    if (kt == (rt >> 1)) {
#pragma unroll
      for (int r = 0; r < 16; ++r) { const int m = 64 * kt + att::crow(r, hi); if (m > n) p0[r] = 0.f; if (m + 32 > n) p1[r] = 0.f; }
    }
    u32x4 pw0, pw1, pw2, pw3;
    pw0 = (u32x4){att::cvtpk(p0[0], p0[1]), att::cvtpk(p0[2], p0[3]), att::cvtpk(p0[4], p0[5]), att::cvtpk(p0[6], p0[7])};
    pw1 = (u32x4){att::cvtpk(p0[8], p0[9]), att::cvtpk(p0[10], p0[11]), att::cvtpk(p0[12], p0[13]), att::cvtpk(p0[14], p0[15])};
    pw2 = (u32x4){att::cvtpk(p1[0], p1[1]), att::cvtpk(p1[2], p1[3]), att::cvtpk(p1[4], p1[5]), att::cvtpk(p1[6], p1[7])};
    pw3 = (u32x4){att::cvtpk(p1[8], p1[9]), att::cvtpk(p1[10], p1[11]), att::cvtpk(p1[12], p1[13]), att::cvtpk(p1[14], p1[15])};
    const lds_cptr vp = (lds_cptr)(uintptr_t)(lds0 + 32768 + tile * 8192) + vlane_off(lane);
#pragma unroll
    for (int d0 = 0; d0 < 2; ++d0) {
      o[d0] = MX_MFMA(__builtin_bit_cast(bf16x8, pw0), vfrag(vp, 4 * d0 + 0), o[d0]); o[d0] = MX_MFMA(__builtin_bit_cast(bf16x8, pw1), vfrag(vp, 4 * d0 + 1), o[d0]);
      o[d0] = MX_MFMA(__builtin_bit_cast(bf16x8, pw2), vfrag(vp, 4 * d0 + 2), o[d0]); o[d0] = MX_MFMA(__builtin_bit_cast(bf16x8, pw3), vfrag(vp, 4 * d0 + 3), o[d0]); }
  }
#pragma unroll
  for (int eb = 0; eb < 2; ++eb)
#pragma unroll
    for (int ks = 0; ks < 4; ++ks) o[eb] = MX_MFMA(qr[ks], rtf[eb][ks], o[eb]);
  float* stg = (float*)(lds + 65536) + wid * 2048;
#pragma unroll
  for (int r = 0; r < 16; ++r) { const int orow = att::crow(r, hi); stg[orow * 64 + r32] = o[0][r]; stg[orow * 64 + 32 + r32] = o[1][r]; }
  asm volatile("s_waitcnt lgkmcnt(0)" ::: "memory");
  bf16_t* mix = (bf16_t*)(p.ws + OFF_MIX) + (r0 + rw) * D_ + h * 64;
#pragma unroll
  for (int i = 0; i < 4; ++i) { const int row = i * 8 + (lane >> 3), c8 = lane & 7;
    const f32x4 a0 = *(const f32x4*)(stg + row * 64 + c8 * 8), a1 = *(const f32x4*)(stg + row * 64 + c8 * 8 + 4);
    float ss = (a0[0] * a0[0] + a0[1] * a0[1]) + (a0[2] * a0[2] + a0[3] * a0[3]) + (a1[0] * a1[0] + a1[1] * a1[1]) + (a1[2] * a1[2] + a1[3] * a1[3]);
    ss += __shfl_xor(ss, 1); ss += __shfl_xor(ss, 2); ss += __shfl_xor(ss, 4);
    const float rs = rsqrtf(ss * (1.f / 64.f) + EPS);
    const u32x4 gw = gwv[i];
    float gv[8] = {__uint_as_float(gw.x << 16), __uint_as_float(gw.x & 0xffff0000u), __uint_as_float(gw.y << 16), __uint_as_float(gw.y & 0xffff0000u),
                   __uint_as_float(gw.z << 16), __uint_as_float(gw.z & 0xffff0000u), __uint_as_float(gw.w << 16), __uint_as_float(gw.w & 0xffff0000u)};
    float ov[8] = {a0[0], a0[1], a0[2], a0[3], a1[0], a1[1], a1[2], a1[3]};
#pragma unroll
    for (int k = 0; k < 8; ++k) ov[k] = ov[k] * rs * (gv[k] * sigmoidf(gv[k]));
    u32x4 w; w.x = pk2(ov[0], ov[1]); w.y = pk2(ov[2], ov[3]); w.z = pk2(ov[4], ov[5]); w.w = pk2(ov[6], ov[7]);
    *(u32x4*)(mix + (size_t)row * D_ + c8 * 8) = w; }
  MX_WAIT_ALL();
}
__device__ __forceinline__ void gmlp_unit(const Cx& cx, const P& p, int layer, int u, char* lds) {
  const int tid = cx.tid, lane = tid & 63, r32 = lane & 31, hi = lane >> 5, wid = cx.wv;
  const int g = u & 3, bc = u >> 2; const size_t r0 = (size_t)bc * 128;
  const bf16_t* HB = (const bf16_t*)(p.ws + OFF_HB);
  const bf16_t* Up = HB + ((size_t)(42 + g) * M_ + r0) * 64; const bf16_t* Vp = HB + ((size_t)(46 + g) * M_ + r0) * 64;
  const unsigned lds0 = (unsigned)(uintptr_t)lds;
  dma_v_tile(Vp, lds0, lane, wid); dma_v_tile(Vp + 4096, lds0 + 8192, lane, wid);
  const int rt = wid & 3, dh = wid >> 2;
  const bf16_t* Wr = (const bf16_t*)(p.ws + OFF_WSB) + ((size_t)(layer * 4 + g) * 128 + rt * 32 + r32) * 128;
  u32x4 uwv[2]; float bsv[2];
#pragma unroll
  for (int i = 0; i < 2; ++i) { const int t = rt * 32 + i * 16 + (lane >> 2); uwv[i] = *(const u32x4*)(Up + (size_t)t * 64 + dh * 32 + (lane & 3) * 8); bsv[i] = p.gm_b[(layer * 4 + g) * 128 + t]; }
  MX_WAIT_ALL();
  f32x16 acc = f32x16{};
  for (int ks = 0; ks < 2 * rt + 2; ++ks) {
    const uint2 alo = *(const uint2*)(Wr + 16 * ks + 4 * hi), ahi = *(const uint2*)(Wr + 16 * ks + 8 + 4 * hi);
    const u32x4 aw = (u32x4){alo.x, alo.y, ahi.x, ahi.y};
    const lds_cptr vp = (lds_cptr)(uintptr_t)(lds0 + (ks >> 2) * 8192) + vlane_off(lane);
    acc = MX_MFMA(__builtin_bit_cast(bf16x8, aw), vfrag(vp, 4 * dh + (ks & 3)), acc);
  }
  float* stg = (float*)(lds + 16384) + wid * 1024;
#pragma unroll
  for (int r = 0; r < 16; ++r) stg[att::crow(r, hi) * 32 + r32] = acc[r];
  asm volatile("s_waitcnt lgkmcnt(0)" ::: "memory");
  bf16_t* mix = (bf16_t*)(p.ws + OFF_MIX) + (r0 + rt * 32) * D_ + 768 + g * 64 + dh * 32;
#pragma unroll
  for (int i = 0; i < 2; ++i) { const int row = i * 16 + (lane >> 2), c8 = lane & 3, t = rt * 32 + row;
    const f32x4 a0 = *(const f32x4*)(stg + row * 32 + c8 * 8), a1 = *(const f32x4*)(stg + row * 32 + c8 * 8 + 4);
    const float bias = bsv[i];
    const u32x4 uw = uwv[i];
    u32x4 w; w.x = pk2(__uint_as_float(uw.x << 16) * (a0[0] + bias), __uint_as_float(uw.x & 0xffff0000u) * (a0[1] + bias));
    w.y = pk2(__uint_as_float(uw.y << 16) * (a0[2] + bias), __uint_as_float(uw.y & 0xffff0000u) * (a0[3] + bias));
    w.z = pk2(__uint_as_float(uw.z << 16) * (a1[0] + bias), __uint_as_float(uw.z & 0xffff0000u) * (a1[1] + bias));
    w.w = pk2(__uint_as_float(uw.w << 16) * (a1[2] + bias), __uint_as_float(uw.w & 0xffff0000u) * (a1[3] + bias));
    *(u32x4*)(mix + (size_t)row * D_ + c8 * 8) = w; }
  MX_WAIT_ALL();
}
__device__ __forceinline__ void cmp_unit(const Cx& cx, const P& p, int layer, int u, char* lds) {
  const int tid = cx.tid, lane = tid & 63, r32 = lane & 31, hi = lane >> 5, wid = cx.wv;
  const int nt = u & 15, bgj = u >> 4, bg = bgj >> 1, j = bgj & 1, b = bg >> 1, g = bg & 1;
  const int nrow = min(nt * 32 + r32, 510);
  const bf16_t* xf = (const bf16_t*)(p.ws + OFF_HB) + ((size_t)(30 + j * 2 + g) * M_ + (size_t)b * T_) * 64 + (size_t)nrow * 1024;
  const bf16_t* W1T = (const bf16_t*)(p.ws + OFF_W1T) + (size_t)(layer * 2 + j) * 64 * 2048;
  bf16x8 w2f[2][2][2];
  if (wid == 0) { const bf16_t* wf = (const bf16_t*)(p.ws + OFF_W2F) + (size_t)(layer * 2 + j) * 4096 + lane * 8;
#pragma unroll
    for (int q = 0; q < 8; ++q) w2f[q >> 2][(q >> 1) & 1][q & 1] = *reinterpret_cast<const bf16x8*>(wf + q * 512); }
  f32x16 acc[2]; acc[0] = f32x16{}; acc[1] = f32x16{};
#pragma unroll 8
  for (int ks = 0; ks < 16; ++ks) { const int i0 = 256 * wid + 16 * ks + 8 * hi;
    const bf16x8 bx = *reinterpret_cast<const bf16x8*>(xf + i0);
    const bf16x8 a0 = *reinterpret_cast<const bf16x8*>(W1T + (size_t)r32 * 2048 + i0), a1 = *reinterpret_cast<const bf16x8*>(W1T + (size_t)(32 + r32) * 2048 + i0);
    acc[0] = MX_MFMA(a0, bx, acc[0]); acc[1] = MX_MFMA(a1, bx, acc[1]); }
  float* red = (float*)lds;
#pragma unroll
  for (int fb = 0; fb < 2; ++fb)
#pragma unroll
    for (int r = 0; r < 16; ++r) red[((wid * 2 + fb) * 16 + r) * 64 + lane] = acc[fb][r];
  MX_WAIT_ALL();
  {
    const float* c1 = (const float*)(p.ws + OFF_C1) + (layer * 2 + j) * 64;
    const int fb = wid >> 2, r0 = 4 * (wid & 3);
#pragma unroll
    for (int rr = 0; rr < 4; ++rr) { const int r = r0 + rr; float a = c1[32 * fb + att::crow(r, hi)];
#pragma unroll
      for (int w = 0; w < 8; ++w) a += red[((w * 2 + fb) * 16 + r) * 64 + lane];
      red[16384 + (fb * 16 + r) * 64 + lane] = gelu_tanh(a); } }
  MX_WAIT_ALL();
  if (wid == 0) {
    bf16x8 hb[2][2];
#pragma unroll
    for (int fb = 0; fb < 2; ++fb)
#pragma unroll
      for (int s2 = 0; s2 < 2; ++s2) { float hv[8];
#pragma unroll
        for (int k = 0; k < 8; ++k) hv[k] = red[16384 + (fb * 16 + 8 * s2 + k) * 64 + lane];
        const u32x4 w = (u32x4){att::cvtpk(hv[0], hv[1]), att::cvtpk(hv[2], hv[3]), att::cvtpk(hv[4], hv[5]), att::cvtpk(hv[6], hv[7])};
        hb[fb][s2] = __builtin_bit_cast(bf16x8, w); }
    f32x16 oc[2]; oc[0] = f32x16{}; oc[1] = f32x16{};
#pragma unroll
    for (int eb = 0; eb < 2; ++eb)
#pragma unroll
      for (int fb = 0; fb < 2; ++fb)
#pragma unroll
        for (int s2 = 0; s2 < 2; ++s2) oc[eb] = MX_MFMA(w2f[eb][fb][s2], hb[fb][s2], oc[eb]);
    if (j == 0) { float ss = 0.f;
#pragma unroll
      for (int eb = 0; eb < 2; ++eb)
#pragma unroll
        for (int r = 0; r < 16; ++r) ss += oc[eb][r] * oc[eb][r];
      ss += __shfl_xor(ss, 32);
      const float rs = rsqrtf(ss * (1.f / 64.f) + EPS);
#pragma unroll
      for (int eb = 0; eb < 2; ++eb)
#pragma unroll
        for (int r = 0; r < 16; ++r) oc[eb][r] *= rs * p.k_gain[(layer * 3 + 0) * 64 + 32 * eb + att::crow(r, hi)]; }
    bf16_t* dst = (bf16_t*)(p.ws + (j == 0 ? OFF_KC : OFF_VC)) + ((size_t)bg * 512 + nt * 32 + r32) * 64;
    const bool real = (nt * 32 + r32) < 511;
    if (real) {
#pragma unroll
      for (int eb = 0; eb < 2; ++eb)
#pragma unroll
        for (int r4 = 0; r4 < 4; ++r4)
        { const unsigned long long w = (unsigned long long)pk2(oc[eb][4 * r4], oc[eb][4 * r4 + 1]) | ((unsigned long long)pk2(oc[eb][4 * r4 + 2], oc[eb][4 * r4 + 3]) << 32);
          unsigned long long* q8 = (unsigned long long*)(dst + 32 * eb + att::crow(4 * r4, hi));
          if (j == 0) __hip_atomic_store(q8, w, __ATOMIC_RELAXED, __HIP_MEMORY_SCOPE_AGENT); else *q8 = w; } }
    if (j == 0) { asm volatile("s_waitcnt vmcnt(0)" ::: "memory"); if (lane == 0) hand_publish((unsigned*)(p.ws + OFF_CTR) + 512 + layer * 64 + bg * 16); }
  }
  MX_WAIT_ALL();
}
#undef MX_MFMA
}

__device__ __forceinline__ void ph_mix1(const Cx& cx, const P& p, int layer, char* lds, int rank, int nranks) {
  for (int item = rank; item < 128 + 384; item += nranks) {
    Cx c2 = cx; c2.tid = cx.wv * 64 + lane_id(); asm volatile("" : "+v"(c2.tid));
    if (item < 128) mx::cmp_unit(c2, p, layer, item, lds); else mx::ret_kv_unit(c2, p, layer, item - 128, lds);
  }
}
__device__ __forceinline__ void ph_mix2(const Cx& cx, const P& p, int layer, char* lds) {
  const int u0 = (cx.bid < 64) ? 192 + cx.bid : cx.bid - 64;
  for (int u = u0; u < 256; u += 256) { Cx c2 = cx; c2.tid = cx.wv * 64 + lane_id(); asm volatile("" : "+v"(c2.tid)); topk_unit(c2, p, layer, u, lds); }
  if (cx.bid >= 160) { if (cx.wv == 0 && lane_id() == 0) hand_wait((unsigned*)(p.ws + OFF_CTR) + 768 + layer * 64, 384u); __syncthreads();
    Cx c3 = cx; c3.bid = cx.bid - 160; c3.G = 96; mx::ret_scan(c3, p); }
  if (layer == 0) convert_weights(p, (LAS unsigned char*)lds, cx.wv, lane_id(), cx.bid * 8 + cx.wv, cx.G * 8, 6400, 8576);
}
__device__ __forceinline__ void ph_mix3(const Cx& cx, const P& p, int layer, char* lds) {
  const int nconv = (layer == 0) ? 148 : 0;
  unsigned* ctr = (unsigned*)(p.ws + OFF_CTR) + layer * 64;
  int* slot = (int*)(lds + 131072);
  for (;;) {
    __syncthreads();
    if (cx.wv == 0 && lane_id() == 0) *slot = (int)atomicAdd(ctr, 1u);
    __syncthreads();
    const int item = __builtin_amdgcn_readfirstlane(*slot);
    if (item >= 384 + 384 + 512 + nconv) break;
    Cx c2 = cx; c2.tid = cx.wv * 64 + lane_id(); asm volatile("" : "+v"(c2.tid));
    if (item < 384) nsa_unit(c2, p, item, lds); else if (item < 768) mx::ret_out_unit(c2, p, item - 384, lds);
    else if (item < 1280) mx::gmlp_unit(c2, p, layer, item - 768, lds);
    else { const int c0 = 1664 + (item - 1280) * 32; convert_weights(p, (LAS unsigned char*)lds, cx.wv, lane_id(), cx.wv, 8, c0, min(c0 + 32, 6400)); }
  }
}
typedef unsigned gu32_t;
#define XB_TMO      128
#define XB_XCNT(j)  (256  + 64 * (j))
#define XB_XSUB(j)  (1280 + 64 * (j))
#define XB_XGEN(j)  (2304 + 64 * (j))
#define XB_TOP      3328
#define XB_TOPGEN   3392
#define XCD_BAR_WORDS 3456
#define XB_SPIN_CAP (1u << 18)

__device__ __forceinline__ unsigned xb_ld(unsigned* p)              { return __hip_atomic_load(p, __ATOMIC_RELAXED, __HIP_MEMORY_SCOPE_AGENT); }
__device__ __forceinline__ unsigned xb_add(unsigned* p, unsigned v) { return __hip_atomic_fetch_add(p, v, __ATOMIC_RELAXED, __HIP_MEMORY_SCOPE_AGENT); }
__device__ __forceinline__ unsigned xb_xcc_id() { return (unsigned)__builtin_amdgcn_s_getreg((3 << 11) | 20) & 0xFu; }
#define XB_SPIN(cond, bar) do { unsigned _sp = 0; while (cond) { __builtin_amdgcn_s_sleep(1); \
    if ((++_sp & 255u) == 0u) { if (xb_ld(&(bar)[XB_TMO])) break; if (_sp > XB_SPIN_CAP) { atomicAdd(&(bar)[XB_TMO], 1u); break; } } } } while (0)

struct XcdBarrier {
    unsigned* bar; unsigned x;
    volatile LAS unsigned* st;
    int wv;
};

__device__ __forceinline__ XcdBarrier xcd_barrier_post(unsigned* bar, volatile LAS unsigned* st, int wv) {
    XcdBarrier b; b.bar = bar; b.x = xb_xcc_id(); b.st = st; b.wv = wv;
    if (wv == 0 && lane_id() == 0) (void)xb_add(&bar[XB_XCNT(b.x)], 1u);
    return b;
}
__device__ __forceinline__ void xcd_barrier_complete(unsigned* bar, unsigned x, unsigned& nloc, unsigned& nx) {
    const unsigned G = gridDim.x * gridDim.y * gridDim.z;
    unsigned sum, cnt, mine, sp = 0u;
    for (;;) {
        sum = 0u; cnt = 0u; mine = 0u;
#pragma unroll
        for (unsigned j = 0; j < 16; ++j) { const unsigned c = xb_ld(&bar[XB_XCNT(j)]); sum += c; cnt += (c > 0u) ? 1u : 0u; mine = (j == x) ? c : mine; }
        if (sum == G) break;
        __builtin_amdgcn_s_sleep(1);
        if ((++sp & 255u) == 0u) { if (xb_ld(&bar[XB_TMO])) break; if (sp > XB_SPIN_CAP) { atomicAdd(&bar[XB_TMO], 1u); break; } }
    }
    nloc = mine > 0u ? mine : 1u; nx = cnt > 0u ? cnt : 1u;
}

__device__ __forceinline__ void xcd_barrier(const XcdBarrier& b) {
    asm volatile("s_waitcnt vmcnt(0)" ::: "memory");
    __syncthreads();
    if (b.wv == 0 && lane_id() == 0) {
        unsigned* bar = b.bar;
        __builtin_amdgcn_s_waitcnt(0);
        unsigned nloc = b.st[0], nx = b.st[1];
        if (nloc == 0u) { xcd_barrier_complete(bar, b.x, nloc, nx); b.st[0] = nloc; b.st[1] = nx; }
        const unsigned old = xb_add(&bar[XB_XSUB(b.x)], 1u);
        const unsigned gen = old / nloc;
        if (old + 1u == (gen + 1u) * nloc) {
            __builtin_amdgcn_fence(__ATOMIC_RELEASE, "agent");
            asm volatile("s_waitcnt vmcnt(0)" ::: "memory");
            const unsigned og = xb_add(&bar[XB_TOP], 1u);
            const unsigned tg = og / nx;
            if (og + 1u == (tg + 1u) * nx) xb_add(&bar[XB_TOPGEN], 1u);
            else XB_SPIN(xb_ld(&bar[XB_TOPGEN]) == tg, bar);
            __builtin_amdgcn_fence(__ATOMIC_ACQUIRE, "agent");
            xb_add(&bar[XB_XGEN(b.x)], 1u);
            asm volatile("s_waitcnt vmcnt(0)" ::: "memory");
        } else {
            XB_SPIN(xb_ld(&bar[XB_XGEN(b.x)]) == gen, bar);
            __builtin_amdgcn_fence(__ATOMIC_ACQUIRE, "agent");
            asm volatile("s_waitcnt vmcnt(0)" ::: "memory");
        }
    }
    __syncthreads();
}

__global__ void __launch_bounds__(NTHR, 2) k_mega(P pk) {
  extern __shared__ __attribute__((aligned(16))) unsigned char lds_raw[];
  LAS unsigned char* lds = (LAS unsigned char*)lds_raw;
  float* sm = (float*)lds_raw;
  const int wave_s = __builtin_amdgcn_readfirstlane((int)threadIdx.x >> 6);
  { volatile LAS unsigned* bst = (volatile LAS unsigned*)(lds + 131072 + 64);
    if (threadIdx.x < 2) bst[threadIdx.x] = 0u;
    __syncthreads();
    (void)xcd_barrier_post((unsigned*)(pk.ws + OFF_BAR), bst, wave_s); }
#define GSYNC() do { kargp_t kb_ = (kargp_t)__builtin_amdgcn_kernarg_segment_ptr(); asm volatile("" : "+s"(kb_)); XcdBarrier xb_; xb_.bar = (unsigned*)(kb_->ws + OFF_BAR); xb_.x = xb_xcc_id(); \
    xb_.st = (volatile LAS unsigned*)(lds + 131072 + 64); xb_.wv = wave_s; xcd_barrier(xb_); } while (0)
#define LOADP(p, k) do { p.x = k->x; p.attn_norm = k->attn_norm; p.w_in = k->w_in; p.w_out = k->w_out; p.q_gain = k->q_gain; p.k_gain = k->k_gain; p.cmp_pe = k->cmp_pe; p.cmp_w1 = k->cmp_w1; p.cmp_w2 = k->cmp_w2; \
    p.gm_ws = k->gm_ws; p.gm_b = k->gm_b; p.ffn_norm = k->ffn_norm; p.w_gu = k->w_gu; p.w_down = k->w_down; p.rel_bias = k->rel_bias; p.out = k->out; p.ws = k->ws; } while (0)
  typedef const __attribute__((address_space(4))) P* kargp_t;
#define PB Cx cx; P p; { int t_ = wave_s * 64 + lane_id(), b_ = blockIdx.x; kargp_t k_ = (kargp_t)__builtin_amdgcn_kernarg_segment_ptr(); asm volatile("" : "+v"(t_), "+s"(b_), "+s"(k_)); LOADP(p, k_); cx.tid = t_; cx.bid = b_; cx.G = gridDim.x; cx.wv = wave_s; }
  { PB; ph_prologue(cx, p, lds); }
  GSYNC();
#pragma unroll 1
  for (int layer = 0; layer < 2; ++layer) {
    { PB; pg8::Gemm g{(const bf16_t*)(p.ws + OFF_XB), (const bf16_t*)(p.ws + OFF_WIN) + (size_t)layer * NPROJ * D_, M_, 3072, D_}; pg8::StaticOrder S; S.init(M_, 3072, cx.G, cx.bid);
      EpiProj E{(const float*)(p.ws + OFF_SSQ), (bf16_t*)(p.ws + OFF_HB), (float*)(p.ws + OFF_GATES), (const float2*)(p.ws + OFF_ROPE), p.q_gain + layer * 64, p.k_gain + layer * 192};
      pg8::gemm_phase<EpiProj, pg8::StaticOrder, PG8_ALIGN, PG8_SP2>(lds, g, S, E, cx.tid); }
    GSYNC();
    { PB; if (cx.bid < 64) {
        pg8::Gemm g2{(const bf16_t*)(p.ws + OFF_XB), (const bf16_t*)(p.ws + OFF_WIN) + (size_t)layer * NPROJ * D_, M_, NPROJ, D_}; pg8::OneUnit S2{cx.bid, 12, true};
        EpiProj E{(const float*)(p.ws + OFF_SSQ), (bf16_t*)(p.ws + OFF_HB), (float*)(p.ws + OFF_GATES), (const float2*)(p.ws + OFF_ROPE), p.q_gain + layer * 64, p.k_gain + layer * 192};
        pg8::gemm_phase<EpiProj, pg8::OneUnit, false, PG8_SP2>(lds, g2, S2, E, cx.tid);
      } else ph_mix1(cx, p, layer, (char*)lds_raw, cx.bid - 64, cx.G - 64); }
    { PB; ph_mix2(cx, p, layer, (char*)lds_raw); } GSYNC();
    { PB; ph_mix3(cx, p, layer, (char*)lds_raw); } GSYNC();
    { PB; pg8::Gemm g{(const bf16_t*)(p.ws + OFF_MIX), (const bf16_t*)(p.ws + OFF_WO) + (size_t)layer * D_ * D_, M_, D_, D_}; pg8::StaticOrder S; S.init(M_, D_, cx.G, cx.bid);
      EpiRes E{(layer == 0) ? p.x : nullptr, nullptr, (bf16_t*)(p.ws + OFF_XB), (float*)(p.ws + OFF_SSQ)};
      pg8::gemm_phase<EpiRes, pg8::StaticOrder, PG8_ALIGN, PG8_SP2>(lds, g, S, E, cx.tid); }
    GSYNC();
    { PB; pg8::Gemm g{(const bf16_t*)(p.ws + OFF_XB), (const bf16_t*)(p.ws + OFF_WGU) + (size_t)layer * 2 * DFF * D_, M_, 2 * DFF, D_}; pg8::StaticOrder S; S.init(M_, 2 * DFF, cx.G, cx.bid);
      EpiGU E{(const float*)(p.ws + OFF_SSQ), (bf16_t*)(p.ws + OFF_ACT)};
      pg8::gemm_phase<EpiGU, pg8::StaticOrder, PG8_ALIGN, PG8_SP2>(lds, g, S, E, cx.tid);
      { const int c0 = (cx.G > 128) ? 128 : 0; if (layer == 0 && cx.bid >= c0) convert_weights(p, lds, cx.wv, cx.tid & 63, (cx.bid - c0) * 8 + cx.wv, (cx.G - c0) * 8, 8576, 12800); } }
    GSYNC();
    { PB; pg8::Gemm g{(const bf16_t*)(p.ws + OFF_ACT), (const bf16_t*)(p.ws + OFF_WD) + (size_t)layer * D_ * DFF, M_, D_, DFF}; pg8::StaticOrder S; S.init(M_, D_, cx.G, cx.bid);
      EpiRes E{nullptr, (layer == 1) ? p.out : nullptr, (bf16_t*)(p.ws + OFF_XB), (float*)(p.ws + OFF_SSQ)};
      pg8::gemm_phase<EpiRes, pg8::StaticOrder, PG8_ALIGN, PG8_SP2>(lds, g, S, E, cx.tid); }
    GSYNC();
  }
}

extern "C" void kernel_launch(void* const* d_in, const int* in_sizes, int n_in, void* d_out, int out_size, void* d_ws, size_t ws_size, hipStream_t stream) {
  P p{};
  p.x = (const float*)d_in[0]; p.attn_norm = (const float*)d_in[1]; p.w_in = (const float*)d_in[2]; p.w_out = (const float*)d_in[3];
  p.q_gain = (const float*)d_in[4]; p.k_gain = (const float*)d_in[5]; p.cmp_pe = (const float*)d_in[6]; p.cmp_w1 = (const float*)d_in[7];
  p.cmp_w2 = (const float*)d_in[8]; p.gm_ws = (const float*)d_in[9]; p.gm_b = (const float*)d_in[10]; p.ffn_norm = (const float*)d_in[11];
  p.w_gu = (const float*)d_in[12]; p.w_down = (const float*)d_in[13]; p.rel_bias = (const float*)d_in[14];
  p.out = (float*)d_out; p.ws = (unsigned char*)d_ws;
  static int grid = 0;
  if (!grid) {
    (void)hipFuncSetAttribute((const void*)k_mega, hipFuncAttributeMaxDynamicSharedMemorySize, LDS_BYTES);
    int dev = 0, cus = 0, per_cu = 0;
    (void)hipGetDevice(&dev);
    (void)hipDeviceGetAttribute(&cus, hipDeviceAttributeMultiprocessorCount, dev);
    (void)hipOccupancyMaxActiveBlocksPerMultiprocessor(&per_cu, (const void*)k_mega, NTHR, LDS_BYTES);
    if (per_cu < 1) per_cu = 1;
    grid = cus;
  }
  (void)hipMemsetAsync((char*)d_ws + OFF_BAR, 0, 16384, stream);
  void* args[] = {&p};
  hipError_t e = hipLaunchCooperativeKernel((const void*)k_mega, dim3(grid), dim3(NTHR), args, LDS_BYTES, stream);
  if (e != hipSuccess) fprintf(stderr, "cooperative launch failed: %s (grid %d)\n", hipGetErrorString(e), grid);
}
```

```cpp
#include <hip/hip_runtime.h>
#include <hip/hip_cooperative_groups.h>
#include <stdint.h>
#include <stdio.h>
namespace cg = cooperative_groups;
namespace pg8 {
#define PG8_LAS __attribute__((address_space(3)))
typedef unsigned short bf16_t;
typedef short bf16x8 __attribute__((ext_vector_type(8)));
typedef float f32x4 __attribute__((ext_vector_type(4)));
typedef unsigned u32x4 __attribute__((ext_vector_type(4)));
constexpr int BM = 256, BK = 64, HALF = 128, HTB = HALF * BK * 2  , STAGE_BYTES = 8 * HTB, NXCD = 8, WGM = 8;

__host__ __device__ __forceinline__ int lds_byte(int r, int c) { const int st = (r >> 4) * 2 + (c >> 5), rr = r & 15, cc = c & 31, ob = rr * 64 + cc * 2; return st * 1024 + (ob ^ (((ob >> 9) & 1) << 5)); }
__host__ __device__ __forceinline__ void stage_rc(int b, int& R, int& C) { const int st = b / 1024, sb = b % 1024, swz = sb ^ (((sb >> 9) & 1) << 5); R = (st >> 1) * 16 + swz / 64; C = (st & 1) * 32 + (swz % 64) / 2; }
__host__ __device__ __forceinline__ int perm32(int rho) { const int n = rho >> 4, i = rho & 15; return 8 * (i >> 2) + 4 * n + (i & 3); }

struct Unit { int pm, pn; };
struct Gemm { const bf16_t* A; const bf16_t* Bt; int M, N, K; };

struct StaticOrder {
    int nM, nN, nwg, G, c;
    __host__ __device__ void init(int M, int N, int G_, int c_) { nM = M / BM; nN = N / BM; nwg = nM * nN; G = G_; c = c_; }
    __host__ __device__ bool next(int i, Unit& u) const {
        const long L = (long)i * G + c; if (L >= nwg) return false;
        int wgid = (int)L; { const int q = nwg / NXCD, r = nwg % NXCD, xcd = wgid % NXCD, off = wgid / NXCD; wgid = (xcd < r ? xcd * (q + 1) : r * (q + 1) + (xcd - r) * q) + off; }
        const int nig = WGM * nN, gid = wgid / nig, fm = gid * WGM, gsz = (nM - fm) < WGM ? (nM - fm) : WGM;
        u.pm = fm + ((wgid % nig) % gsz); u.pn = (wgid % nig) / gsz; return true;
    }
    __device__ __forceinline__ void a_ready(const Unit&) const {}
    __device__ __forceinline__ void done(const Unit&) const {}
};

struct OneUnit {
    int pm, pn; bool have;
    __host__ __device__ bool next(int i, Unit& u) const { if (i > 0 || !have) return false; u.pm = pm; u.pn = pn; return true; }
    __device__ __forceinline__ void a_ready(const Unit&) const {}
    __device__ __forceinline__ void done(const Unit&) const {}
};
__device__ __forceinline__ unsigned cvt_pk_bf16(float lo, float hi) { unsigned r; asm volatile("v_cvt_pk_bf16_f32 %0, %1, %2" : "=v"(r) : "v"(lo), "v"(hi)); return r; }
typedef float f32x2 __attribute__((ext_vector_type(2)));
template <class Epi, class Sched, bool ALIGN_EPI = false, bool SP2 = false>
__device__ __forceinline__ void gemm_phase(PG8_LAS unsigned char* lds, const Gemm g, const Sched& S, const Epi& E, const int tid) {
    const int wid = __builtin_amdgcn_readfirstlane(tid >> 6), lane = tid & 63, wr = wid >> 2, wc = wid & 3, fr = lane & 15, fq = lane >> 4;
    const int K = g.K, nt = K / BK;
    unsigned voffA[2], voffB[2];
#pragma unroll
    for (int i = 0; i < 2; ++i) { int R, C; stage_rc(tid * 16 + i * 8192, R, C); const int Rb = Epi::PERM ? ((R & ~31) + perm32(R & 31)) : R;
        voffA[i] = (unsigned)(R * K + C) * 2u; voffB[i] = (unsigned)(Rb * K + C) * 2u; }
    const size_t kstep = (size_t)(BK * 2);
    const size_t hstep = (size_t)HALF * K * 2;
    const size_t tstep = 2 * hstep;
    const unsigned ldsw = (unsigned)wid * 1024u;
    const int aoff = lds_byte(wr * 64 + fr, fq * 8), boff = lds_byte(wc * 32 + fr, fq * 8);
#define PG8_SA(b, h) (((b) * 2 + (h)) * HTB)
#define PG8_SB(b, h) ((4 + (b) * 2 + (h)) * HTB)
#define PG8_STAGE(bufoff, gbase, voff) do { _Pragma("unroll") for (int _i = 0; _i < 2; ++_i) \
        __builtin_amdgcn_global_load_lds((const unsigned*)((const char*)(gbase) + (voff)[_i]), (PG8_LAS unsigned*)(lds + (bufoff) + ldsw + _i * 8192), 16, 0, 0); } while (0)
#define PG8_LDA(dst, b, h) do { _Pragma("unroll") for (int m = 0; m < 4; ++m) _Pragma("unroll") for (int k = 0; k < 2; ++k) dst[m][k] = *(const PG8_LAS bf16x8*)(lds + PG8_SA(b, h) + aoff + m * 2048 + k * 1024); } while (0)
#define PG8_LDB(dst, b, h) do { _Pragma("unroll") for (int n = 0; n < 2; ++n) _Pragma("unroll") for (int k = 0; k < 2; ++k) dst[n][k] = *(const PG8_LAS bf16x8*)(lds + PG8_SB(b, h) + boff + n * 2048 + k * 1024); } while (0)
#define PG8_MMA(ai, bj, At, Bt) do { __builtin_amdgcn_s_setprio(1); _Pragma("unroll") for (int m = 0; m < 4; ++m) _Pragma("unroll") for (int n = 0; n < 2; ++n) _Pragma("unroll") for (int k = 0; k < 2; ++k) \
        acc[ai][bj][m][n] = __builtin_amdgcn_mfma_f32_16x16x32_bf16(Bt[n][k], At[m][k], acc[ai][bj][m][n], 0, 0, 0); __builtin_amdgcn_s_setprio(0); } while (0)
#define PG8_WAIT_V(n) asm volatile("s_waitcnt vmcnt(" #n ")" ::: "memory")
#define PG8_WAIT_L(n) asm volatile("s_waitcnt lgkmcnt(" #n ")" ::: "memory")
#define PG8_BAR __builtin_amdgcn_s_barrier()
#define PG8_SCHED __builtin_amdgcn_sched_barrier(0)
    Unit cur, nxt; int ui = 0;
    if (!S.next(0, cur)) return;
    f32x4 acc[2][2][4][2];
#pragma unroll
    for (int a = 0; a < 2; ++a)
#pragma unroll
        for (int b = 0; b < 2; ++b)
#pragma unroll
            for (int m = 0; m < 4; ++m)
#pragma unroll
                for (int n = 0; n < 2; ++n) acc[a][b][m][n] = (f32x4){0.f, 0.f, 0.f, 0.f};
    bf16x8 At[4][2], B0[2][2], B1[2][2];
    const char* cA = (const char*)g.A + (size_t)cur.pm * tstep; const char* cB = (const char*)g.Bt + (size_t)cur.pn * tstep;
    S.a_ready(cur);
    if constexpr (SP2) {
        PG8_STAGE(PG8_SB(0, 0), cB, voffB); PG8_STAGE(PG8_SB(0, 1), cB + hstep, voffB); PG8_STAGE(PG8_SA(0, 0), cA, voffA); PG8_STAGE(PG8_SA(0, 1), cA + hstep, voffA);
        if (wr == 1) PG8_BAR;
        PG8_WAIT_V(2); PG8_BAR;
        PG8_STAGE(PG8_SB(1, 0), cB + kstep, voffB); PG8_STAGE(PG8_SA(1, 0), cA + kstep, voffA); PG8_STAGE(PG8_SB(1, 1), cB + hstep + kstep, voffB);
        PG8_WAIT_V(6); PG8_BAR;
    } else {
        PG8_STAGE(PG8_SB(0, 0), cB, voffB); PG8_STAGE(PG8_SA(0, 0), cA, voffA); PG8_STAGE(PG8_SB(0, 1), cB + hstep, voffB); PG8_STAGE(PG8_SA(0, 1), cA + hstep, voffA);
        if (wr == 1) PG8_BAR;
        PG8_WAIT_V(4); PG8_BAR;
        PG8_STAGE(PG8_SB(1, 0), cB + kstep, voffB); PG8_STAGE(PG8_SA(1, 0), cA + kstep, voffA); PG8_STAGE(PG8_SB(1, 1), cB + hstep + kstep, voffB);
        PG8_WAIT_V(6); PG8_BAR;
    }
    for (;;) {
        const bool has_next = S.next(ui + 1, nxt);
        const char* nA = has_next ? (const char*)g.A + (size_t)nxt.pm * tstep : cA; const char* nB = has_next ? (const char*)g.Bt + (size_t)nxt.pn * tstep : cB;
        for (int t = 0; t < nt; t += 2) {
            const bool last = (t == nt - 2);
            const char* a1 = cA + (size_t)(t + 1) * kstep;
            const char* a2 = last ? nA : cA + (size_t)(t + 2) * kstep; const char* b2 = last ? nB : cB + (size_t)(t + 2) * kstep;
            const char* a3 = a2 + kstep; const char* b3 = b2 + kstep;
            if (last && has_next) S.a_ready(nxt);
            if constexpr (SP2) {
            PG8_LDB(B0, 0, 0); PG8_LDB(B1, 0, 1); PG8_SCHED; PG8_LDA(At, 0, 0); PG8_STAGE(PG8_SA(1, 1), a1 + hstep, voffA);
            PG8_WAIT_V(8); PG8_WAIT_L(0); PG8_BAR; PG8_MMA(0, 0, At, B0); PG8_MMA(0, 1, At, B1); PG8_BAR; PG8_SCHED;
            PG8_LDA(At, 0, 1); PG8_STAGE(PG8_SB(0, 0), b2, voffB); PG8_STAGE(PG8_SB(0, 1), b2 + hstep, voffB); PG8_STAGE(PG8_SA(0, 0), a2, voffA);
            PG8_WAIT_V(8); PG8_WAIT_L(0); PG8_BAR; PG8_MMA(1, 0, At, B0); PG8_MMA(1, 1, At, B1); PG8_BAR; PG8_SCHED;
            PG8_LDB(B0, 1, 0); PG8_LDB(B1, 1, 1); PG8_SCHED; PG8_LDA(At, 1, 0); PG8_STAGE(PG8_SA(0, 1), a2 + hstep, voffA);
            PG8_WAIT_V(8); PG8_WAIT_L(0); PG8_BAR; PG8_MMA(0, 0, At, B0); PG8_MMA(0, 1, At, B1); PG8_BAR; PG8_SCHED;
            PG8_LDA(At, 1, 1); PG8_STAGE(PG8_SB(1, 0), b3, voffB); PG8_STAGE(PG8_SB(1, 1), b3 + hstep, voffB); PG8_STAGE(PG8_SA(1, 0), a3, voffA);
            PG8_WAIT_V(8); PG8_WAIT_L(0); PG8_BAR; PG8_MMA(1, 0, At, B0); PG8_MMA(1, 1, At, B1); PG8_BAR; PG8_SCHED;
            } else {
            PG8_LDB(B0, 0, 0); PG8_SCHED; PG8_LDA(At, 0, 0); PG8_STAGE(PG8_SA(1, 1), a1 + hstep, voffA);
            PG8_WAIT_L(8); PG8_BAR; PG8_WAIT_L(0); PG8_MMA(0, 0, At, B0); PG8_BAR; PG8_SCHED;
            PG8_LDB(B1, 0, 1); PG8_STAGE(PG8_SB(0, 0), b2, voffB);
            PG8_BAR; PG8_WAIT_L(0); PG8_MMA(0, 1, At, B1); PG8_BAR;
            PG8_LDA(At, 0, 1); PG8_STAGE(PG8_SA(0, 0), a2, voffA);
            PG8_BAR; PG8_WAIT_L(0); PG8_MMA(1, 0, At, B0); PG8_BAR; PG8_SCHED;
            PG8_STAGE(PG8_SB(0, 1), b2 + hstep, voffB);
            PG8_WAIT_V(6); PG8_BAR; PG8_MMA(1, 1, At, B1); PG8_BAR;
            PG8_LDB(B0, 1, 0); PG8_SCHED; PG8_LDA(At, 1, 0); PG8_STAGE(PG8_SA(0, 1), a2 + hstep, voffA);
            PG8_WAIT_L(8); PG8_BAR; PG8_WAIT_L(0); PG8_MMA(0, 0, At, B0); PG8_BAR; PG8_SCHED;
            PG8_LDB(B1, 1, 1); PG8_STAGE(PG8_SB(1, 0), b3, voffB);
            PG8_BAR; PG8_WAIT_L(0); PG8_MMA(0, 1, At, B1); PG8_BAR;
            PG8_LDA(At, 1, 1); PG8_STAGE(PG8_SA(1, 0), a3, voffA);
            PG8_BAR; PG8_WAIT_L(0); PG8_MMA(1, 0, At, B0); PG8_BAR; PG8_SCHED;
            PG8_STAGE(PG8_SB(1, 1), b3 + hstep, voffB);
            PG8_WAIT_V(6); PG8_BAR; PG8_MMA(1, 1, At, B1); PG8_BAR;
            }
        }
        if constexpr (ALIGN_EPI) { if (wr == 0) PG8_BAR; }
        if constexpr (!Epi::AFTER_DRAIN) { E(acc, cur, wr, wc, fr, fq); S.done(cur); }
        if (!has_next) break;
#pragma unroll
        for (int a = 0; a < 2; ++a)
#pragma unroll
            for (int b = 0; b < 2; ++b)
#pragma unroll
                for (int m = 0; m < 4; ++m)
#pragma unroll
                    for (int n = 0; n < 2; ++n) acc[a][b][m][n] = (f32x4){0.f, 0.f, 0.f, 0.f};
        cur = nxt; cA = nA; cB = nB; ++ui;
        if constexpr (ALIGN_EPI) { if (wr == 1) PG8_BAR; }
    }
    PG8_WAIT_V(0);
    if constexpr (!ALIGN_EPI) { if (wr == 0) PG8_BAR; }
    PG8_BAR;
    if constexpr (Epi::AFTER_DRAIN) { E.fused(acc, cur, wr, wc, fr, fq, lds, wid, lane); S.done(cur); }
#undef PG8_SA
#undef PG8_SB
#undef PG8_STAGE
#undef PG8_LDA
#undef PG8_LDB
#undef PG8_MMA
#undef PG8_WAIT_V
#undef PG8_WAIT_L
#undef PG8_BAR
#undef PG8_SCHED
}
}

#ifndef PG8_SP2
#define PG8_SP2 true
#endif
#ifndef PG8_ALIGN
#define PG8_ALIGN true
#endif

typedef unsigned short bf16_t;
typedef float f32x4 __attribute__((ext_vector_type(4)));
typedef unsigned u32x4 __attribute__((ext_vector_type(4)));
#define LAS __attribute__((address_space(3)))

#define T_ 8192
#define M_ 16384
#define D_ 1024
#define INW 3218
#define NPROJ 3328
#define DFF 2816
#define EPS 1e-6f
#define NTHR 512

struct Cx { int tid, bid, G, wv; };
__device__ __forceinline__ int lane_id() { int l; asm volatile("v_mbcnt_lo_u32_b32 %0, -1, 0\n\tv_mbcnt_hi_u32_b32 %0, -1, %0" : "=v"(l)); return l; }
__device__ __forceinline__ void hand_publish(unsigned* cnt) { asm volatile("s_waitcnt vmcnt(0)" ::: "memory"); __hip_atomic_fetch_add(cnt, 1u, __ATOMIC_RELAXED, __HIP_MEMORY_SCOPE_AGENT); }
__device__ __forceinline__ void hand_wait(unsigned* cnt, unsigned need) { unsigned sp = 0; while (__hip_atomic_load(cnt, __ATOMIC_RELAXED, __HIP_MEMORY_SCOPE_AGENT) < need) { __builtin_amdgcn_s_sleep(4); if (++sp > (1u << 22)) break; }
  asm volatile("" ::: "memory"); }
struct P {
  const float *x, *attn_norm, *w_in, *w_out, *q_gain, *k_gain, *cmp_pe, *cmp_w1, *cmp_w2, *gm_ws, *gm_b, *ffn_norm, *w_gu, *w_down, *rel_bias;
  float* out; unsigned char* ws;
};

constexpr size_t MiB = 1u << 20;
constexpr size_t OFF_HB = 0;
constexpr size_t OFF_ACT = 0;
constexpr size_t OFF_MIX = 100 * MiB;
constexpr size_t OFF_GATES = 132 * MiB;
constexpr size_t OFF_KC = 134 * MiB;
constexpr size_t OFF_VC = 134 * MiB + 512 * 1024;
constexpr size_t OFF_RS = 135 * MiB;
constexpr size_t OFF_ROPE = 148 * MiB;
constexpr size_t OFF_WIN = 152 * MiB;
constexpr size_t OFF_WO = 165 * MiB;
constexpr size_t OFF_WGU = 169 * MiB;
constexpr size_t OFF_WD = 191 * MiB;
constexpr size_t OFF_XB = 204 * MiB;
constexpr size_t OFF_SSQ = 236 * MiB;
constexpr size_t OFF_SELQ = 237 * MiB;
constexpr size_t OFF_CTR = 238 * MiB;
constexpr size_t OFF_BAR = 238 * MiB + 65536;
constexpr size_t OFF_RT = 239 * MiB;
constexpr size_t OFF_W1T = 245 * MiB;
constexpr size_t OFF_C1 = 246 * MiB;
constexpr size_t OFF_WSB = 246 * MiB + 65536;
constexpr size_t OFF_W2F = 247 * MiB + 65536;
constexpr size_t OFF_BTAB = 247 * MiB;

constexpr int LDS_BYTES = 147456;

__device__ __forceinline__ float bf2f(bf16_t v) { return __uint_as_float(((unsigned)v) << 16); }
__device__ __forceinline__ bf16_t f2bf(float f) { unsigned u = __float_as_uint(f); u += 0x7fffu + ((u >> 16) & 1u); return (bf16_t)(u >> 16); }
__device__ __forceinline__ unsigned pk2(float lo, float hi) { unsigned r; asm("v_cvt_pk_bf16_f32 %0, %1, %2" : "=v"(r) : "v"(lo), "v"(hi)); return r; }
__device__ __forceinline__ float gelu_tanh(float x) { const float y = -2.3022082f * (x + 0.044715f * x * x * x); return x * __builtin_amdgcn_rcpf(1.f + __builtin_amdgcn_exp2f(y)); }
__device__ __forceinline__ void div2(float n0, float d0, float n1, float d1, float& q0, float& q1) { const float r = __builtin_amdgcn_rcpf(d0 * d1); q0 = n0 * d1 * r; q1 = n1 * d0 * r; }
__device__ __forceinline__ void gelu2(float& a, float& b) {
  const float ea = fminf(__builtin_amdgcn_exp2f(-2.3022082f * (a + 0.044715f * a * a * a)), 1e15f), eb = fminf(__builtin_amdgcn_exp2f(-2.3022082f * (b + 0.044715f * b * b * b)), 1e15f);
  div2(a, 1.f + ea, b, 1.f + eb, a, b); }
__device__ __forceinline__ float sigmoidf(float x) { return __builtin_amdgcn_rcpf(1.f + __builtin_amdgcn_exp2f(-1.4426950408889634f * x)); }
#define rsqrtf(x) __builtin_amdgcn_rsqf(x)
__device__ __forceinline__ float wave_sum(float v) {
#pragma unroll
  for (int o = 1; o < 64; o <<= 1) v += __shfl_xor(v, o);
  return v;
}
__device__ __forceinline__ float wave_max(float v) {
#pragma unroll
  for (int o = 1; o < 64; o <<= 1) v = fmaxf(v, __shfl_xor(v, o));
  return v;
}
__device__ __forceinline__ int t5_bucket(int n) {
  if (n < 16) return n;
  int b = 16;
  b += (n >= 19); b += (n >= 21); b += (n >= 24); b += (n >= 27); b += (n >= 31); b += (n >= 35); b += (n >= 40); b += (n >= 46);
  b += (n >= 52); b += (n >= 59); b += (n >= 67); b += (n >= 77); b += (n >= 87); b += (n >= 99); b += (n >= 113);
  return b;
}
#define WSYNC() do { __builtin_amdgcn_fence(__ATOMIC_RELEASE, "wavefront"); __builtin_amdgcn_wave_barrier(); __builtin_amdgcn_fence(__ATOMIC_ACQUIRE, "wavefront"); } while (0)

__device__ __forceinline__ int proj_col0(int g) { return (g < 42) ? 64 * g : 2706 + 64 * (g - 42); }
__device__ __forceinline__ float row_rstd(const float* ssq, int row, int fq) {
  const f32x4 s = *(const f32x4*)(ssq + (size_t)row * 16 + 4 * fq);
  float t = (s[0] + s[1]) + (s[2] + s[3]);
  t += __shfl_xor(t, 16); t += __shfl_xor(t, 32);
  return rsqrtf(t * (1.f / D_) + EPS);
}
__device__ __forceinline__ void unit_rstd(const float* __restrict__ ssq, int row0, int fq, float (&rstd)[8]) {
  f32x4 sv[8];
#pragma unroll
  for (int i = 0; i < 8; ++i) sv[i] = *(const f32x4*)(ssq + (size_t)(row0 + (i >> 2) * 128 + (i & 3) * 16) * 16 + 4 * fq);
#pragma unroll
  for (int i = 0; i < 8; ++i) { float t = (sv[i][0] + sv[i][1]) + (sv[i][2] + sv[i][3]); t += __shfl_xor(t, 16); t += __shfl_xor(t, 32); rstd[i] = rsqrtf(t * (1.f / D_) + EPS); }
}
struct EpiProj {
  static constexpr bool PERM = true, AFTER_DRAIN = false;
  const float* ssq; bf16_t* HB; float* gates; const float2* rope; const float* q_gain; const float* k_gain;
  template <int TYPE>
  __device__ __forceinline__ void rows(const f32x4 (&acc)[2][2][4][2], const pg8::Unit& u, int wr, int fr, int fq, int gidx, float sc, float dec_l2, const float* gn_) const {
    const float* __restrict__ ssq = this->ssq; const float2* __restrict__ rope = this->rope; const float* __restrict__ gn = gn_;
    bf16_t* __restrict__ HB = this->HB; float* __restrict__ gates = this->gates;
    float gv[2][8];
    if (TYPE == 2) {
      asm volatile("" : "+v"(sc));
#pragma unroll
      for (int bj = 0; bj < 2; ++bj)
#pragma unroll
        for (int i = 0; i < 8; ++i) gv[bj][i] = gn[32 * bj + 8 * fq + i] * sc;
    }
    const int row0 = u.pm * 256 + wr * 64 + fr;
    float rstd8[8]; unit_rstd(ssq, row0, fq, rstd8);
    f32x4 tn[4];
    if (TYPE == 0) { const f32x4* tb = (const f32x4*)(rope + (size_t)(row0 & (T_ - 1)) * 32 + 8 * fq);
#pragma unroll
      for (int i = 0; i < 4; ++i) tn[i] = tb[i]; }
#pragma unroll
    for (int ai = 0; ai < 2; ++ai)
#pragma unroll
      for (int m = 0; m < 4; ++m) {
        const int row = row0 + ai * 128 + m * 16;
        const float rstd = rstd8[ai * 4 + m];
        float v[2][8];
#pragma unroll
        for (int bj = 0; bj < 2; ++bj)
#pragma unroll
          for (int n = 0; n < 2; ++n)
#pragma unroll
            for (int e = 0; e < 4; ++e) v[bj][4 * n + e] = acc[ai][bj][m][n][e] * rstd;
        if (TYPE == 0) {
          f32x4 tc[4];
#pragma unroll
          for (int i = 0; i < 4; ++i) tc[i] = tn[i];
          if (ai * 4 + m < 7) { const int rown = row0 + ((ai * 4 + m + 1) >> 2) * 128 + ((ai * 4 + m + 1) & 3) * 16; const f32x4* tb = (const f32x4*)(rope + (size_t)(rown & (T_ - 1)) * 32 + 8 * fq);
#pragma unroll
            for (int i = 0; i < 4; ++i) tn[i] = tb[i]; }
          const float scr = sc * __builtin_amdgcn_exp2f((float)(row & 127) * dec_l2);
#pragma unroll
          for (int i = 0; i < 8; ++i) { const float csx = tc[i >> 1][2 * (i & 1)], csy = tc[i >> 1][2 * (i & 1) + 1]; const float x1 = v[0][i], x2 = v[1][i]; v[0][i] = (x1 * csx - x2 * csy) * scr; v[1][i] = (x2 * csx + x1 * csy) * scr; }
        }
        if (TYPE == 3 || TYPE == 4) {
#pragma unroll
          for (int bj = 0; bj < 2; ++bj)
#pragma unroll
            for (int i = 0; i < 8; i += 2) gelu2(v[bj][i], v[bj][i + 1]);
        }
        if (TYPE == 2 || TYPE == 4) {
          float ss = 0.f;
#pragma unroll
          for (int bj = 0; bj < 2; ++bj)
#pragma unroll
            for (int i = 0; i < 8; ++i) ss += v[bj][i] * v[bj][i];
          ss += __shfl_xor(ss, 16); ss += __shfl_xor(ss, 32);
          const float rs = rsqrtf(ss * (1.f / 64.f) + EPS);
#pragma unroll
          for (int bj = 0; bj < 2; ++bj)
#pragma unroll
            for (int i = 0; i < 8; ++i) v[bj][i] = (TYPE == 2) ? v[bj][i] * rs * gv[bj][i] : v[bj][i] * rs;
        }
        if (TYPE == 5) {
          float* gp = gates + (size_t)row * 24 + 8 * fq;
#pragma unroll
          for (int i = 0; i < 8; ++i) if (8 * fq + i < 18) gp[i] = sigmoidf(v[0][i]);
        } else {
          bf16_t* dst = HB + ((size_t)gidx * M_ + row) * 64 + 8 * fq;
#pragma unroll
          for (int bj = 0; bj < 2; ++bj) { u32x4 w; w.x = pk2(v[bj][0], v[bj][1]); w.y = pk2(v[bj][2], v[bj][3]); w.z = pk2(v[bj][4], v[bj][5]); w.w = pk2(v[bj][6], v[bj][7]); *(u32x4*)(dst + 32 * bj) = w; }
        }
      }
  }
  __device__ __forceinline__ void operator()(const f32x4 (&acc)[2][2][4][2], const pg8::Unit& u, int wr, int wc, int fr_in, int fq_in) const {
    int fr = fr_in, fq = fq_in; asm volatile("" : "+v"(fr), "+v"(fq));
    const int gidx = u.pn * 4 + wc;
    if (gidx > 50) return;
    if (gidx < 12) { const float lg2 = log2f(1.f - exp2f(-5.f - (float)(gidx % 6))); rows<0>(acc, u, wr, fr, fq, gidx, (gidx >= 6) ? 0.125f : 1.f, (gidx >= 6) ? -lg2 : lg2, nullptr); }
    else if (gidx < 24) rows<1>(acc, u, wr, fr, fq, gidx, 1.f, 0.f, nullptr);
    else if (gidx < 30) rows<2>(acc, u, wr, fr, fq, gidx, 0.125f * 1.4426950408889634f, 0.f, q_gain);
    else if (gidx == 34 || gidx == 35) rows<2>(acc, u, wr, fr, fq, gidx, 1.f, 0.f, k_gain + 64);
    else if (gidx == 38 || gidx == 39) rows<2>(acc, u, wr, fr, fq, gidx, 1.f, 0.f, k_gain + 128);
    else if (gidx < 42) rows<1>(acc, u, wr, fr, fq, gidx, 1.f, 0.f, nullptr);
    else if (gidx < 46) rows<3>(acc, u, wr, fr, fq, gidx, 1.f, 0.f, nullptr);
    else if (gidx < 50) rows<4>(acc, u, wr, fr, fq, gidx, 1.f, 0.f, nullptr);
    else rows<5>(acc, u, wr, fr, fq, gidx, 1.f, 0.f, nullptr);
  }
};
struct EpiRes {
  static constexpr bool PERM = true, AFTER_DRAIN = false;
  const float* xin32; float* xout32; bf16_t* xb; float* ssq;
  template <bool IN32, bool OUT32>
  __device__ __forceinline__ void rows(const f32x4 (&acc)[2][2][4][2], const pg8::Unit& u, int wr, int wc, int fr, int fq) const {
#pragma unroll
    for (int ai = 0; ai < 2; ++ai)
#pragma unroll
      for (int m = 0; m < 4; ++m) {
        const int row = u.pm * 256 + ai * 128 + wr * 64 + m * 16 + fr;
        float ss = 0.f;
#pragma unroll
        for (int bj = 0; bj < 2; ++bj) {
          const size_t o = (size_t)row * D_ + u.pn * 256 + bj * 128 + wc * 32 + 8 * fq;
          f32x4 x0, x1;
          if (IN32) { x0 = *(const f32x4*)(xin32 + o); x1 = *(const f32x4*)(xin32 + o + 4); }
          else { const u32x4 w = *(const u32x4*)(xb + o); x0 = (f32x4){__uint_as_float(w.x << 16), __uint_as_float(w.x & 0xffff0000u), __uint_as_float(w.y << 16), __uint_as_float(w.y & 0xffff0000u)};
                 x1 = (f32x4){__uint_as_float(w.z << 16), __uint_as_float(w.z & 0xffff0000u), __uint_as_float(w.w << 16), __uint_as_float(w.w & 0xffff0000u)}; }
          const f32x4 y0 = x0 + acc[ai][bj][m][0], y1 = x1 + acc[ai][bj][m][1];
          if (OUT32) { *(f32x4*)(xout32 + o) = y0; *(f32x4*)(xout32 + o + 4) = y1; }
          else { u32x4 w; w.x = pk2(y0[0], y0[1]); w.y = pk2(y0[2], y0[3]); w.z = pk2(y1[0], y1[1]); w.w = pk2(y1[2], y1[3]); *(u32x4*)(xb + o) = w;
            ss += (y0[0] * y0[0] + y0[1] * y0[1]) + (y0[2] * y0[2] + y0[3] * y0[3]) + (y1[0] * y1[0] + y1[1] * y1[1]) + (y1[2] * y1[2] + y1[3] * y1[3]); }
        }
        if (!OUT32) { ss += __shfl_xor(ss, 16); ss += __shfl_xor(ss, 32);
          if (fq == 0) ssq[(size_t)row * 16 + u.pn * 4 + wc] = ss; }
      }
  }
  __device__ __forceinline__ void operator()(const f32x4 (&acc)[2][2][4][2], const pg8::Unit& u, int wr, int wc, int fr_in, int fq_in) const {
    int fr = fr_in, fq = fq_in; asm volatile("" : "+v"(fr), "+v"(fq));
    if (xin32) rows<true, false>(acc, u, wr, wc, fr, fq); else if (xout32) rows<false, true>(acc, u, wr, wc, fr, fq); else rows<false, false>(acc, u, wr, wc, fr, fq);
  }
};
struct EpiGU {
  static constexpr bool PERM = true, AFTER_DRAIN = false;
  const float* ssq; bf16_t* act;
  __device__ __forceinline__ void operator()(const f32x4 (&acc)[2][2][4][2], const pg8::Unit& u, int wr, int wc, int fr_in, int fq_in) const {
    int fr = fr_in, fq = fq_in; asm volatile("" : "+v"(fr), "+v"(fq));
    const float* __restrict__ ssq = this->ssq; bf16_t* __restrict__ act = this->act;
    const int row0 = u.pm * 256 + wr * 64 + fr;
    float rstd8[8]; unit_rstd(ssq, row0, fq, rstd8);
#pragma unroll
    for (int ai = 0; ai < 2; ++ai)
#pragma unroll
      for (int m = 0; m < 4; ++m) {
        const int row = row0 + ai * 128 + m * 16;
        const float rstd = rstd8[ai * 4 + m];
        float a[8];
#pragma unroll
        for (int n = 0; n < 2; ++n)
#pragma unroll
          for (int e = 0; e < 4; e += 2) { const float g0 = acc[ai][0][m][n][e] * rstd, u0 = acc[ai][1][m][n][e] * rstd, g1 = acc[ai][0][m][n][e + 1] * rstd, u1 = acc[ai][1][m][n][e + 1] * rstd;
            const float e0 = fminf(__builtin_amdgcn_exp2f(-1.4426950408889634f * g0), 1e15f), e1 = fminf(__builtin_amdgcn_exp2f(-1.4426950408889634f * g1), 1e15f);
            div2(g0 * u0, 1.f + e0, g1 * u1, 1.f + e1, a[4 * n + e], a[4 * n + e + 1]); }
        u32x4 w; w.x = pk2(a[0], a[1]); w.y = pk2(a[2], a[3]); w.z = pk2(a[4], a[5]); w.w = pk2(a[6], a[7]);
        *(u32x4*)(act + (size_t)row * DFF + u.pn * 128 + wc * 32 + 8 * fq) = w;
      }
  }
};

__device__ __forceinline__ void transpose_item(const float* W, int K, int ldw, const float* gain, bf16_t* WT, int v0, int src0, int nvalid, int k0, LAS float* scr, int lane) {
  const int col = lane & 31;
  float wv[32];
#pragma unroll
  for (int i = 0; i < 32; ++i) { const int kk = 2 * i + (lane >> 5); wv[i] = (col < nvalid) ? W[(size_t)(k0 + kk) * ldw + src0 + col] : 0.f; }
#pragma unroll
  for (int i = 0; i < 32; ++i) { const int kk = 2 * i + (lane >> 5); scr[kk * 33 + col] = gain ? wv[i] * gain[k0 + kk] : wv[i]; }
  asm volatile("s_waitcnt lgkmcnt(0)" ::: "memory");
  const int c = lane & 7;
#pragma unroll
  for (int j = 0; j < 4; ++j) { const int n = (lane >> 3) + 8 * j; const LAS float* s = scr + (8 * c) * 33 + n;
    u32x4 o; o.x = pk2(s[0 * 33], s[1 * 33]); o.y = pk2(s[2 * 33], s[3 * 33]); o.z = pk2(s[4 * 33], s[5 * 33]); o.w = pk2(s[6 * 33], s[7 * 33]);
    *(u32x4*)(WT + (size_t)(v0 + n) * K + k0 + 8 * c) = o; }
  asm volatile("s_waitcnt lgkmcnt(0)" ::: "memory");
}
__device__ __forceinline__ void convert_weights(const P& p, LAS unsigned char* lds, int wave, int lane, int gw, int NGW, int it0, int it1) {
  LAS float* scr = (LAS float*)(lds + wave * 16384);
  for (int it = it0 + gw; it < it1; it += NGW) {
    const int layer = it / 6400; int r = it % 6400;
    if (r < 1664) {
      const int vb = r >> 4, kb = r & 15, v0 = vb * 32, pn = v0 >> 8, bj = (v0 >> 7) & 1, wc = (v0 >> 5) & 3, g = pn * 4 + wc;
      int src0 = 0, nvalid = 32;
      if (g < 50) src0 = proj_col0(g) + 32 * bj; else if (g == 50 && bj == 0) { src0 = 2688; nvalid = 18; } else nvalid = 0;
      transpose_item(p.w_in + (size_t)layer * D_ * INW, D_, INW, p.attn_norm + layer * D_, (bf16_t*)(p.ws + OFF_WIN) + (size_t)layer * NPROJ * D_, v0, src0, nvalid, kb * 64, scr, lane);
      continue;
    }
    r -= 1664;
    if (r < 512) { const int vb = r >> 4, kb = r & 15;
      transpose_item(p.w_out + (size_t)layer * D_ * D_, D_, D_, nullptr, (bf16_t*)(p.ws + OFF_WO) + (size_t)layer * D_ * D_, vb * 32, vb * 32, 32, kb * 64, scr, lane); continue; }
    r -= 512;
    if (r < 2816) { const int vb = r >> 4, kb = r & 15, v0 = vb * 32, pn = v0 >> 8, bj = (v0 >> 7) & 1, c0 = v0 & 127;
      transpose_item(p.w_gu + (size_t)layer * D_ * 2 * DFF, D_, 2 * DFF, p.ffn_norm + layer * D_, (bf16_t*)(p.ws + OFF_WGU) + (size_t)layer * 2 * DFF * D_, v0, bj * DFF + 128 * pn + c0, 32, kb * 64, scr, lane); continue; }
    r -= 2816;
    { const int vb = r / 44, kb = r % 44;
      transpose_item(p.w_down + (size_t)layer * DFF * D_, DFF, D_, nullptr, (bf16_t*)(p.ws + OFF_WD) + (size_t)layer * D_ * DFF, vb * 32, vb * 32, 32, kb * 64, scr, lane); }
  }
}
__device__ __forceinline__ void ph_prologue(const Cx& cx, const P& p, LAS unsigned char* lds) {
  const int tid = cx.tid, lane = tid & 63, wave = tid >> 6;
  LAS float* scr = (LAS float*)(lds + wave * 16384);
  const int gw = cx.bid * 8 + wave, NGW = cx.G * 8;
  convert_weights(p, lds, wave, lane, gw, NGW, 0, 1664);
  bf16_t* XB = (bf16_t*)(p.ws + OFF_XB); float* ssq = (float*)(p.ws + OFF_SSQ);
  for (int r = gw; r < M_; r += 2 * NGW) {
    const int r2 = r + NGW;
    const f32x4* xa = (const f32x4*)(p.x + (size_t)r * D_); const f32x4* xb2 = (const f32x4*)(p.x + (size_t)((r2 < M_) ? r2 : r) * D_);
    f32x4 va[4], vb[4];
#pragma unroll
    for (int j = 0; j < 4; ++j) { va[j] = xa[lane + 64 * j]; vb[j] = xb2[lane + 64 * j]; }
    float sa = 0.f, sb = 0.f;
#pragma unroll
    for (int j = 0; j < 4; ++j) { sa += (va[j][0] * va[j][0] + va[j][1] * va[j][1]) + (va[j][2] * va[j][2] + va[j][3] * va[j][3]); sb += (vb[j][0] * vb[j][0] + vb[j][1] * vb[j][1]) + (vb[j][2] * vb[j][2] + vb[j][3] * vb[j][3]);
      *(uint2*)(XB + (size_t)r * D_ + (lane + 64 * j) * 4) = make_uint2(pk2(va[j][0], va[j][1]), pk2(va[j][2], va[j][3]));
      if (r2 < M_) *(uint2*)(XB + (size_t)r2 * D_ + (lane + 64 * j) * 4) = make_uint2(pk2(vb[j][0], vb[j][1]), pk2(vb[j][2], vb[j][3])); }
    sa = wave_sum(sa); sb = wave_sum(sb);
    if (lane < 16) { ssq[(size_t)r * 16 + lane] = (lane == 0) ? sa : 0.f; if (r2 < M_) ssq[(size_t)r2 * 16 + lane] = (lane == 0) ? sb : 0.f; }
  }
  if (cx.bid == 0) for (int i = tid; i < 1024; i += NTHR) ((unsigned*)(p.ws + OFF_CTR))[i] = 0u;
  const int rot = 1664 % NGW, gwr = (gw >= rot) ? gw - rot : gw + NGW - rot;
  for (int it = gwr; it < 256; it += NGW) { const int mj = it >> 6, vb = (it >> 5) & 1, kb = it & 31;
    transpose_item(p.cmp_w1 + (size_t)mj * 2048 * 64, 2048, 64, nullptr, (bf16_t*)(p.ws + OFF_W1T) + (size_t)mj * 64 * 2048, vb * 32, vb * 32, 32, kb * 64, scr, lane); }
  if (cx.bid >= cx.G - 4) {
    const int mj = cx.bid - (cx.G - 4), rg = lane >> 4, fc = (lane & 15) * 4;
    const float* w1 = p.cmp_w1 + (size_t)mj * 2048 * 64; const float* pe = p.cmp_pe + (size_t)mj * 2048;
    f32x4 acc = {0.f, 0.f, 0.f, 0.f};
#pragma unroll 16
    for (int k = 0; k < 64; ++k) { const int i = wave * 256 + k * 4 + rg; const f32x4 w = *(const f32x4*)(w1 + (size_t)i * 64 + fc); const float pv = pe[i]; acc += w * pv; }
#pragma unroll
    for (int e = 0; e < 4; ++e) { acc[e] += __shfl_xor(acc[e], 16); acc[e] += __shfl_xor(acc[e], 32); }
    LAS float* red = (LAS float*)(lds + 135168);
    if (lane < 16) { red[wave * 64 + fc] = acc[0]; red[wave * 64 + fc + 1] = acc[1]; red[wave * 64 + fc + 2] = acc[2]; red[wave * 64 + fc + 3] = acc[3]; }
    __syncthreads();
    if (tid < 64) { float a = 0.f;
#pragma unroll
      for (int w = 0; w < 8; ++w) a += red[w * 64 + tid];
      ((float*)(p.ws + OFF_C1))[mj * 64 + tid] = a; }
    __syncthreads();
  }
  for (int i = cx.bid * NTHR + tid; i < 6 * 768; i += cx.G * NTHR) { const int hd = i / 768, k = i % 768; float v = 0.f;
    if (k < 115) v = (k == 0) ? -1e30f : p.rel_bias[t5_bucket(k - 1) * 6 + hd] * 1.4426950408889634f;
    else if (k >= 128 && k < 642) { const int kk = k - 128; v = (kk == 0 || kk == 513) ? -1e30f : p.rel_bias[t5_bucket(kk - 1) * 6 + hd] * 1.4426950408889634f; }
    ((float*)(p.ws + OFF_BTAB))[i] = v; }
  for (int i = cx.bid * NTHR + tid; i < 4 * 4096; i += cx.G * NTHR) {
    const int mj = i >> 12, jj = i & 7, ln = (i >> 3) & 63, s2 = (i >> 9) & 1, fb = (i >> 10) & 1, eb = (i >> 11) & 1, r32_ = ln & 31, hi_ = ln >> 5;
    ((bf16_t*)(p.ws + OFF_W2F))[i] = f2bf(p.cmp_w2[(size_t)mj * 4096 + (32 * fb + 16 * s2 + 8 * (jj >> 2) + 4 * hi_ + (jj & 3)) * 64 + 32 * eb + r32_]); }
  for (int i = cx.bid * NTHR + tid; i < 2 * 4 * 128 * 128; i += cx.G * NTHR) { const int tt = (i >> 7) & 127, ss = i & 127; ((bf16_t*)(p.ws + OFF_WSB))[i] = (ss <= tt) ? f2bf(p.gm_ws[i]) : (bf16_t)0; }
  float2* tab = (float2*)(p.ws + OFF_ROPE);
  for (int i = cx.bid * NTHR + tid; i < T_ * 32; i += cx.G * NTHR) {
    const int t = i >> 5, k = i & 31;
    const float inv = powf(10000.0f, -(float)k / 32.0f);
    const float ang = (float)t * inv;
    tab[i] = make_float2(cosf(ang), sinf(ang));
  }
}
namespace att {
using bf16x8 = __attribute__((ext_vector_type(8))) short;
using s16x4 = __attribute__((ext_vector_type(4))) short;
using f32x16 = __attribute__((ext_vector_type(16))) float;
constexpr int NW = 8, QBLK = 32, QB = 256, KVBLK = 64;
constexpr int SLOTB = 8192, LDS_K = 0, LDS_V = 3 * SLOTB, LDS_WS = 6 * SLOTB, LDS_OST = LDS_WS + NW * 256, LDS_TAB = LDS_OST + NW * 8192, LDS_SELW = LDS_TAB + 2304, LDS_END = LDS_SELW + NW * 512;
static_assert(LDS_END <= 131072, "attention LDS");
constexpr float NEGBIG = -1e30f;
#define SBAR() __builtin_amdgcn_sched_barrier(0)
#define PIN(x) asm volatile("" : "+v"(x))
#define MFMA(a, b, c) __builtin_amdgcn_mfma_f32_32x32x16_bf16(a, b, c, 0, 0, 0)
#define WAIT_BAR(N) asm volatile("s_waitcnt vmcnt(" #N ") lgkmcnt(0)\n\ts_barrier" ::: "memory")
__device__ __forceinline__ int crow(int r, int hi) { return (r & 3) + 8 * (r >> 2) + 4 * hi; }
__device__ __forceinline__ unsigned cvtpk(float lo, float hi) { unsigned r; asm("v_cvt_pk_bf16_f32 %0, %1, %2" : "=v"(r) : "v"(lo), "v"(hi)); return r; }
__device__ __forceinline__ void glds16(const void* g, unsigned lds_base) {
  unsigned sv; asm volatile("s_mov_b32 %0, m0\n\ts_mov_b32 m0, %2\n\ts_nop 0\n\tglobal_load_lds_dwordx4 %1, off\n\ts_mov_b32 m0, %0" : "=&s"(sv) : "v"(g), "s"(lds_base) : "memory"); }
typedef __attribute__((address_space(3))) const char* lds_cptr;
typedef short v4i16_t __attribute__((ext_vector_type(4)));
__device__ __forceinline__ void kload2(bf16x8* kf, lds_cptr kp, int d0) { kf[2 * d0] = *(const __attribute__((address_space(3))) bf16x8*)(kp + d0 * 2048); kf[2 * d0 + 1] = *(const __attribute__((address_space(3))) bf16x8*)(kp + d0 * 2048 + 512); }
__device__ __forceinline__ s16x4 vtr(lds_cptr p) { return __builtin_bit_cast(s16x4, __builtin_amdgcn_ds_read_tr16_b64_v4i16((__attribute__((address_space(3))) v4i16_t*)p)); }
#define MX3(a, b, c) __builtin_fmaxf(__builtin_fmaxf((a), (b)), (c))
__device__ __forceinline__ float rowmax(const f32x16& p0, const f32x16& p1) {
  float a = MX3(p0[0], p0[1], p1[0]), b = MX3(p0[2], p0[3], p1[1]); a = MX3(a, p1[2], p1[3]);
#pragma unroll
  for (int r = 4; r < 16; r += 4) { a = MX3(a, p0[r], p0[r + 1]); b = MX3(b, p0[r + 2], p0[r + 3]); a = MX3(a, p1[r], p1[r + 1]); b = MX3(b, p1[r + 2], p1[r + 3]); }
  float m = __builtin_fmaxf(a, b); auto rr = __builtin_amdgcn_permlane32_swap(__float_as_uint(m), __float_as_uint(m), false, false);
  return __builtin_fmaxf(__uint_as_float(rr[0]), __uint_as_float(rr[1])); }
template <int S, int IMAX>
__device__ __forceinline__ void bias_hook(f32x16& p0, f32x16& p1, int dl, const __attribute__((address_space(3))) float* tab) {
#pragma unroll
  for (int r = 0; r < 16; ++r) { const int c = (r & 3) + 8 * (r >> 2); const int d0 = dl - S * c, d1 = d0 - 32 * S;
    p0[r] += tab[1 + min(max(d0, -1), IMAX)]; p1[r] += tab[1 + min(max(d1, -1), IMAX)]; } }

template <int MODE>
__device__ __forceinline__ void nsa_pass(const int tid, const bf16_t* Qrows, const bf16_t* __restrict__ Kt0, const bf16_t* __restrict__ Vt0, const int NT, const int dq, const float b31,
                                         const float* gate, char* lds, const bool first, att::bf16x8 (&qr)[4], const bool preK = false, const bf16_t* __restrict__ nextK = nullptr) {
  constexpr int S = (MODE == 2) ? 16 : 1, IMAX = (MODE == 1) ? 512 : 113; constexpr float REF = 8.f;
  const int lane = tid & 63, r32 = lane & 31, hi = lane >> 5; const int wid = __builtin_amdgcn_readfirstlane(tid >> 6);
  const bf16_t* Qw = Qrows + (size_t)(wid * QBLK) * 64;
  const unsigned lds0 = (unsigned)(uintptr_t)lds; float* wsf = (float*)(lds + LDS_WS) + wid * 64;
  const __attribute__((address_space(3))) float* tab = (const __attribute__((address_space(3))) float*)(uintptr_t)(lds0 + LDS_TAB);
  const __attribute__((address_space(3))) unsigned* selw = (const __attribute__((address_space(3))) unsigned*)(uintptr_t)(lds0 + LDS_SELW + wid * 512);
  const bf16_t* ksrc = Kt0 + (size_t)lane * 64 + wid * 8;
  const bf16_t* vsrc = Vt0 + (size_t)(16 * (wid & 3) + (lane >> 2)) * 64 + (wid >> 2) * 32 + (lane & 3) * 8;
  const unsigned kdst = lds0 + LDS_K + wid * 1024, vdst = lds0 + LDS_V + wid * 1024;
#define DMA_K(t, slot) glds16(ksrc + (size_t)(t) * KVBLK * 64, (unsigned)__builtin_amdgcn_readfirstlane(kdst + (slot)))
#define DMA_V(t, slot) glds16(vsrc + (size_t)(t) * KVBLK * 64, (unsigned)__builtin_amdgcn_readfirstlane(vdst + (slot)))
  const lds_cptr vp0 = (lds_cptr)(uintptr_t)lds0 + LDS_V + ((lane >> 4) & 1) * 32 + (lane & 3) * 8 + (4 * hi + ((lane & 15) >> 2)) * 64;
  const lds_cptr kp0 = (lds_cptr)(uintptr_t)lds0 + LDS_K + hi * 1024 + r32 * 16;
  if (!preK) { DMA_K(0, 0); DMA_V(0, 0); DMA_K(1, SLOTB); } else { DMA_V(0, 0); }
  if (first) {
#pragma unroll
    for (int d0 = 0; d0 < 4; ++d0) qr[d0] = *reinterpret_cast<const bf16x8*>(&Qw[(size_t)r32 * 64 + d0 * 16 + hi * 8]);
  }
  f32x16 o[2], o2; o[0] = f32x16{}; o[1] = f32x16{}; o2 = f32x16{};
  const f32x16 zero16 = f32x16{};
  bf16x8 ones; _Pragma("unroll") for (int r = 0; r < 8; ++r) ones[r] = (short)0x3f80; PIN(ones);
  unsigned mk;
  const int qrel = wid * QBLK + r32;
  const int dlq = dq + qrel - S * 4 * hi;
  const int dwv = dq + 32 * wid;
#define HCLASS(t) (((dwv + 31 - S * 64 * (t)) < 0 || (MODE == 1 && (dwv - S * (64 * (t) + 63)) >= 512)) ? 0 : \
                   (((dwv - S * (64 * (t) + 63)) >= 113 && (MODE != 1 || (dwv + 31 - S * 64 * (t)) < 512)) ? 1 : 2))
  f32x16 pA0, pA1, pB0, pB1; bf16x8 kf[8]; s16x4 vlo[8], vhi[8]; u32x4 pw0, pw1, pw2, pw3;
  int sl_prev = 0, sl_cur = 0, sl_next = SLOTB;
#define ROT() do { sl_prev = sl_cur; sl_cur = sl_next; sl_next = (sl_next == 2 * SLOTB) ? 0 : sl_next + SLOTB; } while (0)
#define EX(v) __builtin_amdgcn_exp2f(v)
#define SELBIT(t) ((MODE == 0) ? (((selw[(t)] >> r32) & 1u) != 0u) : true)
  if (!preK) { DMA_K(2, 2 * SLOTB); WAIT_BAR(3); } else { WAIT_BAR(1); }
  _Pragma("unroll") for (int d0 = 0; d0 < 4; ++d0) kload2(kf, kp0, d0);
  pA0 = MFMA(kf[0], qr[0], zero16); pA1 = MFMA(kf[1], qr[0], zero16); pA0 = MFMA(kf[2], qr[1], pA0); pA1 = MFMA(kf[3], qr[1], pA1);
  pA0 = MFMA(kf[4], qr[2], pA0); pA1 = MFMA(kf[5], qr[2], pA1); pA0 = MFMA(kf[6], qr[3], pA0); pA1 = MFMA(kf[7], qr[3], pA1);
  { const bool band0 = (MODE != 0) || (NT < 8); const int hc0 = band0 ? HCLASS(0) : 1;
    if (hc0 == 2) bias_hook<S, IMAX>(pA0, pA1, dlq, tab);
    mk = (SELBIT(0) && (hc0 != 0)) ? 0xffffffffu : 0u;
#pragma unroll
    for (int r = 0; r < 16; ++r) { pA0[r] = EX(pA0[r]); pA1[r] = EX(pA1[r]); } }
  WAIT_BAR(0);
  DMA_K(3, 0); DMA_V(1, SLOTB); ROT();
  _Pragma("unroll") for (int d0 = 0; d0 < 4; ++d0) kload2(kf, kp0 + sl_cur, d0);
  WAIT_BAR(2);
#define PKW(P, i) cvtpk(P[i], P[i + 1])
#define PAF(k) __builtin_bit_cast(bf16x8, pw##k)
#define VFR(i) (bf16x8){vlo[i][0], vlo[i][1], vlo[i][2], vlo[i][3], vhi[i][0], vhi[i][1], vhi[i][2], vhi[i][3]}
#define VRD(i) do { vlo[i] = vtr(vp_ + (((i) >> 2) * 4096 + ((i) & 3) * 1024)); vhi[i] = vtr(vp_ + (((i) >> 2) * 4096 + ((i) & 3) * 1024 + 512)); } while (0)
#define KRD(G, d0) do { if (G) { kload2(kf, kp0 + sl_next, d0); SBAR(); } } while (0)
#define GAPA(MF, W0, W1, PW) do { MF; W0; W1; PIN(PW); SBAR(); } while (0)
#define GAPT(k, X, b) do { o[0] = MFMA(PAF(k), VFR(k), o[0]); X[b] = EX(X[b]); X[b + 1] = EX(X[b + 1]); X[b + 2] = EX(X[b + 2]); PIN(X); SBAR(); \
    o[1] = MFMA(PAF(k), VFR(4 + (k)), o[1]); X[b + 3] = EX(X[b + 3]); X[b + 4] = EX(X[b + 4]); X[b + 5] = EX(X[b + 5]); PIN(X); SBAR(); \
    o2 = MFMA(PAF(k), ones, o2); X[b + 6] = EX(X[b + 6]); X[b + 7] = EX(X[b + 7]); PIN(X); SBAR(); } while (0)
#define STEP(C0, C1, P0, P1, t, MASK, GK, GV, GL) do { SBAR(); \
    const lds_cptr vp_ = vp0 + sl_prev; const unsigned sw_ = (MODE == 0) ? selw[(t)] : 0u;     \
    VRD(0); SBAR(); GAPA(C0 = MFMA(kf[0], qr[0], zero16), pw0[0] = PKW(P0, 0) & mk,  pw0[1] = PKW(P0, 2) & mk,  pw0); \
    VRD(4); SBAR(); GAPA(C1 = MFMA(kf[1], qr[0], zero16), pw0[2] = PKW(P0, 4) & mk,  pw0[3] = PKW(P0, 6) & mk,  pw0); \
    VRD(1); SBAR(); GAPA(C0 = MFMA(kf[2], qr[1], C0),    pw1[0] = PKW(P0, 8) & mk,  pw1[1] = PKW(P0, 10) & mk, pw1); \
    VRD(5); SBAR(); GAPA(C1 = MFMA(kf[3], qr[1], C1),    pw1[2] = PKW(P0, 12) & mk, pw1[3] = PKW(P0, 14) & mk, pw1); \
    VRD(2); SBAR(); GAPA(C0 = MFMA(kf[4], qr[2], C0),    pw2[0] = PKW(P1, 0) & mk,  pw2[1] = PKW(P1, 2) & mk,  pw2); \
    VRD(6); SBAR(); GAPA(C1 = MFMA(kf[5], qr[2], C1),    pw2[2] = PKW(P1, 4) & mk,  pw2[3] = PKW(P1, 6) & mk,  pw2); \
    VRD(3); SBAR(); GAPA(C0 = MFMA(kf[6], qr[3], C0),    pw3[0] = PKW(P1, 8) & mk,  pw3[1] = PKW(P1, 10) & mk, pw3); \
    VRD(7); SBAR(); GAPA(C1 = MFMA(kf[7], qr[3], C1),    pw3[2] = PKW(P1, 12) & mk, pw3[3] = PKW(P1, 14) & mk, pw3); \
    if (GK) DMA_K((t) + 3, sl_cur); if (GV) DMA_V((t) + 1, sl_next); \
    const int hc_ = (MASK) ? HCLASS(t) : 1; \
    if (hc_ == 2) bias_hook<S, IMAX>(C0, C1, dlq - S * 64 * (t), tab); \
    mk = (((MODE == 0) ? (((sw_ >> r32) & 1u) != 0u) : true) && (hc_ != 0)) ? 0xffffffffu : 0u; SBAR(); \
    GAPT(0, C0, 0); KRD(GL, 0); KRD(GL, 1); GAPT(1, C0, 8); KRD(GL, 2); KRD(GL, 3); GAPT(2, C1, 0); GAPT(3, C1, 8); \
    } while (0)
  int t = 1;
  if (MODE == 0) {
    for (; t + 7 < NT; t += 2) {
      STEP(pB0, pB1, pA0, pA1, t, false, true, true, true);     WAIT_BAR(2); ROT();
      STEP(pA0, pA1, pB0, pB1, t + 1, false, true, true, true); WAIT_BAR(2); ROT();
    }
  }
#define ENDW(tt) do { if ((tt) + 3 < NT) { WAIT_BAR(2); } else if ((tt) + 2 < NT) { WAIT_BAR(1); } else { WAIT_BAR(0); } } while (0)
  for (; t + 1 < NT; t += 2) {
    STEP(pB0, pB1, pA0, pA1, t, true, (t + 3 < NT), (t + 1 < NT), (t + 1 < NT));         ENDW(t);     ROT();
    STEP(pA0, pA1, pB0, pB1, t + 1, true, (t + 4 < NT), (t + 2 < NT), (t + 2 < NT));     ENDW(t + 1); ROT();
  }
  if (nextK) { const bf16_t* nk = nextK + (size_t)lane * 64 + wid * 8;
    glds16(nk, (unsigned)__builtin_amdgcn_readfirstlane(kdst)); glds16(nk + 4096, (unsigned)__builtin_amdgcn_readfirstlane(kdst + SLOTB)); glds16(nk + 8192, (unsigned)__builtin_amdgcn_readfirstlane(kdst + 2 * SLOTB)); }
  STEP(pB0, pB1, pA0, pA1, NT - 1, true, false, false, false);
  { pw0 = (u32x4){PKW(pB0, 0) & mk, PKW(pB0, 2) & mk, PKW(pB0, 4) & mk, PKW(pB0, 6) & mk}; pw1 = (u32x4){PKW(pB0, 8) & mk, PKW(pB0, 10) & mk, PKW(pB0, 12) & mk, PKW(pB0, 14) & mk};
    pw2 = (u32x4){PKW(pB1, 0) & mk, PKW(pB1, 2) & mk, PKW(pB1, 4) & mk, PKW(pB1, 6) & mk}; pw3 = (u32x4){PKW(pB1, 8) & mk, PKW(pB1, 10) & mk, PKW(pB1, 12) & mk, PKW(pB1, 14) & mk};
    const lds_cptr vp_ = vp0 + sl_cur; _Pragma("unroll") for (int i = 0; i < 8; ++i) VRD(i);
    o[0] = MFMA(PAF(0), VFR(0), o[0]); o[1] = MFMA(PAF(0), VFR(4), o[1]); o[0] = MFMA(PAF(1), VFR(1), o[0]); o[1] = MFMA(PAF(1), VFR(5), o[1]);
    o[0] = MFMA(PAF(2), VFR(2), o[0]); o[1] = MFMA(PAF(2), VFR(6), o[1]); o[0] = MFMA(PAF(3), VFR(3), o[0]); o[1] = MFMA(PAF(3), VFR(7), o[1]);
    o2 = MFMA(PAF(0), ones, o2); o2 = MFMA(PAF(1), ones, o2); o2 = MFMA(PAF(2), ones, o2); o2 = MFMA(PAF(3), ones, o2); }
  if (hi == 0) wsf[32 + r32] = gate[(size_t)qrel * 24];
  asm volatile("s_waitcnt lgkmcnt(0)" ::: "memory");
  float rli[16];
#pragma unroll
  for (int r = 0; r < 16; ++r) rli[r] = wsf[32 + crow(r, hi)];
  asm volatile("s_waitcnt lgkmcnt(0)" ::: "memory");
#pragma unroll
  for (int r = 0; r < 16; ++r) { const float q_ = rli[r] * __builtin_amdgcn_rcpf(o2[r]); rli[r] = (o2[r] > 0.f) ? q_ : 0.f; }
  float* stg = (float*)(lds + LDS_OST) + wid * 2048;
  if (first) {
#pragma unroll
    for (int r = 0; r < 16; ++r) { const int orow = crow(r, hi);
#pragma unroll
      for (int d0 = 0; d0 < 2; ++d0) stg[orow * 64 + d0 * 32 + r32] = o[d0][r] * rli[r]; }
  } else {
#pragma unroll
    for (int r = 0; r < 16; ++r) { const int orow = crow(r, hi);
#pragma unroll
      for (int d0 = 0; d0 < 2; ++d0) stg[orow * 64 + d0 * 32 + r32] += o[d0][r] * rli[r]; }
  }
  asm volatile("s_waitcnt lgkmcnt(0)\n\ts_barrier" ::: "memory");
#undef DMA_K
#undef DMA_V
#undef ROT
#undef EX
#undef SELBIT
#undef HCLASS
#undef PKW
#undef PAF
#undef VFR
#undef VRD
#undef KRD
#undef ENDW
#undef GAPA
#undef GAPT
#undef STEP
}
#undef SBAR
#undef PIN
#undef MFMA
#undef WAIT_BAR
#undef MX3
}

#define L2E 1.4426950408889634f
__device__ __forceinline__ void topk_unit(const Cx& cx, const P& p, int layer, int u, char* lds) {
  using att::bf16x8; using att::f32x16;
  const int tid = cx.tid, lane = tid & 63, r32 = lane & 31, hi = lane >> 5, wid = cx.wv, grp = wid & 3, half = wid >> 2;
  const int qb = 63 - (u >> 2), bg = u & 3, b = bg >> 1, g = bg & 1, q0 = qb * 128;
  const int ntile64 = ((((q0 + 127) >> 4) + 1) + 63) >> 6;
  if (tid == 0) hand_wait((unsigned*)(p.ws + OFF_CTR) + 512 + layer * 64 + bg * 16, 16u);
  __syncthreads();
  const bf16_t* KCb = (const bf16_t*)(p.ws + OFF_KC) + (size_t)bg * 512 * 64;
  const unsigned lds0 = (unsigned)(uintptr_t)lds;
  constexpr int L_IMP = 65536, L_LSUM = 131072 + 1024, L_TAB = 139264;
  for (int i = tid; i < ntile64 * 512; i += NTHR) { const int n = i >> 3, c = i & 7; const unsigned long long* q8 = (const unsigned long long*)(KCb + (size_t)n * 64 + c * 8);
    const unsigned long long a = __hip_atomic_load(q8, __ATOMIC_RELAXED, __HIP_MEMORY_SCOPE_AGENT), b2 = __hip_atomic_load(q8 + 1, __ATOMIC_RELAXED, __HIP_MEMORY_SCOPE_AGENT);
    *(u32x4*)(lds + (n >> 6) * 8192 + c * 1024 + (n & 63) * 16) = (u32x4){(unsigned)a, (unsigned)(a >> 32), (unsigned)b2, (unsigned)(b2 >> 32)}; }
  float* tabw = (float*)(lds + L_TAB);
  for (int i = tid; i < 3 * 115; i += NTHR) { const int h = i / 115, k = i % 115; tabw[i] = ((const float*)(p.ws + OFF_BTAB))[(g * 3 + h) * 768 + k]; }
  float* impw = (float*)(lds + L_IMP) + wid * 2048;
#pragma unroll
  for (int s2 = 0; s2 < 32; ++s2) impw[s2 * 64 + lane] = 0.f;
  __syncthreads();
  const __attribute__((address_space(3))) float* tab = (const __attribute__((address_space(3))) float*)(uintptr_t)(lds0 + L_TAB);
  const att::lds_cptr kp0 = (att::lds_cptr)(uintptr_t)lds0 + hi * 1024 + r32 * 16;
  const int tq0 = q0 + grp * 32, t = tq0 + r32, cur = tq0 >> 6;
  const int NT32 = ((tq0 >> 4) + 1 + 31) >> 5;
  const int Th = (NT32 + 1) >> 1, T0 = half ? Th : 0, T1 = half ? NT32 : Th;
  const int nfar = (tq0 - 144) >> 4;
  const int Tnear0 = (nfar >= 31) ? ((nfar - 31) >> 5) + 1 : 0;
  const bf16_t* HB = (const bf16_t*)(p.ws + OFF_HB);
  float b31[3];
#pragma unroll
  for (int h = 0; h < 3; ++h) b31[h] = p.rel_bias[31 * 6 + g * 3 + h] * L2E;
  const int dl0 = t - 31 - 64 * hi;
  f32x16 zero16 = f32x16{}; asm volatile("" : "+v"(zero16));
#define TK_SCORES(T, h, sv) do { const att::lds_cptr kp_ = kp0 + ((T) >> 1) * 8192 + ((T) & 1) * 512; \
    const bf16x8 k0_ = *(const __attribute__((address_space(3))) bf16x8*)(kp_), k1_ = *(const __attribute__((address_space(3))) bf16x8*)(kp_ + 2048), \
                 k2_ = *(const __attribute__((address_space(3))) bf16x8*)(kp_ + 4096), k3_ = *(const __attribute__((address_space(3))) bf16x8*)(kp_ + 6144); \
    sv = __builtin_amdgcn_mfma_f32_32x32x16_bf16(k0_, qr[0], zero16, 0, 0, 0); sv = __builtin_amdgcn_mfma_f32_32x32x16_bf16(k1_, qr[1], sv, 0, 0, 0); \
    sv = __builtin_amdgcn_mfma_f32_32x32x16_bf16(k2_, qr[2], sv, 0, 0, 0); sv = __builtin_amdgcn_mfma_f32_32x32x16_bf16(k3_, qr[3], sv, 0, 0, 0); \
    if ((T) >= Tnear0) { const int dl_ = dl0 - 512 * (T); _Pragma("unroll") for (int r = 0; r < 16; ++r) { const int c_ = (r & 3) + 8 * (r >> 2); sv[r] = __builtin_amdgcn_exp2f(sv[r] + tab[(h) * 115 + 1 + min(max(dl_ - 16 * c_, -1), 113)]); } } \
    else { _Pragma("unroll") for (int r = 0; r < 16; ++r) sv[r] = __builtin_amdgcn_exp2f(sv[r] + b31[h]); } } while (0)
  float U[3][32]; float l[3];
#pragma unroll
  for (int h = 0; h < 3; ++h) {
    const bf16_t* Qh = HB + ((size_t)(24 + g * 3 + h) * M_ + (size_t)b * T_ + tq0) * 64;
    bf16x8 qr[4];
#pragma unroll
    for (int d0 = 0; d0 < 4; ++d0) qr[d0] = *reinterpret_cast<const bf16x8*>(Qh + (size_t)r32 * 64 + d0 * 16 + hi * 8);
    float lh = 0.f, carry = 0.f;
    if (half == 1 && T0 < T1) { f32x16 sv; TK_SCORES(T0 - 1, h, sv); carry = __shfl_xor(sv[15], 32); }
#define TK_FINISH(tt_, sv_) do { float body[4], pt[4], a_ = 0.f; \
        _Pragma("unroll") for (int g4 = 0; g4 < 4; ++g4) { const float s3 = (sv_[4 * g4] + sv_[4 * g4 + 1]) + sv_[4 * g4 + 2]; body[g4] = 2.f * s3 + sv_[4 * g4 + 3]; a_ += s3 + sv_[4 * g4 + 3]; } \
        lh += a_; \
        _Pragma("unroll") for (int k = 0; k < 4; ++k) pt[k] = __shfl_xor(sv_[4 * k + 3], 32); \
        U[h][(tt_) * 4 + 0] = body[0] + (hi ? pt[0] : carry); U[h][(tt_) * 4 + 1] = body[1] + (hi ? pt[1] : pt[0]); \
        U[h][(tt_) * 4 + 2] = body[2] + (hi ? pt[2] : pt[1]); U[h][(tt_) * 4 + 3] = body[3] + (hi ? pt[3] : pt[2]); \
        carry = pt[3]; } while (0)
#pragma unroll
    for (int tp = 0; tp < 4; ++tp) {
      const int T = T0 + 2 * tp;
      if (T + 1 < T1 && T + 1 < Tnear0) {
        const att::lds_cptr ka_ = kp0 + (T >> 1) * 8192 + (T & 1) * 512, kb_ = kp0 + ((T + 1) >> 1) * 8192 + ((T + 1) & 1) * 512;
        f32x16 sa, sb;
        { const bf16x8 a0 = *(const __attribute__((address_space(3))) bf16x8*)(ka_), a1 = *(const __attribute__((address_space(3))) bf16x8*)(ka_ + 2048), a2 = *(const __attribute__((address_space(3))) bf16x8*)(ka_ + 4096), a3 = *(const __attribute__((address_space(3))) bf16x8*)(ka_ + 6144);
          const bf16x8 b0 = *(const __attribute__((address_space(3))) bf16x8*)(kb_), b1 = *(const __attribute__((address_space(3))) bf16x8*)(kb_ + 2048), b2 = *(const __attribute__((address_space(3))) bf16x8*)(kb_ + 4096), b3 = *(const __attribute__((address_space(3))) bf16x8*)(kb_ + 6144);
          sa = __builtin_amdgcn_mfma_f32_32x32x16_bf16(a0, qr[0], zero16, 0, 0, 0); sb = __builtin_amdgcn_mfma_f32_32x32x16_bf16(b0, qr[0], zero16, 0, 0, 0);
          sa = __builtin_amdgcn_mfma_f32_32x32x16_bf16(a1, qr[1], sa, 0, 0, 0);     sb = __builtin_amdgcn_mfma_f32_32x32x16_bf16(b1, qr[1], sb, 0, 0, 0);
          sa = __builtin_amdgcn_mfma_f32_32x32x16_bf16(a2, qr[2], sa, 0, 0, 0);     sb = __builtin_amdgcn_mfma_f32_32x32x16_bf16(b2, qr[2], sb, 0, 0, 0);
          sa = __builtin_amdgcn_mfma_f32_32x32x16_bf16(a3, qr[3], sa, 0, 0, 0);     sb = __builtin_amdgcn_mfma_f32_32x32x16_bf16(b3, qr[3], sb, 0, 0, 0); }
#pragma unroll
        for (int r = 0; r < 16; ++r) { sa[r] = __builtin_amdgcn_exp2f(sa[r] + b31[h]); sb[r] = __builtin_amdgcn_exp2f(sb[r] + b31[h]); }
        TK_FINISH(2 * tp, sa); TK_FINISH(2 * tp + 1, sb);
      } else {
        if (T < T1) { f32x16 sv; TK_SCORES(T, h, sv); TK_FINISH(2 * tp, sv); }
        else { U[h][tp * 8 + 0] = 0.f; U[h][tp * 8 + 1] = 0.f; U[h][tp * 8 + 2] = 0.f; U[h][tp * 8 + 3] = 0.f; }
        if (T + 1 < T1) { f32x16 sv; TK_SCORES(T + 1, h, sv); TK_FINISH(2 * tp + 1, sv); }
        else { U[h][tp * 8 + 4] = 0.f; U[h][tp * 8 + 5] = 0.f; U[h][tp * 8 + 6] = 0.f; U[h][tp * 8 + 7] = 0.f; }
      }
    }
#undef TK_FINISH
    l[h] = lh;
  }
  { float* ls = (float*)(lds + L_LSUM);
#pragma unroll
    for (int h = 0; h < 3; ++h) ls[((grp * 2 + half) * 3 + h) * 64 + lane] = l[h]; }
  __syncthreads();
  { const float* ls = (const float*)(lds + L_LSUM); float rl[3];
#pragma unroll
    for (int h = 0; h < 3; ++h) { float lt = ls[((grp * 2 + 0) * 3 + h) * 64 + lane] + ls[((grp * 2 + 1) * 3 + h) * 64 + lane]; lt += __shfl_xor(lt, 32); rl[h] = (lt > 0.f) ? 1.f / lt : 0.f; }
#pragma unroll
    for (int i = 0; i < 32; ++i) impw[i * 64 + lane] = (U[0][i] * rl[0] + U[1][i] * rl[1]) + U[2][i] * rl[2]; }
#undef TK_SCORES
  __syncthreads();
  {
    const int qq = 16 * half + (lane & 15), part = lane >> 4, srcw = part >> 1, shi = part & 1;
    const float* ip = (const float*)(lds + L_IMP) + (grp + 4 * srcw) * 2048 + qq + 32 * shi;
    const int tbase = srcw ? Th : 0;
    unsigned v[32];
#pragma unroll
    for (int i = 0; i < 32; ++i) { const int j = 8 * (tbase + (i >> 2)) + 2 * (i & 3) + shi; v[i] = (j >= 1 && j <= cur - 2) ? __float_as_uint(ip[i * 64]) : 0u; }
    unsigned tau = 0u;
    if (cur >= 16) {
      unsigned thr = 0x7fffffffu;
#pragma unroll 1
      for (int rnd = 0; rnd < 13; ++rnd) {
        unsigned m0 = 0u, m1 = 0u, m2 = 0u, m3 = 0u;
#pragma unroll
        for (int i = 0; i < 32; i += 4) { m0 = max(m0, (v[i] < thr) ? v[i] : 0u); m1 = max(m1, (v[i + 1] < thr) ? v[i + 1] : 0u); m2 = max(m2, (v[i + 2] < thr) ? v[i + 2] : 0u); m3 = max(m3, (v[i + 3] < thr) ? v[i + 3] : 0u); }
        unsigned m = max(max(m0, m1), max(m2, m3));
        m = max(m, (unsigned)__shfl_xor((int)m, 16)); m = max(m, (unsigned)__shfl_xor((int)m, 32));
        thr = m;
      }
      tau = thr;
    }
    unsigned w0 = 0u, w1 = 0u, w2 = 0u, w3 = 0u;
#pragma unroll
    for (int i = 0; i < 32; ++i) { const int j = 8 * (tbase + (i >> 2)) + 2 * (i & 3) + shi;
      const bool ok = (j >= 1 && j <= cur - 2) && (v[i] >= tau); const unsigned m = ok ? (1u << (j & 31)) : 0u; const int wq = j >> 5;
      w0 |= (wq == 0) ? m : 0u; w1 |= (wq == 1) ? m : 0u; w2 |= (wq == 2) ? m : 0u; w3 |= (wq == 3) ? m : 0u; }
    w0 |= (unsigned)__shfl_xor((int)w0, 16); w1 |= (unsigned)__shfl_xor((int)w1, 16); w2 |= (unsigned)__shfl_xor((int)w2, 16); w3 |= (unsigned)__shfl_xor((int)w3, 16);
    w0 |= (unsigned)__shfl_xor((int)w0, 32); w1 |= (unsigned)__shfl_xor((int)w1, 32); w2 |= (unsigned)__shfl_xor((int)w2, 32); w3 |= (unsigned)__shfl_xor((int)w3, 32);
#pragma unroll
    for (int f = 0; f < 3; ++f) { const int jf = (f == 0) ? 0 : (f == 1) ? cur - 1 : cur; if (jf >= 0) { const unsigned m = 1u << (jf & 31); const int wq = jf >> 5;
        w0 |= (wq == 0) ? m : 0u; w1 |= (wq == 1) ? m : 0u; w2 |= (wq == 2) ? m : 0u; w3 |= (wq == 3) ? m : 0u; } }
    if (part == 0) *(uint4*)((unsigned*)(p.ws + OFF_SELQ) + ((size_t)bg * T_ + tq0 + qq) * 4) = make_uint4(w0, w1, w2, w3);
  }
  __syncthreads();
}
__device__ __forceinline__ void nsa_unit(const Cx& cx, const P& p, int u, char* lds, unsigned* qctr, int* qslot) {
  const int tid = cx.tid, lane = tid & 63, r32 = lane & 31, wid = tid >> 6;
  const int qb = 31 - u / 12, bgh = u % 12, b = bgh / 6, g = (bgh / 3) & 1, h = bgh % 3, head = g * 3 + h;
  const size_t rowb = (size_t)b * T_; const int q0 = qb * 256;
  const bf16_t* HB = (const bf16_t*)(p.ws + OFF_HB);
  const bf16_t* Qrows = HB + ((size_t)(24 + head) * M_ + rowb + q0) * 64;
  const float* gate0 = (const float*)(p.ws + OFF_GATES) + (rowb + q0) * 24 + head * 3;
  float* tabw = (float*)(lds + att::LDS_TAB);
  const float b31 = p.rel_bias[31 * 6 + head] * L2E;
  { const uint4 mq = *(const uint4*)((const unsigned*)(p.ws + OFF_SELQ) + ((size_t)(b * 2 + g) * T_ + q0 + wid * 32 + r32) * 4);
    unsigned* sw = (unsigned*)(lds + att::LDS_SELW) + wid * 128;
    const int nblk = 4 * qb + 4;
#pragma unroll
    for (int w4 = 0; w4 < 4; ++w4) { const unsigned w = (w4 == 0) ? mq.x : (w4 == 1) ? mq.y : (w4 == 2) ? mq.z : mq.w;
      if (32 * w4 < nblk) { for (int j = 0; j < 32; ++j) { const unsigned long long bal = __ballot((w >> j) & 1u); if (lane == 0) sw[32 * w4 + j] = (unsigned)bal; } } } }
  const float* btab = (const float*)(p.ws + OFF_BTAB) + head * 768;
  if (tid < 115) tabw[tid] = btab[tid] - b31;
  const int t0w = (qb >= 2) ? 4 * qb - 8 : 0;
  const bf16_t* Kwin = HB + ((size_t)(38 + g) * M_ + rowb + 64 * t0w) * 64; const bf16_t* Kcmp = (const bf16_t*)(p.ws + OFF_KC) + (size_t)(b * 2 + g) * 512 * 64;
  att::bf16x8 qfr[4];
  att::nsa_pass<0>(tid, Qrows, HB + ((size_t)(34 + g) * M_ + rowb) * 64, HB + ((size_t)(36 + g) * M_ + rowb) * 64, 4 * qb + 4, q0, b31, gate0 + 1, lds, true, qfr, false, Kwin);
  for (int i = tid; i < 514; i += NTHR) tabw[i] = btab[128 + i] - b31;
  { const int t0 = (qb >= 2) ? 4 * qb - 8 : 0;
    att::nsa_pass<1>(tid, Qrows, HB + ((size_t)(38 + g) * M_ + rowb + 64 * t0) * 64, HB + ((size_t)(40 + g) * M_ + rowb + 64 * t0) * 64, 4 * qb + 4 - t0, q0 - 64 * t0, b31, gate0 + 2, lds, false, qfr, true, Kcmp); }
  if (tid < 115) tabw[tid] = btab[tid] - b31;
  { const int nt = (qb < 16) ? 4 : (qb < 24) ? 6 : 8;
    att::nsa_pass<2>(tid, Qrows, (const bf16_t*)(p.ws + OFF_KC) + (size_t)(b * 2 + g) * 512 * 64, (const bf16_t*)(p.ws + OFF_VC) + (size_t)(b * 2 + g) * 512 * 64, nt, q0 - 31, b31, gate0, lds, false, qfr, true, nullptr); }
  int qpre = 0; if (cx.wv == 0 && lane_id() == 0) qpre = (int)atomicAdd(qctr, 1u);
  { const float* stg = (const float*)(lds + att::LDS_OST) + wid * 2048;
    bf16_t* mixw = (bf16_t*)(p.ws + OFF_MIX) + (rowb + q0 + wid * 32) * D_ + 384 + head * 64;
#pragma unroll
    for (int i = 0; i < 4; ++i) { const int row = i * 8 + (lane >> 3), ch = lane & 7;
      const f32x4 a0 = *(const f32x4*)(stg + row * 64 + ch * 8), a1 = *(const f32x4*)(stg + row * 64 + ch * 8 + 4);
      u32x4 w; w.x = pk2(a0[0], a0[1]); w.y = pk2(a0[2], a0[3]); w.z = pk2(a1[0], a1[1]); w.w = pk2(a1[2], a1[3]);
      *(u32x4*)(mixw + (size_t)row * D_ + ch * 8) = w; }
    asm volatile("s_waitcnt lgkmcnt(0)\n\ts_barrier" ::: "memory"); }
  if (cx.wv == 0 && lane_id() == 0) *qslot = qpre;
}
namespace mx {
using att::bf16x8; using att::s16x4; using att::f32x16; using att::lds_cptr;
#define MX_MFMA(a, b, c) __builtin_amdgcn_mfma_f32_32x32x16_bf16(a, b, c, 0, 0, 0)
__device__ __forceinline__ void dma_k_tile(const bf16_t* src, unsigned ldsaddr, int lane, int wid) { att::glds16(src + (size_t)lane * 64 + wid * 8, (unsigned)__builtin_amdgcn_readfirstlane(ldsaddr + wid * 1024)); }
__device__ __forceinline__ void dma_v_tile(const bf16_t* src, unsigned ldsaddr, int lane, int wid) { att::glds16(src + (size_t)(16 * (wid & 3) + (lane >> 2)) * 64 + (wid >> 2) * 32 + (lane & 3) * 8, (unsigned)__builtin_amdgcn_readfirstlane(ldsaddr + wid * 1024)); }
__device__ __forceinline__ int vlane_off(int lane) { return ((lane >> 4) & 1) * 32 + (lane & 3) * 8 + (4 * (lane >> 5) + ((lane & 15) >> 2)) * 64; }
__device__ __forceinline__ bf16x8 vfrag(lds_cptr vp, int i) { const s16x4 lo = att::vtr(vp + (i >> 2) * 4096 + (i & 3) * 1024), hi = att::vtr(vp + (i >> 2) * 4096 + (i & 3) * 1024 + 512);
  return (bf16x8){lo[0], lo[1], lo[2], lo[3], hi[0], hi[1], hi[2], hi[3]}; }
__device__ __forceinline__ bf16x8 kfrag(lds_cptr kp, int d0, int n) { return *(const __attribute__((address_space(3))) bf16x8*)(kp + d0 * 2048 + n * 512); }
#define MX_WAIT_ALL() asm volatile("s_waitcnt vmcnt(0) lgkmcnt(0)\n\ts_barrier" ::: "memory")
__device__ __forceinline__ float loggamma2(int h) { return log2f(1.f - exp2f(-5.f - (float)h)); }

__device__ __forceinline__ void ret_kv_unit(const Cx& cx, const P& p, int layer, int u, char* lds) {
  const int tid = cx.tid, lane = tid & 63, r32 = lane & 31, hi = lane >> 5, wid = cx.wv;
  const int bh = u >> 5, cp = u & 31, b = bh / 6, h = bh % 6;
  const size_t r0 = (size_t)b * T_ + cp * 256;
  const bf16_t* HB = (const bf16_t*)(p.ws + OFF_HB);
  const bf16_t* Kp = HB + ((size_t)(6 + h) * M_ + r0) * 64; const bf16_t* Vp = HB + ((size_t)(12 + h) * M_ + r0) * 64;
  const unsigned lds0 = (unsigned)(uintptr_t)lds;
#pragma unroll
  for (int i = 0; i < 4; ++i) { dma_v_tile(Vp + (size_t)i * 4096, lds0 + i * 8192, lane, wid); dma_v_tile(Kp + (size_t)i * 4096, lds0 + 32768 + i * 8192, lane, wid); }
  MX_WAIT_ALL();
  const int ch = wid >> 2, eb = (wid >> 1) & 1, db = wid & 1;
  f32x16 acc = f32x16{};
#pragma unroll
  for (int kt = 0; kt < 2; ++kt) { const lds_cptr vv = (lds_cptr)(uintptr_t)(lds0 + (ch * 2 + kt) * 8192) + vlane_off(lane), vk = vv + 32768;
#pragma unroll
    for (int ks = 0; ks < 4; ++ks) acc = MX_MFMA(vfrag(vv, 4 * eb + ks), vfrag(vk, 4 * db + ks), acc); }
  const float sc = exp2f(127.f * loggamma2(h));
  float* ST = (float*)(p.ws + OFF_RS) + ((size_t)bh * 64 + cp * 2 + ch) * 4096;
#pragma unroll
  for (int r = 0; r < 16; ++r) __hip_atomic_store(ST + (32 * eb + att::crow(r, hi)) * 64 + 32 * db + r32, acc[r] * sc, __ATOMIC_RELAXED, __HIP_MEMORY_SCOPE_AGENT);
  MX_WAIT_ALL();
  if (tid == 0) hand_publish((unsigned*)(p.ws + OFF_CTR) + 768 + layer * 64);
}
__device__ __forceinline__ void ret_scan(const Cx& cx, const P& p) {
  const float* __restrict__ ST = (const float*)(p.ws + OFF_RS); bf16_t* __restrict__ RT = (bf16_t*)(p.ws + OFF_RT);
  for (int i = cx.bid * NTHR + cx.tid; i < 12 * 4096; i += cx.G * NTHR) {
    const int bh = i >> 12, ed = i & 4095, h = bh % 6; const float lg = loggamma2(h), cd = exp2f(128.f * lg), g1 = exp2f(lg);
    const size_t o0 = (size_t)bh * 64 * 4096 + ed;
    float R = 0.f;
    float kv[64];
#pragma unroll
    for (int k = 0; k < 64; ++k) kv[k] = __hip_atomic_load(ST + o0 + (size_t)k * 4096, __ATOMIC_RELAXED, __HIP_MEMORY_SCOPE_AGENT);
#pragma unroll
    for (int k = 0; k < 64; ++k) { RT[o0 + (size_t)k * 4096] = f2bf(R * g1); R = cd * R + kv[k]; }
  }
}
__device__ __forceinline__ void ret_out_unit(const Cx& cx, const P& p, int u, char* lds, unsigned* qctr, int* qslot) {
  const int tid = cx.tid, lane = tid & 63, r32 = lane & 31, hi = lane >> 5, wid = cx.wv;
  const int bh = u >> 5, cp = u & 31, b = bh / 6, h = bh % 6;
  const size_t r0 = (size_t)b * T_ + cp * 256;
  const bf16_t* HB = (const bf16_t*)(p.ws + OFF_HB);
  const bf16_t* Qp = HB + ((size_t)(0 + h) * M_ + r0) * 64; const bf16_t* Kp = HB + ((size_t)(6 + h) * M_ + r0) * 64;
  const bf16_t* Vp = HB + ((size_t)(12 + h) * M_ + r0) * 64; const bf16_t* Gp = HB + ((size_t)(18 + h) * M_ + r0) * 64;
  const unsigned lds0 = (unsigned)(uintptr_t)lds;
#pragma unroll
  for (int i = 0; i < 4; ++i) { dma_k_tile(Kp + (size_t)i * 4096, lds0 + i * 8192, lane, wid); dma_v_tile(Vp + (size_t)i * 4096, lds0 + 32768 + i * 8192, lane, wid); }
  const int ch = wid >> 2, rt = wid & 3, rw = ch * 128 + rt * 32;
  bf16x8 qr[4], rtf[2][4];
  const bf16_t* RT = (const bf16_t*)(p.ws + OFF_RT) + ((size_t)bh * 64 + cp * 2 + ch) * 4096;
#pragma unroll
  for (int d0 = 0; d0 < 4; ++d0) qr[d0] = *reinterpret_cast<const bf16x8*>(Qp + (size_t)(rw + r32) * 64 + d0 * 16 + hi * 8);
#pragma unroll
  for (int eb = 0; eb < 2; ++eb)
#pragma unroll
    for (int ks = 0; ks < 4; ++ks) rtf[eb][ks] = *reinterpret_cast<const bf16x8*>(RT + (size_t)(32 * eb + r32) * 64 + 16 * ks + 8 * hi);
  u32x4 gwv[4];
#pragma unroll
  for (int i = 0; i < 4; ++i) gwv[i] = *(const u32x4*)(Gp + (size_t)(rw + i * 8 + (lane >> 3)) * 64 + (lane & 7) * 8);
  MX_WAIT_ALL();
  f32x16 o[2]; o[0] = f32x16{}; o[1] = f32x16{};
  const f32x16 zero16 = f32x16{};
  const int n = rt * 32 + r32;
  for (int kt = 0; kt <= (rt >> 1); ++kt) {
    const int tile = ch * 2 + kt;
    const lds_cptr kp = (lds_cptr)(uintptr_t)(lds0 + tile * 8192) + hi * 1024 + r32 * 16;
    f32x16 p0 = MX_MFMA(kfrag(kp, 0, 0), qr[0], zero16), p1 = MX_MFMA(kfrag(kp, 0, 1), qr[0], zero16);
#pragma unroll
    for (int d0 = 1; d0 < 4; ++d0) { p0 = MX_MFMA(kfrag(kp, d0, 0), qr[d0], p0); p1 = MX_MFMA(kfrag(kp, d0, 1), qr[d0], p1); }
    if (kt == (rt >> 1)) {
#pragma unroll
      for (int r = 0; r < 16; ++r) { const int m = 64 * kt + att::crow(r, hi); if (m > n) p0[r] = 0.f; if (m + 32 > n) p1[r] = 0.f; }
    }
    u32x4 pw0, pw1, pw2, pw3;
    pw0 = (u32x4){att::cvtpk(p0[0], p0[1]), att::cvtpk(p0[2], p0[3]), att::cvtpk(p0[4], p0[5]), att::cvtpk(p0[6], p0[7])};
    pw1 = (u32x4){att::cvtpk(p0[8], p0[9]), att::cvtpk(p0[10], p0[11]), att::cvtpk(p0[12], p0[13]), att::cvtpk(p0[14], p0[15])};
    pw2 = (u32x4){att::cvtpk(p1[0], p1[1]), att::cvtpk(p1[2], p1[3]), att::cvtpk(p1[4], p1[5]), att::cvtpk(p1[6], p1[7])};
    pw3 = (u32x4){att::cvtpk(p1[8], p1[9]), att::cvtpk(p1[10], p1[11]), att::cvtpk(p1[12], p1[13]), att::cvtpk(p1[14], p1[15])};
    const lds_cptr vp = (lds_cptr)(uintptr_t)(lds0 + 32768 + tile * 8192) + vlane_off(lane);
#pragma unroll
    for (int d0 = 0; d0 < 2; ++d0) {
      o[d0] = MX_MFMA(__builtin_bit_cast(bf16x8, pw0), vfrag(vp, 4 * d0 + 0), o[d0]); o[d0] = MX_MFMA(__builtin_bit_cast(bf16x8, pw1), vfrag(vp, 4 * d0 + 1), o[d0]);
      o[d0] = MX_MFMA(__builtin_bit_cast(bf16x8, pw2), vfrag(vp, 4 * d0 + 2), o[d0]); o[d0] = MX_MFMA(__builtin_bit_cast(bf16x8, pw3), vfrag(vp, 4 * d0 + 3), o[d0]); }
  }
#pragma unroll
  for (int eb = 0; eb < 2; ++eb)
#pragma unroll
    for (int ks = 0; ks < 4; ++ks) o[eb] = MX_MFMA(qr[ks], rtf[eb][ks], o[eb]);
  float* stg = (float*)(lds + 65536) + wid * 2048;
#pragma unroll
  for (int r = 0; r < 16; ++r) { const int orow = att::crow(r, hi); stg[orow * 64 + r32] = o[0][r]; stg[orow * 64 + 32 + r32] = o[1][r]; }
  asm volatile("s_waitcnt lgkmcnt(0)" ::: "memory");
  int qpre = 0; if (wid == 0 && lane_id() == 0) qpre = (int)atomicAdd(qctr, 1u);
  bf16_t* mix = (bf16_t*)(p.ws + OFF_MIX) + (r0 + rw) * D_ + h * 64;
#pragma unroll
  for (int i = 0; i < 4; ++i) { const int row = i * 8 + (lane >> 3), c8 = lane & 7;
    const f32x4 a0 = *(const f32x4*)(stg + row * 64 + c8 * 8), a1 = *(const f32x4*)(stg + row * 64 + c8 * 8 + 4);
    float ss = (a0[0] * a0[0] + a0[1] * a0[1]) + (a0[2] * a0[2] + a0[3] * a0[3]) + (a1[0] * a1[0] + a1[1] * a1[1]) + (a1[2] * a1[2] + a1[3] * a1[3]);
    ss += __shfl_xor(ss, 1); ss += __shfl_xor(ss, 2); ss += __shfl_xor(ss, 4);
    const float rs = rsqrtf(ss * (1.f / 64.f) + EPS);
    const u32x4 gw = gwv[i];
    float gv[8] = {__uint_as_float(gw.x << 16), __uint_as_float(gw.x & 0xffff0000u), __uint_as_float(gw.y << 16), __uint_as_float(gw.y & 0xffff0000u),
                   __uint_as_float(gw.z << 16), __uint_as_float(gw.z & 0xffff0000u), __uint_as_float(gw.w << 16), __uint_as_float(gw.w & 0xffff0000u)};
    float ov[8] = {a0[0], a0[1], a0[2], a0[3], a1[0], a1[1], a1[2], a1[3]};
#pragma unroll
    for (int k = 0; k < 8; ++k) ov[k] = ov[k] * rs * (gv[k] * sigmoidf(gv[k]));
    u32x4 w; w.x = pk2(ov[0], ov[1]); w.y = pk2(ov[2], ov[3]); w.z = pk2(ov[4], ov[5]); w.w = pk2(ov[6], ov[7]);
    *(u32x4*)(mix + (size_t)row * D_ + c8 * 8) = w; }
  asm volatile("s_waitcnt lgkmcnt(0)\n\ts_barrier" ::: "memory");
  if (wid == 0 && lane_id() == 0) *qslot = qpre;
}
__device__ __forceinline__ void gmlp_unit(const Cx& cx, const P& p, int layer, int u, char* lds, unsigned* qctr, int* qslot) {
  const int tid = cx.tid, lane = tid & 63, r32 = lane & 31, hi = lane >> 5, wid = cx.wv;
  const int g = u & 3, bc = u >> 2; const size_t r0 = (size_t)bc * 128;
  const bf16_t* HB = (const bf16_t*)(p.ws + OFF_HB);
  const bf16_t* Up = HB + ((size_t)(42 + g) * M_ + r0) * 64; const bf16_t* Vp = HB + ((size_t)(46 + g) * M_ + r0) * 64;
  const unsigned lds0 = (unsigned)(uintptr_t)lds;
  dma_v_tile(Vp, lds0, lane, wid); dma_v_tile(Vp + 4096, lds0 + 8192, lane, wid);
  const int rt = wid & 3, dh = wid >> 2;
  const bf16_t* Wr = (const bf16_t*)(p.ws + OFF_WSB) + ((size_t)(layer * 4 + g) * 128 + rt * 32 + r32) * 128;
  u32x4 uwv[2]; float bsv[2];
#pragma unroll
  for (int i = 0; i < 2; ++i) { const int t = rt * 32 + i * 16 + (lane >> 2); uwv[i] = *(const u32x4*)(Up + (size_t)t * 64 + dh * 32 + (lane & 3) * 8); bsv[i] = p.gm_b[(layer * 4 + g) * 128 + t]; }
  MX_WAIT_ALL();
  f32x16 acc = f32x16{};
  for (int ks = 0; ks < 2 * rt + 2; ++ks) {
    const uint2 alo = *(const uint2*)(Wr + 16 * ks + 4 * hi), ahi = *(const uint2*)(Wr + 16 * ks + 8 + 4 * hi);
    const u32x4 aw = (u32x4){alo.x, alo.y, ahi.x, ahi.y};
    const lds_cptr vp = (lds_cptr)(uintptr_t)(lds0 + (ks >> 2) * 8192) + vlane_off(lane);
    acc = MX_MFMA(__builtin_bit_cast(bf16x8, aw), vfrag(vp, 4 * dh + (ks & 3)), acc);
  }
  float* stg = (float*)(lds + 16384) + wid * 1024;
#pragma unroll
  for (int r = 0; r < 16; ++r) stg[att::crow(r, hi) * 32 + r32] = acc[r];
  asm volatile("s_waitcnt lgkmcnt(0)" ::: "memory");
  int qpre = 0; if (wid == 0 && lane_id() == 0) qpre = (int)atomicAdd(qctr, 1u);
  bf16_t* mix = (bf16_t*)(p.ws + OFF_MIX) + (r0 + rt * 32) * D_ + 768 + g * 64 + dh * 32;
#pragma unroll
  for (int i = 0; i < 2; ++i) { const int row = i * 16 + (lane >> 2), c8 = lane & 3, t = rt * 32 + row;
    const f32x4 a0 = *(const f32x4*)(stg + row * 32 + c8 * 8), a1 = *(const f32x4*)(stg + row * 32 + c8 * 8 + 4);
    const float bias = bsv[i];
    const u32x4 uw = uwv[i];
    u32x4 w; w.x = pk2(__uint_as_float(uw.x << 16) * (a0[0] + bias), __uint_as_float(uw.x & 0xffff0000u) * (a0[1] + bias));
    w.y = pk2(__uint_as_float(uw.y << 16) * (a0[2] + bias), __uint_as_float(uw.y & 0xffff0000u) * (a0[3] + bias));
    w.z = pk2(__uint_as_float(uw.z << 16) * (a1[0] + bias), __uint_as_float(uw.z & 0xffff0000u) * (a1[1] + bias));
    w.w = pk2(__uint_as_float(uw.w << 16) * (a1[2] + bias), __uint_as_float(uw.w & 0xffff0000u) * (a1[3] + bias));
    *(u32x4*)(mix + (size_t)row * D_ + c8 * 8) = w; }
  asm volatile("s_waitcnt lgkmcnt(0)\n\ts_barrier" ::: "memory");
  if (wid == 0 && lane_id() == 0) *qslot = qpre;
}
__device__ __forceinline__ void cmp_unit(const Cx& cx, const P& p, int layer, int u, char* lds) {
  const int tid = cx.tid, lane = tid & 63, r32 = lane & 31, hi = lane >> 5, wid = cx.wv;
  const int nt = u & 15, bgj = u >> 4, bg = bgj >> 1, j = bgj & 1, b = bg >> 1, g = bg & 1;
  const int nrow = min(nt * 32 + r32, 510);
  const bf16_t* xf = (const bf16_t*)(p.ws + OFF_HB) + ((size_t)(30 + j * 2 + g) * M_ + (size_t)b * T_) * 64 + (size_t)nrow * 1024;
  const bf16_t* W1T = (const bf16_t*)(p.ws + OFF_W1T) + (size_t)(layer * 2 + j) * 64 * 2048;
  bf16x8 w2f[2][2][2];
  if (wid == 0) { const bf16_t* wf = (const bf16_t*)(p.ws + OFF_W2F) + (size_t)(layer * 2 + j) * 4096 + lane * 8;
#pragma unroll
    for (int q = 0; q < 8; ++q) w2f[q >> 2][(q >> 1) & 1][q & 1] = *reinterpret_cast<const bf16x8*>(wf + q * 512); }
  f32x16 acc[2]; acc[0] = f32x16{}; acc[1] = f32x16{};
#pragma unroll 8
  for (int ks = 0; ks < 16; ++ks) { const int i0 = 256 * wid + 16 * ks + 8 * hi;
    const bf16x8 bx = *reinterpret_cast<const bf16x8*>(xf + i0);
    const bf16x8 a0 = *reinterpret_cast<const bf16x8*>(W1T + (size_t)r32 * 2048 + i0), a1 = *reinterpret_cast<const bf16x8*>(W1T + (size_t)(32 + r32) * 2048 + i0);
    acc[0] = MX_MFMA(a0, bx, acc[0]); acc[1] = MX_MFMA(a1, bx, acc[1]); }
  float* red = (float*)lds;
#pragma unroll
  for (int fb = 0; fb < 2; ++fb)
#pragma unroll
    for (int r = 0; r < 16; ++r) red[((wid * 2 + fb) * 16 + r) * 64 + lane] = acc[fb][r];
  MX_WAIT_ALL();
  {
    const float* c1 = (const float*)(p.ws + OFF_C1) + (layer * 2 + j) * 64;
    const int fb = wid >> 2, r0 = 4 * (wid & 3);
#pragma unroll
    for (int rr = 0; rr < 4; ++rr) { const int r = r0 + rr; float a = c1[32 * fb + att::crow(r, hi)];
#pragma unroll
      for (int w = 0; w < 8; ++w) a += red[((w * 2 + fb) * 16 + r) * 64 + lane];
      red[16384 + (fb * 16 + r) * 64 + lane] = gelu_tanh(a); } }
  MX_WAIT_ALL();
  if (wid == 0) {
    bf16x8 hb[2][2];
#pragma unroll
    for (int fb = 0; fb < 2; ++fb)
#pragma unroll
      for (int s2 = 0; s2 < 2; ++s2) { float hv[8];
#pragma unroll
        for (int k = 0; k < 8; ++k) hv[k] = red[16384 + (fb * 16 + 8 * s2 + k) * 64 + lane];
        const u32x4 w = (u32x4){att::cvtpk(hv[0], hv[1]), att::cvtpk(hv[2], hv[3]), att::cvtpk(hv[4], hv[5]), att::cvtpk(hv[6], hv[7])};
        hb[fb][s2] = __builtin_bit_cast(bf16x8, w); }
    f32x16 oc[2]; oc[0] = f32x16{}; oc[1] = f32x16{};
#pragma unroll
    for (int eb = 0; eb < 2; ++eb)
#pragma unroll
      for (int fb = 0; fb < 2; ++fb)
#pragma unroll
        for (int s2 = 0; s2 < 2; ++s2) oc[eb] = MX_MFMA(w2f[eb][fb][s2], hb[fb][s2], oc[eb]);
    if (j == 0) { float ss = 0.f;
#pragma unroll
      for (int eb = 0; eb < 2; ++eb)
#pragma unroll
        for (int r = 0; r < 16; ++r) ss += oc[eb][r] * oc[eb][r];
      ss += __shfl_xor(ss, 32);
      const float rs = rsqrtf(ss * (1.f / 64.f) + EPS);
#pragma unroll
      for (int eb = 0; eb < 2; ++eb)
#pragma unroll
        for (int r = 0; r < 16; ++r) oc[eb][r] *= rs * p.k_gain[(layer * 3 + 0) * 64 + 32 * eb + att::crow(r, hi)]; }
    bf16_t* dst = (bf16_t*)(p.ws + (j == 0 ? OFF_KC : OFF_VC)) + ((size_t)bg * 512 + nt * 32 + r32) * 64;
    const bool real = (nt * 32 + r32) < 511;
    if (real) {
#pragma unroll
      for (int eb = 0; eb < 2; ++eb)
#pragma unroll
        for (int r4 = 0; r4 < 4; ++r4)
        { const unsigned long long w = (unsigned long long)pk2(oc[eb][4 * r4], oc[eb][4 * r4 + 1]) | ((unsigned long long)pk2(oc[eb][4 * r4 + 2], oc[eb][4 * r4 + 3]) << 32);
          unsigned long long* q8 = (unsigned long long*)(dst + 32 * eb + att::crow(4 * r4, hi));
          if (j == 0) __hip_atomic_store(q8, w, __ATOMIC_RELAXED, __HIP_MEMORY_SCOPE_AGENT); else *q8 = w; } }
    if (j == 0) { asm volatile("s_waitcnt vmcnt(0)" ::: "memory"); if (lane == 0) hand_publish((unsigned*)(p.ws + OFF_CTR) + 512 + layer * 64 + bg * 16); }
  }
  MX_WAIT_ALL();
}
#undef MX_MFMA
}

__device__ __forceinline__ void ph_mix1(const Cx& cx, const P& p, int layer, char* lds, int rank, int nranks) {
  for (int item = rank; item < 128 + 384; item += nranks) {
    Cx c2 = cx; c2.tid = cx.wv * 64 + lane_id(); asm volatile("" : "+v"(c2.tid));
    if (item < 128) mx::cmp_unit(c2, p, layer, item, lds); else mx::ret_kv_unit(c2, p, layer, item - 128, lds);
  }
}
__device__ __forceinline__ void ph_mix2(const Cx& cx, const P& p, int layer, char* lds) {
  const int u0 = (cx.bid < 64) ? 192 + cx.bid : cx.bid - 64;
  for (int u = u0; u < 256; u += 256) { Cx c2 = cx; c2.tid = cx.wv * 64 + lane_id(); asm volatile("" : "+v"(c2.tid)); topk_unit(c2, p, layer, u, lds); }
  if (cx.bid >= 160) { if (cx.wv == 0 && lane_id() == 0) hand_wait((unsigned*)(p.ws + OFF_CTR) + 768 + layer * 64, 384u); __syncthreads();
    Cx c3 = cx; c3.bid = cx.bid - 160; c3.G = 96; mx::ret_scan(c3, p); }
}
__device__ __forceinline__ void ph_mix3(const Cx& cx, const P& p, int layer, char* lds) {
  const int nconv = (layer == 0) ? 148 : 0;
  unsigned* ctr = (unsigned*)(p.ws + OFF_CTR) + layer * 64;
  int* slot = (int*)(lds + 131072);
  const int nitem = 384 + 384 + 512 + nconv;
  __syncthreads();
  if (cx.wv == 0 && lane_id() == 0) *slot = (int)atomicAdd(ctr, 1u);
  __syncthreads();
  int item = __builtin_amdgcn_readfirstlane(*slot);
  while (item < nitem) {
    Cx c2 = cx; c2.tid = cx.wv * 64 + lane_id(); asm volatile("" : "+v"(c2.tid));
    if (item < 384) { nsa_unit(c2, p, item, lds, ctr, slot);
      asm volatile("s_waitcnt lgkmcnt(0)\n\ts_barrier" ::: "memory"); }
    else if (item < 768) { mx::ret_out_unit(c2, p, item - 384, lds, ctr, slot); asm volatile("s_waitcnt lgkmcnt(0)\n\ts_barrier" ::: "memory"); }
    else if (item < 768 + nconv) { const int c0 = 1664 + (item - 768) * 32; convert_weights(p, (LAS unsigned char*)lds, cx.wv, lane_id(), cx.wv, 8, c0, min(c0 + 32, 6400));
      __syncthreads();
      if (cx.wv == 0 && lane_id() == 0) *slot = (int)atomicAdd(ctr, 1u);
      __syncthreads(); }
    else { mx::gmlp_unit(c2, p, layer, item - 768 - nconv, lds, ctr, slot); asm volatile("s_waitcnt lgkmcnt(0)\n\ts_barrier" ::: "memory"); }
    item = __builtin_amdgcn_readfirstlane(*slot);
  }
}
typedef unsigned gu32_t;
#define XB_TMO      128
#define XB_XCNT(j)  (256  + 64 * (j))
#define XB_XSUB(j)  (1280 + 64 * (j))
#define XB_XGEN(j)  (2304 + 64 * (j))
#define XB_TOP      3328
#define XB_TOPGEN   3392
#define XCD_BAR_WORDS 3456
#define XB_SPIN_CAP (1u << 18)

__device__ __forceinline__ unsigned xb_ld(unsigned* p)              { return __hip_atomic_load(p, __ATOMIC_RELAXED, __HIP_MEMORY_SCOPE_AGENT); }
__device__ __forceinline__ unsigned xb_add(unsigned* p, unsigned v) { return __hip_atomic_fetch_add(p, v, __ATOMIC_RELAXED, __HIP_MEMORY_SCOPE_AGENT); }
__device__ __forceinline__ unsigned xb_xcc_id() { return (unsigned)__builtin_amdgcn_s_getreg((3 << 11) | 20) & 0xFu; }
#define XB_SPIN(cond, bar) do { unsigned _sp = 0; while (cond) { __builtin_amdgcn_s_sleep(1); \
    if ((++_sp & 255u) == 0u) { if (xb_ld(&(bar)[XB_TMO])) break; if (_sp > XB_SPIN_CAP) { atomicAdd(&(bar)[XB_TMO], 1u); break; } } } } while (0)

struct XcdBarrier {
    unsigned* bar; unsigned x;
    volatile LAS unsigned* st;
    int wv;
};

__device__ __forceinline__ XcdBarrier xcd_barrier_post(unsigned* bar, volatile LAS unsigned* st, int wv) {
    XcdBarrier b; b.bar = bar; b.x = xb_xcc_id(); b.st = st; b.wv = wv;
    if (wv == 0 && lane_id() == 0) (void)xb_add(&bar[XB_XCNT(b.x)], 1u);
    return b;
}
__device__ __forceinline__ void xcd_barrier_complete(unsigned* bar, unsigned x, unsigned& nloc, unsigned& nx) {
    const unsigned G = gridDim.x * gridDim.y * gridDim.z;
    unsigned sum, cnt, mine, sp = 0u;
    for (;;) {
        sum = 0u; cnt = 0u; mine = 0u;
#pragma unroll
        for (unsigned j = 0; j < 16; ++j) { const unsigned c = xb_ld(&bar[XB_XCNT(j)]); sum += c; cnt += (c > 0u) ? 1u : 0u; mine = (j == x) ? c : mine; }
        if (sum == G) break;
        __builtin_amdgcn_s_sleep(1);
        if ((++sp & 255u) == 0u) { if (xb_ld(&bar[XB_TMO])) break; if (sp > XB_SPIN_CAP) { atomicAdd(&bar[XB_TMO], 1u); break; } }
    }
    nloc = mine > 0u ? mine : 1u; nx = cnt > 0u ? cnt : 1u;
}

__device__ __forceinline__ void xcd_barrier(const XcdBarrier& b) {
    asm volatile("s_waitcnt vmcnt(0)" ::: "memory");
    __syncthreads();
    if (b.wv == 0 && lane_id() == 0) {
        unsigned* bar = b.bar;
        __builtin_amdgcn_s_waitcnt(0);
        unsigned nloc = b.st[0], nx = b.st[1];
        if (nloc == 0u) { xcd_barrier_complete(bar, b.x, nloc, nx); b.st[0] = nloc; b.st[1] = nx; }
        const unsigned old = __hip_atomic_fetch_add(&bar[XB_XSUB(b.x)], 1u, __ATOMIC_RELAXED, __HIP_MEMORY_SCOPE_WORKGROUP);
        const unsigned gen = old / nloc;
        if (old + 1u == (gen + 1u) * nloc) {
            __builtin_amdgcn_fence(__ATOMIC_RELEASE, "agent");
            asm volatile("s_waitcnt vmcnt(0)" ::: "memory");
            (void)xb_add(&bar[XB_TOP], 1u);
        }
        { const unsigned target = (gen + 1u) * nx;
          XB_SPIN((int)(xb_ld(&bar[XB_TOP]) - target) < 0, bar); }
        __builtin_amdgcn_fence(__ATOMIC_ACQUIRE, "agent");
        asm volatile("s_waitcnt vmcnt(0)" ::: "memory");
    }
    __syncthreads();
}

__global__ void __launch_bounds__(NTHR, 2) k_mega(P pk) {
  extern __shared__ __attribute__((aligned(16))) unsigned char lds_raw[];
  LAS unsigned char* lds = (LAS unsigned char*)lds_raw;
  float* sm = (float*)lds_raw;
  const int wave_s = __builtin_amdgcn_readfirstlane((int)threadIdx.x >> 6);
  { volatile LAS unsigned* bst = (volatile LAS unsigned*)(lds + 131072 + 64);
    if (threadIdx.x < 2) bst[threadIdx.x] = 0u;
    __syncthreads();
    (void)xcd_barrier_post((unsigned*)(pk.ws + OFF_BAR), bst, wave_s); }
#define GSYNC() do { kargp_t kb_ = (kargp_t)__builtin_amdgcn_kernarg_segment_ptr(); asm volatile("" : "+s"(kb_)); XcdBarrier xb_; xb_.bar = (unsigned*)(kb_->ws + OFF_BAR); xb_.x = xb_xcc_id(); \
    xb_.st = (volatile LAS unsigned*)(lds + 131072 + 64); xb_.wv = wave_s; xcd_barrier(xb_); } while (0)
#define LOADP(p, k) do { p.x = k->x; p.attn_norm = k->attn_norm; p.w_in = k->w_in; p.w_out = k->w_out; p.q_gain = k->q_gain; p.k_gain = k->k_gain; p.cmp_pe = k->cmp_pe; p.cmp_w1 = k->cmp_w1; p.cmp_w2 = k->cmp_w2; \
    p.gm_ws = k->gm_ws; p.gm_b = k->gm_b; p.ffn_norm = k->ffn_norm; p.w_gu = k->w_gu; p.w_down = k->w_down; p.rel_bias = k->rel_bias; p.out = k->out; p.ws = k->ws; } while (0)
  typedef const __attribute__((address_space(4))) P* kargp_t;
#define PB Cx cx; P p; { int t_ = wave_s * 64 + lane_id(), b_ = blockIdx.x; kargp_t k_ = (kargp_t)__builtin_amdgcn_kernarg_segment_ptr(); asm volatile("" : "+v"(t_), "+s"(b_), "+s"(k_)); LOADP(p, k_); cx.tid = t_; cx.bid = b_; cx.G = gridDim.x; cx.wv = wave_s; }
  { PB; ph_prologue(cx, p, lds); }
  GSYNC();
#pragma unroll 1
  for (int layer = 0; layer < 2; ++layer) {
    { PB; pg8::Gemm g{(const bf16_t*)(p.ws + OFF_XB), (const bf16_t*)(p.ws + OFF_WIN) + (size_t)layer * NPROJ * D_, M_, 3072, D_}; pg8::StaticOrder S; S.init(M_, 3072, cx.G, cx.bid);
      EpiProj E{(const float*)(p.ws + OFF_SSQ), (bf16_t*)(p.ws + OFF_HB), (float*)(p.ws + OFF_GATES), (const float2*)(p.ws + OFF_ROPE), p.q_gain + layer * 64, p.k_gain + layer * 192};
      pg8::gemm_phase<EpiProj, pg8::StaticOrder, PG8_ALIGN, PG8_SP2>(lds, g, S, E, cx.tid); }
    GSYNC();
    { PB; if (cx.bid < 64) {
        pg8::Gemm g2{(const bf16_t*)(p.ws + OFF_XB), (const bf16_t*)(p.ws + OFF_WIN) + (size_t)layer * NPROJ * D_, M_, NPROJ, D_}; pg8::OneUnit S2{cx.bid, 12, true};
        EpiProj E{(const float*)(p.ws + OFF_SSQ), (bf16_t*)(p.ws + OFF_HB), (float*)(p.ws + OFF_GATES), (const float2*)(p.ws + OFF_ROPE), p.q_gain + layer * 64, p.k_gain + layer * 192};
        pg8::gemm_phase<EpiProj, pg8::OneUnit, false, PG8_SP2>(lds, g2, S2, E, cx.tid);
      } else ph_mix1(cx, p, layer, (char*)lds_raw, cx.bid - 64, cx.G - 64); }
    { PB; ph_mix2(cx, p, layer, (char*)lds_raw); } GSYNC();
    { PB; ph_mix3(cx, p, layer, (char*)lds_raw); } GSYNC();
    { PB; pg8::Gemm g{(const bf16_t*)(p.ws + OFF_MIX), (const bf16_t*)(p.ws + OFF_WO) + (size_t)layer * D_ * D_, M_, D_, D_}; pg8::StaticOrder S; S.init(M_, D_, cx.G, cx.bid);
      EpiRes E{(layer == 0) ? p.x : nullptr, nullptr, (bf16_t*)(p.ws + OFF_XB), (float*)(p.ws + OFF_SSQ)};
      pg8::gemm_phase<EpiRes, pg8::StaticOrder, PG8_ALIGN, PG8_SP2>(lds, g, S, E, cx.tid); }
    GSYNC();
    { PB; pg8::Gemm g{(const bf16_t*)(p.ws + OFF_XB), (const bf16_t*)(p.ws + OFF_WGU) + (size_t)layer * 2 * DFF * D_, M_, 2 * DFF, D_}; pg8::StaticOrder S; S.init(M_, 2 * DFF, cx.G, cx.bid);
      EpiGU E{(const float*)(p.ws + OFF_SSQ), (bf16_t*)(p.ws + OFF_ACT)};
      pg8::gemm_phase<EpiGU, pg8::StaticOrder, PG8_ALIGN, PG8_SP2>(lds, g, S, E, cx.tid);
      { const int c0 = (cx.G > 128) ? 128 : 0; if (layer == 0 && cx.bid >= c0) convert_weights(p, lds, cx.wv, cx.tid & 63, (cx.bid - c0) * 8 + cx.wv, (cx.G - c0) * 8, 6400, 12800); } }
    GSYNC();
    { PB; pg8::Gemm g{(const bf16_t*)(p.ws + OFF_ACT), (const bf16_t*)(p.ws + OFF_WD) + (size_t)layer * D_ * DFF, M_, D_, DFF}; pg8::StaticOrder S; S.init(M_, D_, cx.G, cx.bid);
      EpiRes E{nullptr, (layer == 1) ? p.out : nullptr, (bf16_t*)(p.ws + OFF_XB), (float*)(p.ws + OFF_SSQ)};
      pg8::gemm_phase<EpiRes, pg8::StaticOrder, PG8_ALIGN, PG8_SP2>(lds, g, S, E, cx.tid); }
    if (layer == 0) GSYNC();
  }
}

extern "C" void kernel_launch(void* const* d_in, const int* in_sizes, int n_in, void* d_out, int out_size, void* d_ws, size_t ws_size, hipStream_t stream) {
  P p{};
  p.x = (const float*)d_in[0]; p.attn_norm = (const float*)d_in[1]; p.w_in = (const float*)d_in[2]; p.w_out = (const float*)d_in[3];
  p.q_gain = (const float*)d_in[4]; p.k_gain = (const float*)d_in[5]; p.cmp_pe = (const float*)d_in[6]; p.cmp_w1 = (const float*)d_in[7];
  p.cmp_w2 = (const float*)d_in[8]; p.gm_ws = (const float*)d_in[9]; p.gm_b = (const float*)d_in[10]; p.ffn_norm = (const float*)d_in[11];
  p.w_gu = (const float*)d_in[12]; p.w_down = (const float*)d_in[13]; p.rel_bias = (const float*)d_in[14];
  p.out = (float*)d_out; p.ws = (unsigned char*)d_ws;
  static int grid = 0;
  if (!grid) {
    (void)hipFuncSetAttribute((const void*)k_mega, hipFuncAttributeMaxDynamicSharedMemorySize, LDS_BYTES);
    int dev = 0, cus = 0, per_cu = 0;
    (void)hipGetDevice(&dev);
    (void)hipDeviceGetAttribute(&cus, hipDeviceAttributeMultiprocessorCount, dev);
    (void)hipOccupancyMaxActiveBlocksPerMultiprocessor(&per_cu, (const void*)k_mega, NTHR, LDS_BYTES);
    if (per_cu < 1) per_cu = 1;
    grid = cus;
  }
  (void)hipMemsetAsync((char*)d_ws + OFF_BAR, 0, 16384, stream);
  void* args[] = {&p};
  hipError_t e = hipLaunchCooperativeKernel((const void*)k_mega, dim3(grid), dim3(NTHR), args, LDS_BYTES, stream);
  if (e != hipSuccess) fprintf(stderr, "cooperative launch failed: %s (grid %d)\n", hipGetErrorString(e), grid);
}
```
